# Optimizing an MI355X kernel written in HIP

```python
import math
import jax, jax.numpy as jnp
from jax import lax
import numpy as np

D_MODEL = 1024
BATCH = 16
SEQ = 4096
DEPTH = 1

HEAD_DIM = 64
N_HEADS_A = 8
N_HEADS_B = 8
N_HEADS = N_HEADS_A + N_HEADS_B
D_A = N_HEADS_A * HEAD_DIM
D_B = N_HEADS_B * HEAD_DIM
D_MIX = D_A + D_B
N_IDX_HEADS = 4
IDX_DIM = 64
TOPK_MAX = 256
DIL_PATTERNS = ((128, 1), (512, 4), (2048, 16))
BLOCK = 128
N_BUCKETS = 32
MAX_DISTANCE = 128
EPS = 1e-6
SPLITS = (D_A, D_A, D_A, D_A, N_IDX_HEADS * IDX_DIM, IDX_DIM, N_IDX_HEADS, D_B, D_B, D_B, D_B)
D_IN = sum(SPLITS)

kernel_name = "hybrid_dsa_dilated_parallel_heads"


def rms_norm(x, g):
    xf = x.astype(jnp.float32)
    y = xf * lax.rsqrt(jnp.mean(xf * xf, axis=-1, keepdims=True) + EPS) * g.astype(jnp.float32)
    return y.astype(x.dtype)


def rel_bucket(dist):
    max_exact = N_BUCKETS // 2
    d = jnp.maximum(dist, 0)
    df = jnp.maximum(d, 1).astype(jnp.float32)
    large = max_exact + (jnp.log(df / max_exact) / math.log(MAX_DISTANCE / max_exact)
                         * (N_BUCKETS - max_exact)).astype(jnp.int32)
    large = jnp.minimum(large, N_BUCKETS - 1)
    return jnp.where(d < max_exact, d, large)


def dsa_attention(q, k, v, q_idx, k_idx, w_idx, bias_table):
    b, s, h, dh = q.shape
    topk = min(TOPK_MAX, s // 4)
    nblk = s // BLOCK
    scale = HEAD_DIM ** -0.5
    idx_scale = (N_IDX_HEADS * IDX_DIM) ** -0.5
    key_pos = jnp.arange(s)

    def to_blocks(a):
        return jnp.moveaxis(a.reshape(b, nblk, BLOCK, *a.shape[2:]), 1, 0)

    def block_fn(args):
        qb, qib, wb, start = args
        q_pos = start + jnp.arange(BLOCK)
        rel = jnp.einsum('bqhd,bsd->bqhs', qib, k_idx)
        score = jnp.einsum('bqhs,bqh->bqs', jax.nn.relu(rel).astype(jnp.float32),
                           wb.astype(jnp.float32)) * idx_scale
        causal = key_pos[None, :] <= q_pos[:, None]
        score = jnp.where(causal[None], score, -jnp.inf)
        top_val, top_idx = lax.top_k(score, topk)
        valid = jnp.isfinite(top_val)
        k_sel = jax.vmap(lambda kk, ii: kk[ii])(k, top_idx)
        v_sel = jax.vmap(lambda vv, ii: vv[ii])(v, top_idx)
        logits = jnp.einsum('bqhd,bqkhd->bqhk', qb, k_sel).astype(jnp.float32) * scale
        bucket = rel_bucket(q_pos[None, :, None] - top_idx)
        bias = jnp.moveaxis(bias_table[bucket], -1, -2).astype(jnp.float32)
        logits = jnp.where(valid[:, :, None, :], logits + bias, -jnp.inf)
        p = jax.nn.softmax(logits, axis=-1)
        return jnp.einsum('bqhk,bqkhd->bqhd', p.astype(v.dtype), v_sel)

    starts = jnp.arange(nblk) * BLOCK
    out = lax.map(block_fn, (to_blocks(q), to_blocks(q_idx), to_blocks(w_idx), starts))
    return jnp.moveaxis(out, 0, 1).reshape(b, s, h, dh)


def dilated_pattern(q, k, v, window, dilation, bias_table):
    b, s, h, dh = q.shape
    seg = dilation * BLOCK
    p_len = -(-s // seg) * seg
    pad = p_len - s
    n_sub = p_len // dilation
    nb = n_sub // BLOCK
    steps = window // dilation
    scale = HEAD_DIM ** -0.5

    def to_segments(a):
        a = jnp.pad(a, ((0, 0), (0, pad), (0, 0), (0, 0)))
        a = a.reshape(b, n_sub, dilation, h, dh).transpose(2, 0, 1, 3, 4)
        return a.reshape(dilation, b, nb, BLOCK, h, dh)

    def band(a):
        prev = jnp.pad(a, ((0, 0), (0, 0), (1, 0), (0, 0), (0, 0), (0, 0)))[:, :, :-1]
        return jnp.concatenate([prev, a], axis=3)

    def seg_major(a):
        return jnp.moveaxis(a, 2, 1).reshape(dilation * nb, b, *a.shape[3:])

    qs, ks, vs = to_segments(q), to_segments(k), to_segments(v)
    qs, kb, vb = seg_major(qs), seg_major(band(ks)), seg_major(band(vs))
    blk_ids = jnp.arange(dilation * nb) % nb

    a_idx = jnp.arange(BLOCK)[:, None]
    c_idx = jnp.arange(2 * BLOCK)[None, :]
    diff = a_idx - c_idx + BLOCK
    band_mask = (diff >= 0) & (diff <= steps)
    bias = jnp.transpose(bias_table[rel_bucket(diff * dilation)], (2, 0, 1)).astype(jnp.float32)

    def seg_fn(args):
        qq, kk, vv, blk = args
        key_ok = (blk * BLOCK - BLOCK + jnp.arange(2 * BLOCK)) >= 0
        mask = band_mask & key_ok[None, :]
        logits = jnp.einsum('bqhd,bkhd->bhqk', qq, kk).astype(jnp.float32) * scale + bias
        logits = jnp.where(mask, logits, -jnp.inf)
        m = jnp.max(logits, axis=-1)
        pexp = jnp.exp(logits - m[..., None])
        den = jnp.sum(pexp, axis=-1)
        num = jnp.einsum('bhqk,bkhd->bqhd', pexp, vv.astype(jnp.float32))
        return jnp.swapaxes(m, 1, 2), jnp.swapaxes(den, 1, 2), num

    m, den, num = lax.map(seg_fn, (qs, kb, vb, blk_ids))

    def unseg(a):
        rest = a.shape[3:]
        a = a.reshape(dilation, nb, b, BLOCK, *rest)
        a = jnp.moveaxis(jnp.moveaxis(a, 0, 3), 0, 1)
        return a.reshape(b, p_len, *rest)[:, :s]

    return unseg(m), unseg(den), unseg(num)


def dilated_attention(q, k, v, bias_table):
    stats = [dilated_pattern(q, k, v, w, d, bias_table) for (w, d) in DIL_PATTERNS]
    m_all = jnp.stack([st[0] for st in stats])
    wts = jnp.exp(m_all - jnp.max(m_all, axis=0))
    den = sum(wts[i] * stats[i][1] for i in range(len(stats)))
    num = sum(wts[i][..., None] * stats[i][2] for i in range(len(stats)))
    return (num / den[..., None]).astype(q.dtype)


def setup_inputs(seed: int = 0) -> dict:
    key = jax.random.key(seed)
    ks = jax.random.split(key, 9)
    x = jax.random.normal(ks[0], (BATCH, SEQ, D_MODEL), jnp.float32)
    norm_gain = 1.0 + 0.02 * jax.random.normal(ks[1], (DEPTH, D_MODEL), jnp.float32)
    w_in = jax.random.normal(ks[2], (DEPTH, D_MODEL, D_IN), jnp.float32) * D_MODEL ** -0.5
    w_out = jax.random.normal(ks[3], (DEPTH, D_MIX, D_MODEL), jnp.float32) * D_MIX ** -0.5
    rel_bias = 0.1 * jax.random.normal(ks[4], (N_BUCKETS, N_HEADS), jnp.float32)
    q_norm_a = 1.0 + 0.02 * jax.random.normal(ks[5], (DEPTH, HEAD_DIM), jnp.float32)
    k_norm_a = 1.0 + 0.02 * jax.random.normal(ks[6], (DEPTH, HEAD_DIM), jnp.float32)
    q_norm_b = 1.0 + 0.02 * jax.random.normal(ks[7], (DEPTH, HEAD_DIM), jnp.float32)
    k_norm_b = 1.0 + 0.02 * jax.random.normal(ks[8], (DEPTH, HEAD_DIM), jnp.float32)
    return {"x": x, "norm_gain": norm_gain, "w_in": w_in, "w_out": w_out, "rel_bias": rel_bias,
            "q_norm_a": q_norm_a, "k_norm_a": k_norm_a, "q_norm_b": q_norm_b, "k_norm_b": k_norm_b}


def reference(x, norm_gain, w_in, w_out, rel_bias, q_norm_a, k_norm_a, q_norm_b, k_norm_b):
    b, s, _ = x.shape
    split_points = np.cumsum(SPLITS)[:-1].tolist()
    bias_a = rel_bias[:, :N_HEADS_A]
    bias_b = rel_bias[:, N_HEADS_A:]
    for layer in range(DEPTH):
        xn = rms_norm(x, norm_gain[layer])
        proj = jnp.einsum('bsd,de->bse', xn, w_in[layer])
        qa, ka, va, za, qi, ki, wi, qb, kb, vb, zb = jnp.split(proj, split_points, axis=-1)
        qa = rms_norm(qa.reshape(b, s, N_HEADS_A, HEAD_DIM), q_norm_a[layer])
        ka = rms_norm(ka.reshape(b, s, N_HEADS_A, HEAD_DIM), k_norm_a[layer])
        va = va.reshape(b, s, N_HEADS_A, HEAD_DIM)
        qi = qi.reshape(b, s, N_IDX_HEADS, IDX_DIM)
        qb = rms_norm(qb.reshape(b, s, N_HEADS_B, HEAD_DIM), q_norm_b[layer])
        kb = rms_norm(kb.reshape(b, s, N_HEADS_B, HEAD_DIM), k_norm_b[layer])
        vb = vb.reshape(b, s, N_HEADS_B, HEAD_DIM)
        a_out = dsa_attention(qa, ka, va, qi, ki, wi, bias_a)
        b_out = dilated_attention(qb, kb, vb, bias_b)
        mixed = jnp.concatenate([a_out.reshape(b, s, D_A) * jax.nn.silu(za),
                                 b_out.reshape(b, s, D_B) * jax.nn.silu(zb)], axis=-1)
        x = x + jnp.einsum('bse,ed->bsd', mixed, w_out[layer])
    return x
```

```cpp
#include <hip/hip_runtime.h>
#include <stdint.h>
#include <cstdio>

typedef unsigned short bf16_t;

constexpr int D_MODEL = 1024, BATCH = 16, SEQ = 4096, M_TOK = BATCH * SEQ;
constexpr int NPHYS = 4608;
constexpr float EPS = 1e-6f;
constexpr float LOG2E = 1.4426950408889634f;
constexpr float QSCALE = 0.125f * LOG2E;
constexpr float IDX_SCALE = 0.0625f;

constexpr size_t MiB = 1u << 20;
constexpr size_t WS_CTL = 0;
constexpr size_t WS_WTI = 2 * MiB;
constexpr size_t WS_WTO = 11 * MiB;
constexpr size_t WS_TAB = 13 * MiB;
constexpr size_t WS_RSTD = 14 * MiB;
constexpr size_t WS_WI = 15 * MiB;
constexpr size_t WS_XB = 16 * MiB;
constexpr size_t WS_MIX = WS_XB;
constexpr size_t WS_QA = 144 * MiB, WS_KA = 208 * MiB, WS_VA = 272 * MiB, WS_ZA = 336 * MiB;
constexpr size_t WS_QB = 400 * MiB, WS_KB = 464 * MiB, WS_VB = 528 * MiB, WS_ZB = 592 * MiB;
constexpr size_t WS_QI = 656 * MiB;
constexpr size_t WS_KI = 688 * MiB;
constexpr size_t WS_MASK = 696 * MiB;
constexpr size_t WS_GM = 728 * MiB;
constexpr size_t WS_END = 760 * MiB;

__device__ __forceinline__ float bf2f(bf16_t v) { return __uint_as_float(((unsigned)v) << 16); }
__device__ __forceinline__ bf16_t f2bf(float f) { unsigned u = __float_as_uint(f); return (bf16_t)((u + 0x7fffu + ((u >> 16) & 1u)) >> 16); }

__host__ __device__ __forceinline__ int logical_of_phys(int p) { const int tile = p >> 8, pc = p & 255, bj = pc >> 7, wc = (pc >> 5) & 3, w = pc & 31; return tile * 256 + 64 * wc + 32 * bj + w; }
__host__ __device__ __forceinline__ int src_col_of_logical(int L) {
    if (L < 2048) return L;
    if (L < 4096) return 2372 + (L - 2048);
    if (L < 4352) return 2048 + (L - 4096);
    if (L < 4416) return 2304 + (L - 4352);
    if (L < 4420) return 2368 + (L - 4416);
    return -1;
}
__device__ __forceinline__ int crow(int r, int hi) { return (r & 3) + 8 * (r >> 2) + 4 * hi; }
__device__ __forceinline__ size_t mask_word_index(int b, int q, int k, int& bit) {
    const int qb = q >> 5, kb = k >> 5, kk = k & 31; const int r = (kk & 3) | ((kk >> 3) << 2), hi = (kk >> 2) & 1;
    bit = (q & 31) + 32 * hi;
    return (((size_t)b * 128 + qb) * 128 + kb) * 16 + r;
}

__global__ void g_prep_w(const float* __restrict__ w_in, const float* __restrict__ gain, const float* __restrict__ w_out, const float* __restrict__ rel_bias,
                         bf16_t* WTI, bf16_t* WTO, float* bias2, int* bucket) {
    const size_t gid = (size_t)blockIdx.x * blockDim.x + threadIdx.x, gsz = (size_t)gridDim.x * blockDim.x;
    for (size_t i = gid; i < (size_t)NPHYS * 1024; i += gsz) {
        const int k = (int)(i / NPHYS), p = (int)(i % NPHYS); const int src = src_col_of_logical(logical_of_phys(p));
        const float v = src >= 0 ? w_in[(size_t)k * 4420 + src] * gain[k] : 0.f;
        WTI[(size_t)p * 1024 + k] = f2bf(v);
    }
    for (size_t i = gid; i < (size_t)1024 * 1024; i += gsz) { const int k = (int)(i >> 10), n = (int)(i & 1023); WTO[(size_t)n * 1024 + k] = f2bf(w_out[(size_t)k * 1024 + n]); }
    for (size_t i = gid; i < 512; i += gsz) bias2[i] = rel_bias[i] * LOG2E;
    for (size_t i = gid; i < 4096; i += gsz) { const int d = (int)i; int bk;
        if (d < 16) bk = d; else { const float df = (float)d; int lg = 16 + (int)(logf(df / 16.f) / logf(8.f) * 16.f); bk = lg < 31 ? lg : 31; }
        bucket[i] = bk; }
}

__global__ __launch_bounds__(256) void g_prep_x(const float* __restrict__ x, bf16_t* XB, float* RSTD) {
    const int wave = (blockIdx.x * 256 + threadIdx.x) >> 6, lane = threadIdx.x & 63, nw = (gridDim.x * 256) >> 6;
    for (int m = wave; m < M_TOK; m += nw) {
        const float4* xr = (const float4*)(x + (size_t)m * 1024) + lane; float4 v[4]; float s = 0.f;
#pragma unroll
        for (int j = 0; j < 4; ++j) { v[j] = xr[64 * j]; s += v[j].x * v[j].x + v[j].y * v[j].y + v[j].z * v[j].z + v[j].w * v[j].w; }
#pragma unroll
        for (int o = 1; o < 64; o <<= 1) s += __shfl_xor(s, o);
        if (lane == 0) RSTD[m] = rsqrtf(s * (1.f / 1024.f) + EPS);
        uint2* o2 = (uint2*)(XB + (size_t)m * 1024) + lane;
#pragma unroll
        for (int j = 0; j < 4; ++j) { uint2 w; w.x = f2bf(v[j].x) | ((unsigned)f2bf(v[j].y) << 16); w.y = f2bf(v[j].z) | ((unsigned)f2bf(v[j].w) << 16); o2[64 * j] = w; }
    }
}

struct EpiInProj {
    const float* rstd; unsigned char* ws;
    __device__ __forceinline__ void operator()(int m, int p, float v) const {
        const int L = logical_of_phys(p); v *= rstd[m];
        if (L < 2048) { bf16_t* base = (bf16_t*)(ws + WS_QA + (size_t)(L >> 9) * 64 * MiB); base[(size_t)m * 512 + (L & 511)] = f2bf(v); }
        else if (L < 4096) { const int l2 = L - 2048; bf16_t* base = (bf16_t*)(ws + WS_QB + (size_t)(l2 >> 9) * 64 * MiB); base[(size_t)m * 512 + (l2 & 511)] = f2bf(v); }
        else if (L < 4352) ((bf16_t*)(ws + WS_QI))[(size_t)m * 256 + (L - 4096)] = f2bf(v);
        else if (L < 4416) ((bf16_t*)(ws + WS_KI))[(size_t)m * 64 + (L - 4352)] = f2bf(v);
        else if (L < 4420) ((float*)(ws + WS_WI))[(size_t)m * 4 + (L - 4416)] = v * IDX_SCALE;
    }
};
struct EpiOutProj {
    const float* x; float* out;
    __device__ __forceinline__ void operator()(int m, int n, float v) const { out[(size_t)m * 1024 + n] = x[(size_t)m * 1024 + n] + v; }
};

template <class Epi> __global__ __launch_bounds__(256) void g_gemm(const bf16_t* __restrict__ A, const bf16_t* __restrict__ B, int K, Epi epi) {
    __shared__ float As[16][68], Bs[16][68];
    const int tid = threadIdx.x, tx = tid & 15, ty = tid >> 4, m0 = blockIdx.y * 64, n0 = blockIdx.x * 64, lr = tid >> 2, lk = (tid & 3) * 4;
    float acc[4][4];
#pragma unroll
    for (int i = 0; i < 4; ++i)
#pragma unroll
        for (int j = 0; j < 4; ++j) acc[i][j] = 0.f;
    const bf16_t* ap = A + (size_t)(m0 + lr) * K + lk; const bf16_t* bp = B + (size_t)(n0 + lr) * K + lk;
    for (int k0 = 0; k0 < K; k0 += 16) {
        const uint2 a = *(const uint2*)(ap + k0), b = *(const uint2*)(bp + k0);
        As[lk + 0][lr] = __uint_as_float(a.x << 16); As[lk + 1][lr] = __uint_as_float(a.x & 0xffff0000u); As[lk + 2][lr] = __uint_as_float(a.y << 16); As[lk + 3][lr] = __uint_as_float(a.y & 0xffff0000u);
        Bs[lk + 0][lr] = __uint_as_float(b.x << 16); Bs[lk + 1][lr] = __uint_as_float(b.x & 0xffff0000u); Bs[lk + 2][lr] = __uint_as_float(b.y << 16); Bs[lk + 3][lr] = __uint_as_float(b.y & 0xffff0000u);
        __syncthreads();
#pragma unroll
        for (int kk = 0; kk < 16; ++kk) {
            const float4 av = *(const float4*)&As[kk][ty * 4], bv = *(const float4*)&Bs[kk][tx * 4];
            const float a4[4] = {av.x, av.y, av.z, av.w}, b4[4] = {bv.x, bv.y, bv.z, bv.w};
#pragma unroll
            for (int i = 0; i < 4; ++i)
#pragma unroll
                for (int j = 0; j < 4; ++j) acc[i][j] = fmaf(a4[i], b4[j], acc[i][j]);
        }
        __syncthreads();
    }
#pragma unroll
    for (int i = 0; i < 4; ++i)
#pragma unroll
        for (int j = 0; j < 4; ++j) epi(m0 + ty * 4 + i, n0 + tx * 4 + j, acc[i][j]);
}

__global__ __launch_bounds__(256) void g_qknorm(unsigned char* ws, const float* __restrict__ gqa, const float* __restrict__ gka, const float* __restrict__ gqb, const float* __restrict__ gkb) {
    const size_t gid = (size_t)blockIdx.x * 256 + threadIdx.x;
    if (gid >= (size_t)4 * M_TOK * 8) return;
    const int which = (int)(gid / ((size_t)M_TOK * 8)); const size_t rem = gid % ((size_t)M_TOK * 8);
    const size_t off = which == 0 ? WS_QA : which == 1 ? WS_KA : which == 2 ? WS_QB : WS_KB; const float* g = which == 0 ? gqa : which == 1 ? gka : which == 2 ? gqb : gkb;
    bf16_t* p = (bf16_t*)(ws + off) + rem * 64; const float sc = (which == 0 || which == 2) ? QSCALE : 1.f;
    float v[64]; float s = 0.f;
#pragma unroll
    for (int i = 0; i < 64; ++i) { v[i] = bf2f(p[i]); s += v[i] * v[i]; }
    const float r = rsqrtf(s * (1.f / 64.f) + EPS) * sc;
#pragma unroll
    for (int i = 0; i < 64; ++i) p[i] = f2bf(v[i] * r * g[i]);
}

__device__ __forceinline__ unsigned mono_key(float s) { const unsigned u = __float_as_uint(s); return (u & 0x80000000u) ? ~u : (u | 0x80000000u); }

__global__ __launch_bounds__(256) void g_topk(const bf16_t* __restrict__ QI, const bf16_t* __restrict__ KI, const float* __restrict__ WI, unsigned long long* GM) {
    __shared__ float sc[4096]; __shared__ float qs[256]; __shared__ unsigned hist[256]; __shared__ unsigned sh_prefix, sh_need; __shared__ unsigned cnt[256]; __shared__ unsigned short bits16[256];
    const int t = blockIdx.x, b = t / SEQ, q = t % SEQ, n = q + 1, tid = threadIdx.x;
    qs[tid] = bf2f(QI[(size_t)t * 256 + tid]);
    float w[4];
#pragma unroll
    for (int h = 0; h < 4; ++h) w[h] = WI[(size_t)t * 4 + h];
    __syncthreads();
    for (int k = tid; k < n; k += 256) {
        const bf16_t* kr = KI + ((size_t)b * SEQ + k) * 64; float r[4] = {0.f, 0.f, 0.f, 0.f};
#pragma unroll 8
        for (int d = 0; d < 64; ++d) { const float kv = bf2f(kr[d]);
#pragma unroll
            for (int h = 0; h < 4; ++h) r[h] = fmaf(qs[h * 64 + d], kv, r[h]); }
        float s = 0.f;
#pragma unroll
        for (int h = 0; h < 4; ++h) s = fmaf(w[h], fmaxf(r[h], 0.f), s);
        sc[k] = s;
    }
    __syncthreads();
    unsigned T = 0u, need = 0u; bool all = (n <= 256);
    if (!all) {
        if (tid == 0) { sh_prefix = 0u; sh_need = 256u; }
        for (int pass = 3; pass >= 0; --pass) {
            const int shift = pass * 8; hist[tid] = 0u; __syncthreads();
            const unsigned prefix = sh_prefix, himask = (pass == 3) ? 0u : (0xffffffffu << (shift + 8));
            for (int k = tid; k < n; k += 256) { const unsigned key = mono_key(sc[k]); if ((key & himask) == prefix) atomicAdd(&hist[(key >> shift) & 255u], 1u); }
            __syncthreads();
            if (tid == 0) { unsigned nd = sh_need, cum = 0u; int d = 255; for (; d > 0; --d) { if (cum + hist[d] >= nd) break; cum += hist[d]; } sh_need = nd - cum; sh_prefix = prefix | ((unsigned)d << shift); }
            __syncthreads();
        }
        T = sh_prefix; need = sh_need;
    }
    unsigned myties = 0u;
    if (!all) for (int i = 0; i < 16; ++i) { const int k = tid * 16 + i; if (k < n && mono_key(sc[k]) == T) ++myties; }
    cnt[tid] = myties; __syncthreads();
    unsigned before = 0u; for (int i = 0; i < tid; ++i) before += cnt[i];
    unsigned short bits = 0;
    for (int i = 0; i < 16; ++i) { const int k = tid * 16 + i; if (k >= n) break; bool sel;
        if (all) sel = true; else { const unsigned key = mono_key(sc[k]); if (key > T) sel = true; else if (key == T) { sel = before < need; ++before; } else sel = false; }
        if (sel) bits |= (unsigned short)(1u << i); }
    bits16[tid] = bits; __syncthreads();
    if (tid < 64) { unsigned long long w64 = 0ull; for (int i = 0; i < 4; ++i) w64 |= (unsigned long long)bits16[tid * 4 + i] << (16 * i); GM[(size_t)t * 64 + tid] = w64; }
}

__global__ __launch_bounds__(256) void g_mask_convert(const unsigned long long* __restrict__ GM, unsigned long long* MASK) {
    const size_t gid = (size_t)blockIdx.x * 256 + threadIdx.x;
    if (gid >= (size_t)BATCH * 128 * 128 * 16) return;
    const int r = (int)(gid & 15), kb = (int)((gid >> 4) & 127), qb = (int)((gid >> 11) & 127), b = (int)(gid >> 18);
    unsigned long long w = 0ull;
    if (kb <= qb) for (int l = 0; l < 64; ++l) { const int q = qb * 32 + (l & 31), k = kb * 32 + crow(r, l >> 5); const unsigned long long g = GM[((size_t)b * SEQ + q) * 64 + (k >> 6)]; w |= ((g >> (k & 63)) & 1ull) << l; }
    MASK[gid] = w;
}

template <int BRANCH> __global__ __launch_bounds__(256) void g_attn(const bf16_t* __restrict__ Q, const bf16_t* __restrict__ Kt, const bf16_t* __restrict__ V, const bf16_t* __restrict__ Z,
                                                                     const unsigned long long* __restrict__ MASK, const float* __restrict__ bias2, const int* __restrict__ bucket, bf16_t* MIX) {
    __shared__ float qf[512]; __shared__ int lkey[400]; __shared__ int ldist[400]; __shared__ float pe[400][8]; __shared__ float red[32][8]; __shared__ float hm[8], hl[8]; __shared__ unsigned cnt[256]; __shared__ int sh_n;
    const int t = blockIdx.x, b = t / SEQ, q = t % SEQ, tid = threadIdx.x; const size_t rowb = (size_t)b * SEQ;
    qf[tid] = bf2f(Q[(size_t)t * 512 + tid]); qf[tid + 256] = bf2f(Q[(size_t)t * 512 + 256 + tid]);
    int nE;
    if (BRANCH == 0) {
        unsigned mybits = 0u; unsigned c = 0u;
        for (int i = 0; i < 16; ++i) { const int k = tid * 16 + i; if (k <= q) { int bit; const size_t wi = mask_word_index(b, q, k, bit); if ((MASK[wi] >> bit) & 1ull) { mybits |= 1u << i; ++c; } } }
        cnt[tid] = c; __syncthreads();
        unsigned before = 0u; for (int i = 0; i < tid; ++i) before += cnt[i];
        for (int i = 0; i < 16; ++i) if (mybits & (1u << i)) { if (before < 400) { lkey[before] = tid * 16 + i; ldist[before] = q - (tid * 16 + i); } ++before; }
        if (tid == 255) sh_n = (int)(before < 400 ? before : 400);
        __syncthreads(); nE = sh_n;
    } else {
        nE = 387;
        for (int e = tid; e < nE; e += 256) { const int p = e / 129, j = e % 129, dil = (p == 0) ? 1 : (p == 1 ? 4 : 16); const int k = q - j * dil; lkey[e] = k; ldist[e] = j * dil; }
        __syncthreads();
    }
    const int hoff = BRANCH * 8;
    for (int e = tid; e < nE; e += 256) {
        const int k = lkey[e];
        if (k < 0) { for (int h = 0; h < 8; ++h) pe[e][h] = -INFINITY; continue; }
        const bf16_t* kr = Kt + (rowb + k) * 512; const int bk = bucket[ldist[e]];
#pragma unroll 1
        for (int h = 0; h < 8; ++h) { float s = 0.f;
#pragma unroll 8
            for (int d = 0; d < 64; ++d) s = fmaf(qf[h * 64 + d], bf2f(kr[h * 64 + d]), s);
            pe[e][h] = s + bias2[bk * 16 + hoff + h]; }
    }
    __syncthreads();
    { const int h = tid & 7, part = tid >> 3; float m = -INFINITY; for (int e = part; e < nE; e += 32) m = fmaxf(m, pe[e][h]); red[part][h] = m; }
    __syncthreads();
    if (tid < 8) { float m = -INFINITY; for (int i = 0; i < 32; ++i) m = fmaxf(m, red[i][tid]); hm[tid] = m; }
    __syncthreads();
    { const int h = tid & 7, part = tid >> 3; float s = 0.f; for (int e = part; e < nE; e += 32) { const float p = exp2f(pe[e][h] - hm[h]); pe[e][h] = p; s += p; } red[part][h] = s; }
    __syncthreads();
    if (tid < 8) { float s = 0.f; for (int i = 0; i < 32; ++i) s += red[i][tid]; hl[tid] = s; }
    __syncthreads();
    for (int c = tid; c < 512; c += 256) { const int h = c >> 6; float o = 0.f;
#pragma unroll 4
        for (int e = 0; e < nE; ++e) { const int k = lkey[e]; if (k >= 0) o = fmaf(pe[e][h], bf2f(V[(rowb + k) * 512 + c]), o); }
        o /= hl[h]; const float z = bf2f(Z[(size_t)t * 512 + c]); const float g = z / (1.f + __expf(-z));
        MIX[(size_t)t * 1024 + BRANCH * 512 + c] = f2bf(o * g); }
}

extern "C" void kernel_launch(void* const* d_in, const int* in_sizes, int n_in, void* d_out, int out_size, void* d_ws, size_t ws_size, hipStream_t stream) {
    const float* x = (const float*)d_in[0]; const float* gain = (const float*)d_in[1]; const float* w_in = (const float*)d_in[2]; const float* w_out = (const float*)d_in[3];
    const float* rel_bias = (const float*)d_in[4]; const float* gqa = (const float*)d_in[5]; const float* gka = (const float*)d_in[6]; const float* gqb = (const float*)d_in[7]; const float* gkb = (const float*)d_in[8];
    unsigned char* ws = (unsigned char*)d_ws; float* out = (float*)d_out;
    if (ws_size < WS_END) { fprintf(stderr, "workspace too small: %zu\n", ws_size); return; }
    bf16_t* WTI = (bf16_t*)(ws + WS_WTI); bf16_t* WTO = (bf16_t*)(ws + WS_WTO); float* bias2 = (float*)(ws + WS_TAB); int* bucket = (int*)(ws + WS_TAB + 4096);
    float* RSTD = (float*)(ws + WS_RSTD); bf16_t* XB = (bf16_t*)(ws + WS_XB); bf16_t* MIX = (bf16_t*)(ws + WS_MIX);
    g_prep_w<<<2048, 256, 0, stream>>>(w_in, gain, w_out, rel_bias, WTI, WTO, bias2, bucket);
    g_prep_x<<<2048, 256, 0, stream>>>(x, XB, RSTD);
    { EpiInProj e{RSTD, ws}; g_gemm<EpiInProj><<<dim3(NPHYS / 64, M_TOK / 64), 256, 0, stream>>>(XB, WTI, 1024, e); }
    g_qknorm<<<(4 * M_TOK * 8 + 255) / 256, 256, 0, stream>>>(ws, gqa, gka, gqb, gkb);
    g_topk<<<M_TOK, 256, 0, stream>>>((const bf16_t*)(ws + WS_QI), (const bf16_t*)(ws + WS_KI), (const float*)(ws + WS_WI), (unsigned long long*)(ws + WS_GM));
    g_mask_convert<<<(BATCH * 128 * 128 * 16 + 255) / 256, 256, 0, stream>>>((const unsigned long long*)(ws + WS_GM), (unsigned long long*)(ws + WS_MASK));
    g_attn<0><<<M_TOK, 256, 0, stream>>>((const bf16_t*)(ws + WS_QA), (const bf16_t*)(ws + WS_KA), (const bf16_t*)(ws + WS_VA), (const bf16_t*)(ws + WS_ZA), (const unsigned long long*)(ws + WS_MASK), bias2, bucket, MIX);
    g_attn<1><<<M_TOK, 256, 0, stream>>>((const bf16_t*)(ws + WS_QB), (const bf16_t*)(ws + WS_KB), (const bf16_t*)(ws + WS_VB), (const bf16_t*)(ws + WS_ZB), (const unsigned long long*)(ws + WS_MASK), bias2, bucket, MIX);
    { EpiOutProj e{x, out}; g_gemm<EpiOutProj><<<dim3(1024 / 64, M_TOK / 64), 256, 0, stream>>>(MIX, WTO, 1024, e); }
}
```

```cpp
#include <hip/hip_runtime.h>
#include <stdint.h>
#include <cstdio>

typedef unsigned short bf16_t;

constexpr int D_MODEL = 1024, BATCH = 16, SEQ = 4096, M_TOK = BATCH * SEQ;
constexpr int NPHYS = 4608;
constexpr float EPS = 1e-6f;
constexpr float LOG2E = 1.4426950408889634f;
constexpr float QSCALE = 0.125f * LOG2E;
constexpr float IDX_SCALE = 0.0625f;

constexpr size_t MiB = 1u << 20;
constexpr size_t WS_CTL = 0;
constexpr size_t WS_WTI = 2 * MiB;
constexpr size_t WS_WTO = 11 * MiB;
constexpr size_t WS_TAB = 13 * MiB;
constexpr size_t WS_GTAB = WS_TAB + 32768;
constexpr size_t WS_ATAB = WS_TAB + 65536;
constexpr size_t WS_RSTD = 14 * MiB;
constexpr size_t WS_WI = 15 * MiB;
constexpr size_t WS_XB = 16 * MiB;
constexpr size_t WS_MIX = WS_XB;
constexpr size_t WS_QA = 144 * MiB, WS_KA = 208 * MiB, WS_VA = 272 * MiB, WS_ZA = 336 * MiB;
constexpr size_t WS_QB = 400 * MiB, WS_KB = 464 * MiB, WS_VB = 528 * MiB, WS_ZB = 592 * MiB;
constexpr size_t WS_QI = 656 * MiB;
constexpr size_t WS_KI = 688 * MiB;
constexpr size_t WS_MASK = 696 * MiB;
constexpr size_t WS_GM = 728 * MiB;
constexpr size_t WS_PB1 = 760 * MiB, WS_PB2 = 824 * MiB;
constexpr size_t WS_LB1 = 888 * MiB, WS_LB2 = 890 * MiB;
constexpr size_t WS_END = 892 * MiB;

__device__ __forceinline__ float bf2f(bf16_t v) { return __uint_as_float(((unsigned)v) << 16); }
__device__ __forceinline__ bf16_t f2bf(float f) { unsigned u = __float_as_uint(f); return (bf16_t)((u + 0x7fffu + ((u >> 16) & 1u)) >> 16); }

__host__ __device__ __forceinline__ int logical_of_phys(int p) { const int tile = p >> 8, pc = p & 255, bj = pc >> 7, wc = (pc >> 5) & 3, w = pc & 31; return tile * 256 + 64 * wc + 32 * bj + w; }
__host__ __device__ __forceinline__ int src_col_of_logical(int L) {
    if (L < 2048) return L;
    if (L < 4096) return 2372 + (L - 2048);
    if (L < 4352) return 2048 + (L - 4096);
    if (L < 4416) return 2304 + (L - 4352);
    if (L < 4420) return 2368 + (L - 4416);
    return -1;
}
__device__ __forceinline__ int crow(int r, int hi) { return (r & 3) + 8 * (r >> 2) + 4 * hi; }
__device__ __forceinline__ size_t mask_word_index(int b, int q, int k, int& bit) {
    const int qb = q >> 5, kb = k >> 5, kk = k & 31; const int r = (kk & 3) | ((kk >> 3) << 2), hi = (kk >> 2) & 1;
    bit = (q & 31) + 32 * hi;
    return (((size_t)b * 128 + qb) * 128 + kb) * 16 + r;
}

__global__ void g_prep_w(const float* __restrict__ w_in, const float* __restrict__ gain, const float* __restrict__ w_out, const float* __restrict__ rel_bias,
                         bf16_t* WTI, bf16_t* WTO, float* bias2, int* bucket, const float* gqa, const float* gka, const float* gqb, const float* gkb, float* gtab, float* atab) {
    const size_t gid = (size_t)blockIdx.x * blockDim.x + threadIdx.x, gsz = (size_t)gridDim.x * blockDim.x;
    for (size_t i = gid; i < (size_t)NPHYS * 1024; i += gsz) {
        const int k = (int)(i / NPHYS), p = (int)(i % NPHYS); const int src = src_col_of_logical(logical_of_phys(p));
        const float v = src >= 0 ? w_in[(size_t)k * 4420 + src] * gain[k] : 0.f;
        WTI[(size_t)p * 1024 + k] = f2bf(v);
    }
    for (size_t i = gid; i < (size_t)1024 * 1024; i += gsz) { const int k = (int)(i >> 10), n = (int)(i & 1023); WTO[(size_t)n * 1024 + k] = f2bf(w_out[(size_t)k * 1024 + n]); }
    for (size_t i = gid; i < 512; i += gsz) bias2[i] = rel_bias[i] * LOG2E;
    for (size_t i = gid; i < 256; i += gsz) { const int w = (int)(i >> 6), d = (int)(i & 63); gtab[i] = w == 0 ? gqa[d] : w == 1 ? gka[d] : w == 2 ? gqb[d] : gkb[d]; }
    for (size_t i = gid; i < 4096; i += gsz) { const int d = (int)i; int bk;
        if (d < 16) bk = d; else { const float df = (float)d; int lg = 16 + (int)(logf(df / 16.f) / logf(8.f) * 16.f); bk = lg < 31 ? lg : 31; }
        bucket[i] = bk; }
    if (gid < 32) { const int kind = (int)gid >> 3, h = (int)gid & 7, dil = kind <= 1 ? 1 : (kind == 2 ? 4 : 16), hoff = kind == 0 ? 0 : 8; float* T = atab + gid * 132;
        const float far = rel_bias[31 * 16 + hoff + h] * LOG2E; float mx = 0.f;
        for (int j = 0; j <= 128; ++j) { const int d = j * dil; int bk; if (d < 16) bk = d; else if (d >= 128) bk = 31; else { int lg = 16 + (int)(logf((float)d / 16.f) / logf(8.f) * 16.f); bk = lg < 31 ? lg : 31; }
            const float v = rel_bias[bk * 16 + hoff + h] * LOG2E - far; T[j] = v; mx = fmaxf(mx, v); }
        const float* gq = kind == 0 ? gqa : gqb; const float* gk = kind == 0 ? gka : gkb; float qm = 0.f, km = 0.f;
        for (int d = 0; d < 64; ++d) { qm = fmaxf(qm, fabsf(gq[d])); km = fmaxf(km, fabsf(gk[d])); }
        T[129] = -(64.f * QSCALE * qm * km * 1.02f + mx); T[130] = 0.f; T[131] = 0.f; }
}

__global__ __launch_bounds__(256) void g_prep_x(const float* __restrict__ x, bf16_t* XB, float* RSTD) {
    const int wave = (blockIdx.x * 256 + threadIdx.x) >> 6, lane = threadIdx.x & 63, nw = (gridDim.x * 256) >> 6;
    for (int m = wave; m < M_TOK; m += nw) {
        const float4* xr = (const float4*)(x + (size_t)m * 1024) + lane; float4 v[4]; float s = 0.f;
#pragma unroll
        for (int j = 0; j < 4; ++j) { v[j] = xr[64 * j]; s += v[j].x * v[j].x + v[j].y * v[j].y + v[j].z * v[j].z + v[j].w * v[j].w; }
#pragma unroll
        for (int o = 1; o < 64; o <<= 1) s += __shfl_xor(s, o);
        if (lane == 0) RSTD[m] = rsqrtf(s * (1.f / 1024.f) + EPS);
        uint2* o2 = (uint2*)(XB + (size_t)m * 1024) + lane;
#pragma unroll
        for (int j = 0; j < 4; ++j) { uint2 w; w.x = f2bf(v[j].x) | ((unsigned)f2bf(v[j].y) << 16); w.y = f2bf(v[j].z) | ((unsigned)f2bf(v[j].w) << 16); o2[64 * j] = w; }
    }
}

struct EpiInProj {
    const float* rstd; unsigned char* ws;
    __device__ __forceinline__ void operator()(int m, int p, float v) const {
        const int L = logical_of_phys(p); v *= rstd[m];
        if (L < 2048) { bf16_t* base = (bf16_t*)(ws + WS_QA + (size_t)(L >> 9) * 64 * MiB); base[(size_t)m * 512 + (L & 511)] = f2bf(v); }
        else if (L < 4096) { const int l2 = L - 2048; bf16_t* base = (bf16_t*)(ws + WS_QB + (size_t)(l2 >> 9) * 64 * MiB); base[(size_t)m * 512 + (l2 & 511)] = f2bf(v); }
        else if (L < 4352) ((bf16_t*)(ws + WS_QI))[(size_t)m * 256 + (L - 4096)] = f2bf(v);
        else if (L < 4416) ((bf16_t*)(ws + WS_KI))[(size_t)m * 64 + (L - 4352)] = f2bf(v);
        else if (L < 4420) ((float*)(ws + WS_WI))[(size_t)m * 4 + (L - 4416)] = v * IDX_SCALE;
    }
};
struct EpiOutProj {
    const float* x; float* out;
    __device__ __forceinline__ void operator()(int m, int n, float v) const { out[(size_t)m * 1024 + n] = x[(size_t)m * 1024 + n] + v; }
};

template <class Epi> __global__ __launch_bounds__(256) void g_gemm(const bf16_t* __restrict__ A, const bf16_t* __restrict__ B, int K, Epi epi) {
    __shared__ float As[16][68], Bs[16][68];
    const int tid = threadIdx.x, tx = tid & 15, ty = tid >> 4, m0 = blockIdx.y * 64, n0 = blockIdx.x * 64, lr = tid >> 2, lk = (tid & 3) * 4;
    float acc[4][4];
#pragma unroll
    for (int i = 0; i < 4; ++i)
#pragma unroll
        for (int j = 0; j < 4; ++j) acc[i][j] = 0.f;
    const bf16_t* ap = A + (size_t)(m0 + lr) * K + lk; const bf16_t* bp = B + (size_t)(n0 + lr) * K + lk;
    for (int k0 = 0; k0 < K; k0 += 16) {
        const uint2 a = *(const uint2*)(ap + k0), b = *(const uint2*)(bp + k0);
        As[lk + 0][lr] = __uint_as_float(a.x << 16); As[lk + 1][lr] = __uint_as_float(a.x & 0xffff0000u); As[lk + 2][lr] = __uint_as_float(a.y << 16); As[lk + 3][lr] = __uint_as_float(a.y & 0xffff0000u);
        Bs[lk + 0][lr] = __uint_as_float(b.x << 16); Bs[lk + 1][lr] = __uint_as_float(b.x & 0xffff0000u); Bs[lk + 2][lr] = __uint_as_float(b.y << 16); Bs[lk + 3][lr] = __uint_as_float(b.y & 0xffff0000u);
        __syncthreads();
#pragma unroll
        for (int kk = 0; kk < 16; ++kk) {
            const float4 av = *(const float4*)&As[kk][ty * 4], bv = *(const float4*)&Bs[kk][tx * 4];
            const float a4[4] = {av.x, av.y, av.z, av.w}, b4[4] = {bv.x, bv.y, bv.z, bv.w};
#pragma unroll
            for (int i = 0; i < 4; ++i)
#pragma unroll
                for (int j = 0; j < 4; ++j) acc[i][j] = fmaf(a4[i], b4[j], acc[i][j]);
        }
        __syncthreads();
    }
#pragma unroll
    for (int i = 0; i < 4; ++i)
#pragma unroll
        for (int j = 0; j < 4; ++j) epi(m0 + ty * 4 + i, n0 + tx * 4 + j, acc[i][j]);
}

__global__ __launch_bounds__(256) void g_qknorm(unsigned char* ws, const float* __restrict__ gqa, const float* __restrict__ gka, const float* __restrict__ gqb, const float* __restrict__ gkb) {
    const size_t gid = (size_t)blockIdx.x * 256 + threadIdx.x;
    if (gid >= (size_t)4 * M_TOK * 8) return;
    const int which = (int)(gid / ((size_t)M_TOK * 8)); const size_t rem = gid % ((size_t)M_TOK * 8);
    const size_t off = which == 0 ? WS_QA : which == 1 ? WS_KA : which == 2 ? WS_QB : WS_KB; const float* g = which == 0 ? gqa : which == 1 ? gka : which == 2 ? gqb : gkb;
    bf16_t* p = (bf16_t*)(ws + off) + rem * 64; const float sc = (which == 0 || which == 2) ? QSCALE : 1.f;
    float v[64]; float s = 0.f;
#pragma unroll
    for (int i = 0; i < 64; ++i) { v[i] = bf2f(p[i]); s += v[i] * v[i]; }
    const float r = rsqrtf(s * (1.f / 64.f) + EPS) * sc;
#pragma unroll
    for (int i = 0; i < 64; ++i) p[i] = f2bf(v[i] * r * g[i]);
}

__device__ __forceinline__ unsigned mono_key(float s) { const unsigned u = __float_as_uint(s); return (u & 0x80000000u) ? ~u : (u | 0x80000000u); }

__global__ __launch_bounds__(256) void g_topk(const bf16_t* __restrict__ QI, const bf16_t* __restrict__ KI, const float* __restrict__ WI, unsigned long long* GM) {
    __shared__ float sc[4096]; __shared__ float qs[256]; __shared__ unsigned hist[256]; __shared__ unsigned sh_prefix, sh_need; __shared__ unsigned cnt[256]; __shared__ unsigned short bits16[256];
    const int t = blockIdx.x, b = t / SEQ, q = t % SEQ, n = q + 1, tid = threadIdx.x;
    qs[tid] = bf2f(QI[(size_t)t * 256 + tid]);
    float w[4];
#pragma unroll
    for (int h = 0; h < 4; ++h) w[h] = WI[(size_t)t * 4 + h];
    __syncthreads();
    for (int k = tid; k < n; k += 256) {
        const bf16_t* kr = KI + ((size_t)b * SEQ + k) * 64; float r[4] = {0.f, 0.f, 0.f, 0.f};
#pragma unroll 8
        for (int d = 0; d < 64; ++d) { const float kv = bf2f(kr[d]);
#pragma unroll
            for (int h = 0; h < 4; ++h) r[h] = fmaf(qs[h * 64 + d], kv, r[h]); }
        float s = 0.f;
#pragma unroll
        for (int h = 0; h < 4; ++h) s = fmaf(w[h], fmaxf(r[h], 0.f), s);
        sc[k] = s;
    }
    __syncthreads();
    unsigned T = 0u, need = 0u; bool all = (n <= 256);
    if (!all) {
        if (tid == 0) { sh_prefix = 0u; sh_need = 256u; }
        for (int pass = 3; pass >= 0; --pass) {
            const int shift = pass * 8; hist[tid] = 0u; __syncthreads();
            const unsigned prefix = sh_prefix, himask = (pass == 3) ? 0u : (0xffffffffu << (shift + 8));
            for (int k = tid; k < n; k += 256) { const unsigned key = mono_key(sc[k]); if ((key & himask) == prefix) atomicAdd(&hist[(key >> shift) & 255u], 1u); }
            __syncthreads();
            if (tid == 0) { unsigned nd = sh_need, cum = 0u; int d = 255; for (; d > 0; --d) { if (cum + hist[d] >= nd) break; cum += hist[d]; } sh_need = nd - cum; sh_prefix = prefix | ((unsigned)d << shift); }
            __syncthreads();
        }
        T = sh_prefix; need = sh_need;
    }
    unsigned myties = 0u;
    if (!all) for (int i = 0; i < 16; ++i) { const int k = tid * 16 + i; if (k < n && mono_key(sc[k]) == T) ++myties; }
    cnt[tid] = myties; __syncthreads();
    unsigned before = 0u; for (int i = 0; i < tid; ++i) before += cnt[i];
    unsigned short bits = 0;
    for (int i = 0; i < 16; ++i) { const int k = tid * 16 + i; if (k >= n) break; bool sel;
        if (all) sel = true; else { const unsigned key = mono_key(sc[k]); if (key > T) sel = true; else if (key == T) { sel = before < need; ++before; } else sel = false; }
        if (sel) bits |= (unsigned short)(1u << i); }
    bits16[tid] = bits; __syncthreads();
    if (tid < 64) { unsigned long long w64 = 0ull; for (int i = 0; i < 4; ++i) w64 |= (unsigned long long)bits16[tid * 4 + i] << (16 * i); GM[(size_t)t * 64 + tid] = w64; }
}

__global__ __launch_bounds__(256) void g_mask_convert(const unsigned long long* __restrict__ GM, unsigned long long* MASK) {
    const size_t gid = (size_t)blockIdx.x * 256 + threadIdx.x;
    if (gid >= (size_t)BATCH * 128 * 128 * 16) return;
    const int r = (int)(gid & 15), kb = (int)((gid >> 4) & 127), qb = (int)((gid >> 11) & 127), b = (int)(gid >> 18);
    unsigned long long w = 0ull;
    if (kb <= qb) for (int l = 0; l < 64; ++l) { const int q = qb * 32 + (l & 31), k = kb * 32 + crow(r, l >> 5); const unsigned long long g = GM[((size_t)b * SEQ + q) * 64 + (k >> 6)]; w |= ((g >> (k & 63)) & 1ull) << l; }
    MASK[gid] = w;
}

template <int BRANCH> __global__ __launch_bounds__(256) void g_attn(const bf16_t* __restrict__ Q, const bf16_t* __restrict__ Kt, const bf16_t* __restrict__ V, const bf16_t* __restrict__ Z,
                                                                     const unsigned long long* __restrict__ MASK, const float* __restrict__ bias2, const int* __restrict__ bucket, bf16_t* MIX) {
    __shared__ float qf[512]; __shared__ int lkey[400]; __shared__ int ldist[400]; __shared__ float pe[400][8]; __shared__ float red[32][8]; __shared__ float hm[8], hl[8]; __shared__ unsigned cnt[256]; __shared__ int sh_n;
    const int t = blockIdx.x, b = t / SEQ, q = t % SEQ, tid = threadIdx.x; const size_t rowb = (size_t)b * SEQ;
    qf[tid] = bf2f(Q[(size_t)t * 512 + tid]); qf[tid + 256] = bf2f(Q[(size_t)t * 512 + 256 + tid]);
    int nE;
    if (BRANCH == 0) {
        unsigned mybits = 0u; unsigned c = 0u;
        for (int i = 0; i < 16; ++i) { const int k = tid * 16 + i; if (k <= q) { int bit; const size_t wi = mask_word_index(b, q, k, bit); if ((MASK[wi] >> bit) & 1ull) { mybits |= 1u << i; ++c; } } }
        cnt[tid] = c; __syncthreads();
        unsigned before = 0u; for (int i = 0; i < tid; ++i) before += cnt[i];
        for (int i = 0; i < 16; ++i) if (mybits & (1u << i)) { if (before < 400) { lkey[before] = tid * 16 + i; ldist[before] = q - (tid * 16 + i); } ++before; }
        if (tid == 255) sh_n = (int)(before < 400 ? before : 400);
        __syncthreads(); nE = sh_n;
    } else {
        nE = 387;
        for (int e = tid; e < nE; e += 256) { const int p = e / 129, j = e % 129, dil = (p == 0) ? 1 : (p == 1 ? 4 : 16); const int k = q - j * dil; lkey[e] = k; ldist[e] = j * dil; }
        __syncthreads();
    }
    const int hoff = BRANCH * 8;
    for (int e = tid; e < nE; e += 256) {
        const int k = lkey[e];
        if (k < 0) { for (int h = 0; h < 8; ++h) pe[e][h] = -INFINITY; continue; }
        const bf16_t* kr = Kt + (rowb + k) * 512; const int bk = bucket[ldist[e]];
#pragma unroll 1
        for (int h = 0; h < 8; ++h) { float s = 0.f;
#pragma unroll 8
            for (int d = 0; d < 64; ++d) s = fmaf(qf[h * 64 + d], bf2f(kr[h * 64 + d]), s);
            pe[e][h] = s + bias2[bk * 16 + hoff + h]; }
    }
    __syncthreads();
    { const int h = tid & 7, part = tid >> 3; float m = -INFINITY; for (int e = part; e < nE; e += 32) m = fmaxf(m, pe[e][h]); red[part][h] = m; }
    __syncthreads();
    if (tid < 8) { float m = -INFINITY; for (int i = 0; i < 32; ++i) m = fmaxf(m, red[i][tid]); hm[tid] = m; }
    __syncthreads();
    { const int h = tid & 7, part = tid >> 3; float s = 0.f; for (int e = part; e < nE; e += 32) { const float p = exp2f(pe[e][h] - hm[h]); pe[e][h] = p; s += p; } red[part][h] = s; }
    __syncthreads();
    if (tid < 8) { float s = 0.f; for (int i = 0; i < 32; ++i) s += red[i][tid]; hl[tid] = s; }
    __syncthreads();
    for (int c = tid; c < 512; c += 256) { const int h = c >> 6; float o = 0.f;
#pragma unroll 4
        for (int e = 0; e < nE; ++e) { const int k = lkey[e]; if (k >= 0) o = fmaf(pe[e][h], bf2f(V[(rowb + k) * 512 + c]), o); }
        o /= hl[h]; const float z = bf2f(Z[(size_t)t * 512 + c]); const float g = z / (1.f + __expf(-z));
        MIX[(size_t)t * 1024 + BRANCH * 512 + c] = f2bf(o * g); }
}

namespace pg8 {
#define PG8_LAS __attribute__((address_space(3)))
typedef unsigned short bf16_t;
typedef short bf16x8 __attribute__((ext_vector_type(8)));
typedef float f32x4 __attribute__((ext_vector_type(4)));
typedef unsigned u32x4 __attribute__((ext_vector_type(4)));
constexpr int BM = 256, BK = 64, HALF = 128, HTB = HALF * BK * 2  , STAGE_BYTES = 8 * HTB, NXCD = 8, WGM = 8;

__host__ __device__ __forceinline__ int lds_byte(int r, int c) { const int st = (r >> 4) * 2 + (c >> 5), rr = r & 15, cc = c & 31, ob = rr * 64 + cc * 2; return st * 1024 + (ob ^ (((ob >> 9) & 1) << 5)); }
__host__ __device__ __forceinline__ void stage_rc(int b, int& R, int& C) { const int st = b / 1024, sb = b % 1024, swz = sb ^ (((sb >> 9) & 1) << 5); R = (st >> 1) * 16 + swz / 64; C = (st & 1) * 32 + (swz % 64) / 2; }
__host__ __device__ __forceinline__ int perm32(int rho) { const int n = rho >> 4, i = rho & 15; return 8 * (i >> 2) + 4 * n + (i & 3); }

struct Unit { int pm, pn; };
struct Gemm { const bf16_t* A; const bf16_t* Bt; int M, N, K; };

struct StaticOrder {
    int nM, nN, nwg, G, c;
    __host__ __device__ void init(int M, int N, int G_, int c_) { nM = M / BM; nN = N / BM; nwg = nM * nN; G = G_; c = c_; }
    __host__ __device__ bool next(int i, Unit& u) const {
        const long L = (long)i * G + c; if (L >= nwg) return false;
        int wgid = (int)L; { const int q = nwg / NXCD, r = nwg % NXCD, xcd = wgid % NXCD, off = wgid / NXCD; wgid = (xcd < r ? xcd * (q + 1) : r * (q + 1) + (xcd - r) * q) + off; }
        const int nig = WGM * nN, gid = wgid / nig, fm = gid * WGM, gsz = (nM - fm) < WGM ? (nM - fm) : WGM;
        u.pm = fm + ((wgid % nig) % gsz); u.pn = (wgid % nig) / gsz; return true;
    }
    __device__ __forceinline__ void a_ready(const Unit&) const {}
    __device__ __forceinline__ void done(const Unit&) const {}
};
__device__ __forceinline__ unsigned cvt_pk_bf16(float lo, float hi) { unsigned r; asm volatile("v_cvt_pk_bf16_f32 %0, %1, %2" : "=v"(r) : "v"(lo), "v"(hi)); return r; }
typedef float f32x2 __attribute__((ext_vector_type(2)));
template <class Epi, class Sched, bool ALIGN_EPI = false, bool SP2 = false>
__device__ __forceinline__ void gemm_phase(PG8_LAS unsigned char* lds, const Gemm g, const Sched& S, const Epi& E) {
    const int tid = threadIdx.x, wid = __builtin_amdgcn_readfirstlane(tid >> 6), lane = tid & 63, wr = wid >> 2, wc = wid & 3, fr = lane & 15, fq = lane >> 4;
    const int K = g.K, nt = K / BK;
    unsigned voffA[2], voffB[2];
#pragma unroll
    for (int i = 0; i < 2; ++i) { int R, C; stage_rc(tid * 16 + i * 8192, R, C); const int Rb = Epi::PERM ? ((R & ~31) + perm32(R & 31)) : R;
        voffA[i] = (unsigned)(R * K + C) * 2u; voffB[i] = (unsigned)(Rb * K + C) * 2u; }
    const size_t kstep = (size_t)(BK * 2);
    const size_t hstep = (size_t)HALF * K * 2;
    const size_t tstep = 2 * hstep;
    const unsigned ldsw = (unsigned)wid * 1024u;
    const int aoff = lds_byte(wr * 64 + fr, fq * 8), boff = lds_byte(wc * 32 + fr, fq * 8);
#define PG8_SA(b, h) (((b) * 2 + (h)) * HTB)
#define PG8_SB(b, h) ((4 + (b) * 2 + (h)) * HTB)
#define PG8_STAGE(bufoff, gbase, voff) do { _Pragma("unroll") for (int _i = 0; _i < 2; ++_i) \
        __builtin_amdgcn_global_load_lds((const unsigned*)((const char*)(gbase) + (voff)[_i]), (PG8_LAS unsigned*)(lds + (bufoff) + ldsw + _i * 8192), 16, 0, 0); } while (0)
#define PG8_LDA(dst, b, h) do { _Pragma("unroll") for (int m = 0; m < 4; ++m) _Pragma("unroll") for (int k = 0; k < 2; ++k) dst[m][k] = *(const PG8_LAS bf16x8*)(lds + PG8_SA(b, h) + aoff + m * 2048 + k * 1024); } while (0)
#define PG8_LDB(dst, b, h) do { _Pragma("unroll") for (int n = 0; n < 2; ++n) _Pragma("unroll") for (int k = 0; k < 2; ++k) dst[n][k] = *(const PG8_LAS bf16x8*)(lds + PG8_SB(b, h) + boff + n * 2048 + k * 1024); } while (0)
#define PG8_MMA(ai, bj, At, Bt) do { __builtin_amdgcn_s_setprio(1); _Pragma("unroll") for (int m = 0; m < 4; ++m) _Pragma("unroll") for (int n = 0; n < 2; ++n) _Pragma("unroll") for (int k = 0; k < 2; ++k) \
        acc[ai][bj][m][n] = __builtin_amdgcn_mfma_f32_16x16x32_bf16(Bt[n][k], At[m][k], acc[ai][bj][m][n], 0, 0, 0); __builtin_amdgcn_s_setprio(0); } while (0)
#define PG8_WAIT_V(n) asm volatile("s_waitcnt vmcnt(" #n ")" ::: "memory")
#define PG8_WAIT_L(n) asm volatile("s_waitcnt lgkmcnt(" #n ")" ::: "memory")
#define PG8_BAR __builtin_amdgcn_s_barrier()
#define PG8_SCHED __builtin_amdgcn_sched_barrier(0)
    Unit cur, nxt; int ui = 0;
    if (!S.next(0, cur)) return;
    f32x4 acc[2][2][4][2];
#pragma unroll
    for (int a = 0; a < 2; ++a)
#pragma unroll
        for (int b = 0; b < 2; ++b)
#pragma unroll
            for (int m = 0; m < 4; ++m)
#pragma unroll
                for (int n = 0; n < 2; ++n) acc[a][b][m][n] = (f32x4){0.f, 0.f, 0.f, 0.f};
    bf16x8 At[4][2], B0[2][2], B1[2][2];
    const char* cA = (const char*)g.A + (size_t)cur.pm * tstep; const char* cB = (const char*)g.Bt + (size_t)cur.pn * tstep;
    S.a_ready(cur);
    if constexpr (SP2) {
        PG8_STAGE(PG8_SB(0, 0), cB, voffB); PG8_STAGE(PG8_SB(0, 1), cB + hstep, voffB); PG8_STAGE(PG8_SA(0, 0), cA, voffA); PG8_STAGE(PG8_SA(0, 1), cA + hstep, voffA);
        if (wr == 1) PG8_BAR;
        PG8_WAIT_V(2); PG8_BAR;
        PG8_STAGE(PG8_SB(1, 0), cB + kstep, voffB); PG8_STAGE(PG8_SA(1, 0), cA + kstep, voffA); PG8_STAGE(PG8_SB(1, 1), cB + hstep + kstep, voffB);
        PG8_WAIT_V(6); PG8_BAR;
    } else {
        PG8_STAGE(PG8_SB(0, 0), cB, voffB); PG8_STAGE(PG8_SA(0, 0), cA, voffA); PG8_STAGE(PG8_SB(0, 1), cB + hstep, voffB); PG8_STAGE(PG8_SA(0, 1), cA + hstep, voffA);
        if (wr == 1) PG8_BAR;
        PG8_WAIT_V(4); PG8_BAR;
        PG8_STAGE(PG8_SB(1, 0), cB + kstep, voffB); PG8_STAGE(PG8_SA(1, 0), cA + kstep, voffA); PG8_STAGE(PG8_SB(1, 1), cB + hstep + kstep, voffB);
        PG8_WAIT_V(6); PG8_BAR;
    }
    for (;;) {
        const bool has_next = S.next(ui + 1, nxt);
        const char* nA = has_next ? (const char*)g.A + (size_t)nxt.pm * tstep : cA; const char* nB = has_next ? (const char*)g.Bt + (size_t)nxt.pn * tstep : cB;
        for (int t = 0; t < nt; t += 2) {
            const bool last = (t == nt - 2);
            const char* a1 = cA + (size_t)(t + 1) * kstep;
            const char* a2 = last ? nA : cA + (size_t)(t + 2) * kstep; const char* b2 = last ? nB : cB + (size_t)(t + 2) * kstep;
            const char* a3 = a2 + kstep; const char* b3 = b2 + kstep;
            if (last && has_next) S.a_ready(nxt);
            if constexpr (SP2) {
            PG8_LDB(B0, 0, 0); PG8_LDB(B1, 0, 1); PG8_SCHED; PG8_LDA(At, 0, 0); PG8_STAGE(PG8_SA(1, 1), a1 + hstep, voffA);
            PG8_WAIT_V(8); PG8_WAIT_L(0); PG8_BAR; PG8_MMA(0, 0, At, B0); PG8_MMA(0, 1, At, B1); PG8_BAR; PG8_SCHED;
            PG8_LDA(At, 0, 1); PG8_STAGE(PG8_SB(0, 0), b2, voffB); PG8_STAGE(PG8_SB(0, 1), b2 + hstep, voffB); PG8_STAGE(PG8_SA(0, 0), a2, voffA);
            PG8_WAIT_V(8); PG8_WAIT_L(0); PG8_BAR; PG8_MMA(1, 0, At, B0); PG8_MMA(1, 1, At, B1); PG8_BAR; PG8_SCHED;
            PG8_LDB(B0, 1, 0); PG8_LDB(B1, 1, 1); PG8_SCHED; PG8_LDA(At, 1, 0); PG8_STAGE(PG8_SA(0, 1), a2 + hstep, voffA);
            PG8_WAIT_V(8); PG8_WAIT_L(0); PG8_BAR; PG8_MMA(0, 0, At, B0); PG8_MMA(0, 1, At, B1); PG8_BAR; PG8_SCHED;
            PG8_LDA(At, 1, 1); PG8_STAGE(PG8_SB(1, 0), b3, voffB); PG8_STAGE(PG8_SB(1, 1), b3 + hstep, voffB); PG8_STAGE(PG8_SA(1, 0), a3, voffA);
            PG8_WAIT_V(8); PG8_WAIT_L(0); PG8_BAR; PG8_MMA(1, 0, At, B0); PG8_MMA(1, 1, At, B1); PG8_BAR; PG8_SCHED;
            } else {
            PG8_LDB(B0, 0, 0); PG8_SCHED; PG8_LDA(At, 0, 0); PG8_STAGE(PG8_SA(1, 1), a1 + hstep, voffA);
            PG8_WAIT_L(8); PG8_BAR; PG8_WAIT_L(0); PG8_MMA(0, 0, At, B0); PG8_BAR; PG8_SCHED;
            PG8_LDB(B1, 0, 1); PG8_STAGE(PG8_SB(0, 0), b2, voffB);
            PG8_BAR; PG8_WAIT_L(0); PG8_MMA(0, 1, At, B1); PG8_BAR;
            PG8_LDA(At, 0, 1); PG8_STAGE(PG8_SA(0, 0), a2, voffA);
            PG8_BAR; PG8_WAIT_L(0); PG8_MMA(1, 0, At, B0); PG8_BAR; PG8_SCHED;
            PG8_STAGE(PG8_SB(0, 1), b2 + hstep, voffB);
            PG8_WAIT_V(6); PG8_BAR; PG8_MMA(1, 1, At, B1); PG8_BAR;
            PG8_LDB(B0, 1, 0); PG8_SCHED; PG8_LDA(At, 1, 0); PG8_STAGE(PG8_SA(0, 1), a2 + hstep, voffA);
            PG8_WAIT_L(8); PG8_BAR; PG8_WAIT_L(0); PG8_MMA(0, 0, At, B0); PG8_BAR; PG8_SCHED;
            PG8_LDB(B1, 1, 1); PG8_STAGE(PG8_SB(1, 0), b3, voffB);
            PG8_BAR; PG8_WAIT_L(0); PG8_MMA(0, 1, At, B1); PG8_BAR;
            PG8_LDA(At, 1, 1); PG8_STAGE(PG8_SA(1, 0), a3, voffA);
            PG8_BAR; PG8_WAIT_L(0); PG8_MMA(1, 0, At, B0); PG8_BAR; PG8_SCHED;
            PG8_STAGE(PG8_SB(1, 1), b3 + hstep, voffB);
            PG8_WAIT_V(6); PG8_BAR; PG8_MMA(1, 1, At, B1); PG8_BAR;
            }
        }
        if constexpr (ALIGN_EPI) { if (wr == 0) PG8_BAR; }
        if constexpr (!Epi::AFTER_DRAIN) { E(acc, cur, wr, wc, fr, fq); S.done(cur); }
        if (!has_next) break;
#pragma unroll
        for (int a = 0; a < 2; ++a)
#pragma unroll
            for (int b = 0; b < 2; ++b)
#pragma unroll
                for (int m = 0; m < 4; ++m)
#pragma unroll
                    for (int n = 0; n < 2; ++n) acc[a][b][m][n] = (f32x4){0.f, 0.f, 0.f, 0.f};
        cur = nxt; cA = nA; cB = nB; ++ui;
        if constexpr (ALIGN_EPI) { if (wr == 1) PG8_BAR; }
    }
    PG8_WAIT_V(0);
    if constexpr (!ALIGN_EPI) { if (wr == 0) PG8_BAR; }
    PG8_BAR;
    if constexpr (Epi::AFTER_DRAIN) { E.fused(acc, cur, wr, wc, fr, fq, lds, wid, lane); S.done(cur); }
#undef PG8_SA
#undef PG8_SB
#undef PG8_STAGE
#undef PG8_LDA
#undef PG8_LDB
#undef PG8_MMA
#undef PG8_WAIT_V
#undef PG8_WAIT_L
#undef PG8_BAR
#undef PG8_SCHED
}
}
namespace pg8 {
struct EpiIn {
    static constexpr bool PERM = true, AFTER_DRAIN = false;
    unsigned char* ws; const float* rstd; const float* gtab;
    __device__ __forceinline__ void operator()(const f32x4 (&acc)[2][2][4][2], const Unit& u, int wr, int wc, int fr, int fq) const {
        const int pn = u.pn; const int row0 = u.pm * BM + wr * 64 + fr;
        const float* rsp = rstd + row0;
#define RS(ai, m) (rsp[(ai) * HALF + (m) * 16])
        if (pn < 16) {
            const int grp = pn >> 1;
            bf16_t* base = (bf16_t*)(ws + WS_QA + (size_t)grp * 64 * MiB) + (pn & 1) * 256 + wc * 64 + 8 * fq;
            if ((grp & 3) < 2) {
                const float* g = gtab + ((grp >> 2) * 2 + (grp & 1)) * 64; const float sc = (grp & 3) == 0 ? QSCALE : 1.f;
                f32x4 gv[2][2];
#pragma unroll
                for (int bj = 0; bj < 2; ++bj)
#pragma unroll
                    for (int n = 0; n < 2; ++n) gv[bj][n] = *(const f32x4*)(g + 32 * bj + 8 * fq + 4 * n);
#pragma unroll
                for (int ai = 0; ai < 2; ++ai)
#pragma unroll
                    for (int m = 0; m < 4; ++m) {
                        const float r_ = RS(ai, m); f32x4 y[2][2]; float ss = 0.f;
#pragma unroll
                        for (int bj = 0; bj < 2; ++bj)
#pragma unroll
                            for (int n = 0; n < 2; ++n) { y[bj][n] = acc[ai][bj][m][n] * r_; ss += (y[bj][n][0] * y[bj][n][0] + y[bj][n][1] * y[bj][n][1]) + (y[bj][n][2] * y[bj][n][2] + y[bj][n][3] * y[bj][n][3]); }
                        ss += __shfl_xor(ss, 16); ss += __shfl_xor(ss, 32);
                        const float rn = rsqrtf(ss * (1.f / 64.f) + EPS) * sc;
                        bf16_t* rowp = base + (size_t)(row0 + ai * HALF + m * 16) * 512;
#pragma unroll
                        for (int bj = 0; bj < 2; ++bj) { const f32x4 v0 = y[bj][0] * rn * gv[bj][0], v1 = y[bj][1] * rn * gv[bj][1];
                            u32x4 w; w.x = cvt_pk_bf16(v0[0], v0[1]); w.y = cvt_pk_bf16(v0[2], v0[3]); w.z = cvt_pk_bf16(v1[0], v1[1]); w.w = cvt_pk_bf16(v1[2], v1[3]);
                            *(u32x4*)(rowp + 32 * bj) = w; }
                        asm volatile("" ::: "memory");
                    }
            } else {
#pragma unroll
                for (int ai = 0; ai < 2; ++ai)
#pragma unroll
                    for (int m = 0; m < 4; ++m) { const float r_ = RS(ai, m); bf16_t* rowp = base + (size_t)(row0 + ai * HALF + m * 16) * 512;
#pragma unroll
                        for (int bj = 0; bj < 2; ++bj) { const f32x4 v0 = acc[ai][bj][m][0] * r_, v1 = acc[ai][bj][m][1] * r_;
                            u32x4 w; w.x = cvt_pk_bf16(v0[0], v0[1]); w.y = cvt_pk_bf16(v0[2], v0[3]); w.z = cvt_pk_bf16(v1[0], v1[1]); w.w = cvt_pk_bf16(v1[2], v1[3]);
                            *(u32x4*)(rowp + 32 * bj) = w; } }
            }
        } else if (pn == 16) {
            bf16_t* base = (bf16_t*)(ws + WS_QI) + wc * 64 + 8 * fq;
#pragma unroll
            for (int ai = 0; ai < 2; ++ai)
#pragma unroll
                for (int m = 0; m < 4; ++m) { const float r_ = RS(ai, m); bf16_t* rowp = base + (size_t)(row0 + ai * HALF + m * 16) * 256;
#pragma unroll
                    for (int bj = 0; bj < 2; ++bj) { const f32x4 v0 = acc[ai][bj][m][0] * r_, v1 = acc[ai][bj][m][1] * r_;
                        u32x4 w; w.x = cvt_pk_bf16(v0[0], v0[1]); w.y = cvt_pk_bf16(v0[2], v0[3]); w.z = cvt_pk_bf16(v1[0], v1[1]); w.w = cvt_pk_bf16(v1[2], v1[3]);
                        *(u32x4*)(rowp + 32 * bj) = w; } }
        } else {
            if (wc == 0) {
                bf16_t* base = (bf16_t*)(ws + WS_KI) + 8 * fq;
#pragma unroll
                for (int ai = 0; ai < 2; ++ai)
#pragma unroll
                    for (int m = 0; m < 4; ++m) { const float r_ = RS(ai, m); bf16_t* rowp = base + (size_t)(row0 + ai * HALF + m * 16) * 64;
#pragma unroll
                        for (int bj = 0; bj < 2; ++bj) { const f32x4 v0 = acc[ai][bj][m][0] * r_, v1 = acc[ai][bj][m][1] * r_;
                            u32x4 w; w.x = cvt_pk_bf16(v0[0], v0[1]); w.y = cvt_pk_bf16(v0[2], v0[3]); w.z = cvt_pk_bf16(v1[0], v1[1]); w.w = cvt_pk_bf16(v1[2], v1[3]);
                            *(u32x4*)(rowp + 32 * bj) = w; } }
            } else if (wc == 1) {
                if (fq == 0) {
                    float* wi = (float*)(ws + WS_WI);
#pragma unroll
                    for (int ai = 0; ai < 2; ++ai)
#pragma unroll
                        for (int m = 0; m < 4; ++m) *(f32x4*)(wi + (size_t)(row0 + ai * HALF + m * 16) * 4) = acc[ai][0][m][0] * (RS(ai, m) * IDX_SCALE);
                }
            }
        }
    }
};
#undef RS
struct EpiOut {
    static constexpr bool PERM = false, AFTER_DRAIN = false;
    const float* x; float* out;
    __device__ __forceinline__ void operator()(const f32x4 (&acc)[2][2][4][2], const Unit& u, int wr, int wc, int fr, int fq) const {
        const int row0 = u.pm * BM + wr * 64 + fr, col0 = u.pn * BM + wc * 32 + 4 * fq;
#pragma unroll
        for (int ai = 0; ai < 2; ++ai)
#pragma unroll
            for (int m = 0; m < 4; ++m) { const size_t off = (size_t)(row0 + ai * HALF + m * 16) * 1024 + col0;
#pragma unroll
                for (int bj = 0; bj < 2; ++bj)
#pragma unroll
                    for (int n = 0; n < 2; ++n) { const f32x4 bs = *(const f32x4*)(x + off + bj * HALF + n * 16); *(f32x4*)(out + off + bj * HALF + n * 16) = bs + acc[ai][bj][m][n]; } }
    }
};
}

constexpr int GEMM_LDS = 131072;
__global__ __launch_bounds__(512, 2) void k_gemm_in(unsigned char* ws) {
    extern __shared__ __attribute__((aligned(16))) unsigned char smem[];
    pg8::Gemm g{(const bf16_t*)(ws + WS_XB), (const bf16_t*)(ws + WS_WTI), M_TOK, NPHYS, 1024}; pg8::StaticOrder S; S.init(M_TOK, NPHYS, gridDim.x, blockIdx.x);
    pg8::EpiIn E{ws, (const float*)(ws + WS_RSTD), (const float*)(ws + WS_GTAB)};
    pg8::gemm_phase<pg8::EpiIn, pg8::StaticOrder, true, true>((PG8_LAS unsigned char*)smem, g, S, E);
}
__global__ __launch_bounds__(512, 2) void k_gemm_out(unsigned char* ws, const float* x, float* out) {
    extern __shared__ __attribute__((aligned(16))) unsigned char smem[];
    pg8::Gemm g{(const bf16_t*)(ws + WS_MIX), (const bf16_t*)(ws + WS_WTO), M_TOK, 1024, 1024}; pg8::StaticOrder S; S.init(M_TOK, 1024, gridDim.x, blockIdx.x);
    pg8::EpiOut E{x, out};
    pg8::gemm_phase<pg8::EpiOut, pg8::StaticOrder, true, true>((PG8_LAS unsigned char*)smem, g, S, E);
}
namespace att {
using bf16x8 = __attribute__((ext_vector_type(8))) short;
using s16x4 = __attribute__((ext_vector_type(4))) short;
using f32x16 = __attribute__((ext_vector_type(16))) float;
using u32x4 = __attribute__((ext_vector_type(4))) unsigned;
using f32x4 = __attribute__((ext_vector_type(4))) float;
#define ALDS __attribute__((address_space(3)))
typedef ALDS const char* lds_cptr;
typedef ALDS unsigned char* lds_ptr;
typedef const __attribute__((address_space(4))) unsigned long long* cmask_ptr;
constexpr int SLOTB = 8192;
constexpr int LDS_K = 0, LDS_V = 3 * SLOTB, LDS_TAB = 6 * SLOTB, LDS_WS = LDS_TAB + 1024, LDS_OST = LDS_WS + 2048, LDS_BYTES = LDS_OST + 8 * 8192;
constexpr int TABN = 132;

struct Unit { int b, h, kind, dil, rho, u0; };

__device__ __forceinline__ void glds16(const void* gsrc, unsigned lds_dst) { unsigned keep;
    asm volatile("s_mov_b32 %0, m0\n\ts_mov_b32 m0, %2\n\ts_nop 0\n\tglobal_load_lds_dwordx4 %1, off\n\ts_mov_b32 m0, %0" : "=&s"(keep) : "v"(gsrc), "s"(lds_dst) : "memory"); }
__device__ __forceinline__ float cndm(float p, unsigned long long m) { float o; asm("v_cndmask_b32_e64 %0, 0, %1, %2" : "=v"(o) : "v"(p), "s"(m)); return o; }
typedef float f32x2_t __attribute__((ext_vector_type(2))); typedef __bf16 bf16x2_t __attribute__((ext_vector_type(2)));
__device__ __forceinline__ unsigned cvtpk(float lo, float hi) { f32x2_t v = {lo, hi}; bf16x2_t b = __builtin_convertvector(v, bf16x2_t); return __builtin_bit_cast(unsigned, b); }
typedef short v4i16_t __attribute__((ext_vector_type(4)));
__device__ __forceinline__ s16x4 vtr(lds_cptr p) { return __builtin_bit_cast(s16x4, __builtin_amdgcn_ds_read_tr16_b64_v4i16((ALDS v4i16_t*)p)); }
__device__ __forceinline__ float silu(float z) { return z / (1.f + __expf(-z)); }

template <int MODE> __device__ __forceinline__ void attn_unit(const Unit U, unsigned char* ws, ALDS unsigned char* shm) {
    const int tid = threadIdx.x, lane = tid & 63, r32 = lane & 31, hi = lane >> 5; const int wid = __builtin_amdgcn_readfirstlane(tid >> 6);
    const int dil = U.dil, rho = U.rho, h = U.h; const size_t rowbase = (size_t)U.b * SEQ;
    const bf16_t* Qg = (const bf16_t*)(ws + (MODE == 0 ? WS_QA : WS_QB)) + rowbase * 512 + h * 64;
    const bf16_t* Kg = (const bf16_t*)(ws + (MODE == 0 ? WS_KA : WS_KB)) + rowbase * 512 + h * 64;
    const bf16_t* Vg = (const bf16_t*)(ws + (MODE == 0 ? WS_VA : WS_VB)) + rowbase * 512 + h * 64;
    const unsigned lds0 = (unsigned)(uintptr_t)shm;
    const int xw = U.u0 + 32 * wid;
    const int kt0 = (MODE == 0) ? 0 : (U.u0 >= 128 ? U.u0 - 128 : 0);
    const int NT = (U.u0 + 256 - kt0) >> 6;
    ALDS float* tab = (ALDS float*)(shm + LDS_TAB);
    if (tid < TABN) tab[tid] = ((const float*)(ws + WS_ATAB))[(U.kind * 8 + h) * TABN + tid];
    bf16x8 qr[4];
    { const bf16_t* qp = Qg + ((size_t)(xw + r32) * dil + rho) * 512 + hi * 8;
#pragma unroll
      for (int d0 = 0; d0 < 4; ++d0) qr[d0] = *(const bf16x8*)(qp + d0 * 16); }
    const bf16_t* ksrc = Kg + ((size_t)(kt0 + lane) * dil + rho) * 512 + wid * 8;
    const bf16_t* vsrc = Vg + ((size_t)(kt0 + 16 * (wid & 3) + (lane >> 2)) * dil + rho) * 512 + (wid >> 2) * 32 + (lane & 3) * 8;
    const size_t tstep = (size_t)64 * dil * 512;
    const unsigned kdst = lds0 + LDS_K + wid * 1024, vdst = lds0 + LDS_V + wid * 1024;
#define ATT_DMA(t, slot) do { glds16(ksrc + (size_t)(t) * tstep, (unsigned)__builtin_amdgcn_readfirstlane(kdst + (slot) * SLOTB)); glds16(vsrc + (size_t)(t) * tstep, (unsigned)__builtin_amdgcn_readfirstlane(vdst + (slot) * SLOTB)); } while (0)
    ATT_DMA(0, 0); if (NT > 1) ATT_DMA(1, 1);
    const lds_cptr kp0 = (lds_cptr)shm + LDS_K + hi * 1024 + r32 * 16;
    const lds_cptr vp0 = (lds_cptr)shm + LDS_V + ((lane >> 4) & 1) * 32 + (lane & 3) * 8 + (4 * hi + ((lane & 15) >> 2)) * 64;
    f32x16 o[2]; o[0] = f32x16{}; o[1] = f32x16{}; float l_reg = 0.f;
    cmask_ptr mrow = (cmask_ptr)(ws + WS_MASK) + ((size_t)U.b * 128 + (xw >> 5)) * 128 * 16;
    int slot = 0;
    for (int t = 0; t < NT; ++t) {
        if (t + 1 < NT) asm volatile("s_waitcnt vmcnt(2) lgkmcnt(0)\n\ts_barrier" ::: "memory");
        else asm volatile("s_waitcnt vmcnt(0) lgkmcnt(0)\n\ts_barrier" ::: "memory");
        if (t + 2 < NT) { const int s2 = slot >= 1 ? slot - 1 : 2; ATT_DMA(t + 2, s2); }
        const int kt = kt0 + 64 * t;
        const bool need = (kt <= xw + 31) && (MODE == 0 || kt + 63 >= xw - 128);
        if (need) {
            const float negb = tab[129];
            f32x16 p0, p1;
#pragma unroll
            for (int r = 0; r < 16; ++r) { p0[r] = negb; p1[r] = negb; }
            const lds_cptr kb = kp0 + slot * SLOTB;
#pragma unroll
            for (int d0 = 0; d0 < 4; ++d0) {
                const bf16x8 b0 = *(const ALDS bf16x8*)(kb + d0 * 2048), b1 = *(const ALDS bf16x8*)(kb + d0 * 2048 + 512);
                p0 = __builtin_amdgcn_mfma_f32_32x32x16_bf16(b0, qr[d0], p0, 0, 0, 0); p1 = __builtin_amdgcn_mfma_f32_32x32x16_bf16(b1, qr[d0], p1, 0, 0, 0);
            }
            const int jb = xw + r32 - kt - 4 * hi;
            if (MODE == 0) {
                if (kt + 63 > xw - 128) {
#pragma unroll
                    for (int r = 0; r < 16; ++r) { const int c = (r & 3) + 8 * (r >> 2); unsigned j0 = (unsigned)(jb - c), j1 = (unsigned)(jb - c - 32); j0 = j0 < 128u ? j0 : 128u; j1 = j1 < 128u ? j1 : 128u; p0[r] += tab[j0]; p1[r] += tab[j1]; }
                }
                cmask_ptr mw = mrow + (size_t)(kt >> 5) * 16;
#pragma unroll
                for (int r = 0; r < 16; ++r) { p0[r] = cndm(__builtin_amdgcn_exp2f(p0[r]), mw[r]); p1[r] = cndm(__builtin_amdgcn_exp2f(p1[r]), mw[16 + r]); }
            } else {
#pragma unroll
                for (int r = 0; r < 16; ++r) { const int c = (r & 3) + 8 * (r >> 2); const unsigned j0 = (unsigned)(jb - c), j1 = (unsigned)(jb - c - 32);
                    const float e0 = __builtin_amdgcn_exp2f(p0[r] + tab[j0 < 128u ? j0 : 128u]), e1 = __builtin_amdgcn_exp2f(p1[r] + tab[j1 < 128u ? j1 : 128u]);
                    p0[r] = j0 <= 128u ? e0 : 0.f; p1[r] = j1 <= 128u ? e1 : 0.f; }
            }
            float sacc = 0.f;
#pragma unroll
            for (int r = 0; r < 16; ++r) sacc += p0[r] + p1[r];
            l_reg += sacc;
            u32x4 pw0, pw1, pw2, pw3;
            pw0 = (u32x4){cvtpk(p0[0], p0[1]), cvtpk(p0[2], p0[3]), cvtpk(p0[4], p0[5]), cvtpk(p0[6], p0[7])};
            pw1 = (u32x4){cvtpk(p0[8], p0[9]), cvtpk(p0[10], p0[11]), cvtpk(p0[12], p0[13]), cvtpk(p0[14], p0[15])};
            pw2 = (u32x4){cvtpk(p1[0], p1[1]), cvtpk(p1[2], p1[3]), cvtpk(p1[4], p1[5]), cvtpk(p1[6], p1[7])};
            pw3 = (u32x4){cvtpk(p1[8], p1[9]), cvtpk(p1[10], p1[11]), cvtpk(p1[12], p1[13]), cvtpk(p1[14], p1[15])};
            const lds_cptr vp = vp0 + slot * SLOTB;
#pragma unroll
            for (int d0 = 0; d0 < 2; ++d0) {
#define ATT_VF(ks) ({ const s16x4 lo_ = vtr(vp + d0 * 4096 + (ks) * 1024), hi_ = vtr(vp + d0 * 4096 + (ks) * 1024 + 512); (bf16x8){lo_[0], lo_[1], lo_[2], lo_[3], hi_[0], hi_[1], hi_[2], hi_[3]}; })
                o[d0] = __builtin_amdgcn_mfma_f32_32x32x16_bf16(__builtin_bit_cast(bf16x8, pw0), ATT_VF(0), o[d0], 0, 0, 0);
                o[d0] = __builtin_amdgcn_mfma_f32_32x32x16_bf16(__builtin_bit_cast(bf16x8, pw1), ATT_VF(1), o[d0], 0, 0, 0);
                o[d0] = __builtin_amdgcn_mfma_f32_32x32x16_bf16(__builtin_bit_cast(bf16x8, pw2), ATT_VF(2), o[d0], 0, 0, 0);
                o[d0] = __builtin_amdgcn_mfma_f32_32x32x16_bf16(__builtin_bit_cast(bf16x8, pw3), ATT_VF(3), o[d0], 0, 0, 0);
#undef ATT_VF
            }
        }
        slot = slot == 2 ? 0 : slot + 1;
    }
    asm volatile("s_waitcnt lgkmcnt(0)\n\ts_barrier" ::: "memory");
    { auto rr = __builtin_amdgcn_permlane32_swap(__float_as_uint(l_reg), __float_as_uint(l_reg), false, false); l_reg = __uint_as_float(rr[0]) + __uint_as_float(rr[1]); }
    ALDS float* wsf = (ALDS float*)(shm + LDS_WS) + wid * 64;
    ALDS float* stg = (ALDS float*)(shm + LDS_OST) + wid * 2048;
    if (hi == 0) wsf[r32] = l_reg;
#pragma unroll
    for (int r = 0; r < 16; ++r) { const int orow = (r & 3) + 8 * (r >> 2) + 4 * hi; stg[orow * 64 + r32] = o[0][r]; stg[orow * 64 + 32 + r32] = o[1][r]; }
    asm volatile("s_waitcnt lgkmcnt(0)" ::: "memory");
#pragma unroll
    for (int i = 0; i < 4; ++i) {
        const int row = i * 8 + (lane >> 3), ch = lane & 7; const size_t tok = rowbase + (size_t)(xw + row) * dil + rho; const int col = h * 64 + ch * 8;
        const f32x4 a0 = *(const ALDS f32x4*)(stg + row * 64 + ch * 8), a1 = *(const ALDS f32x4*)(stg + row * 64 + ch * 8 + 4); float l = wsf[row];
        float v[8] = {a0[0], a0[1], a0[2], a0[3], a1[0], a1[1], a1[2], a1[3]};
        if (MODE == 1) {
            bf16_t* pb = (bf16_t*)(ws + (U.kind == 1 ? WS_PB1 : WS_PB2)); float* lp = (float*)(ws + (U.kind == 1 ? WS_LB1 : WS_LB2));
            u32x4 w; w.x = cvtpk(v[0], v[1]); w.y = cvtpk(v[2], v[3]); w.z = cvtpk(v[4], v[5]); w.w = cvtpk(v[6], v[7]);
            *(u32x4*)(pb + tok * 512 + col) = w; if (ch == 0) lp[tok * 8 + h] = l;
        } else {
            if (MODE == 2) {
                const u32x4 q1 = *(const u32x4*)((const bf16_t*)(ws + WS_PB1) + tok * 512 + col), q2 = *(const u32x4*)((const bf16_t*)(ws + WS_PB2) + tok * 512 + col);
                l += ((const float*)(ws + WS_LB1))[tok * 8 + h] + ((const float*)(ws + WS_LB2))[tok * 8 + h];
#pragma unroll
                for (int e = 0; e < 4; ++e) { v[2 * e] += __uint_as_float(q1[e] << 16) + __uint_as_float(q2[e] << 16); v[2 * e + 1] += __uint_as_float(q1[e] & 0xffff0000u) + __uint_as_float(q2[e] & 0xffff0000u); }
            }
            const u32x4 zz = *(const u32x4*)((const bf16_t*)(ws + (MODE == 0 ? WS_ZA : WS_ZB)) + tok * 512 + col); const float rl = 1.f / l;
#pragma unroll
            for (int e = 0; e < 4; ++e) { v[2 * e] *= rl * silu(__uint_as_float(zz[e] << 16)); v[2 * e + 1] *= rl * silu(__uint_as_float(zz[e] & 0xffff0000u)); }
            u32x4 w; w.x = cvtpk(v[0], v[1]); w.y = cvtpk(v[2], v[3]); w.z = cvtpk(v[4], v[5]); w.w = cvtpk(v[6], v[7]);
            *(u32x4*)((bf16_t*)(ws + WS_MIX) + tok * 1024 + (MODE == 0 ? 0 : 512) + col) = w;
        }
    }
#undef ATT_DMA
}
}

__device__ __forceinline__ int vcu_of_block() { const int G = gridDim.x, bx = blockIdx.x; return (G % 8 == 0) ? (bx % 8) * (G / 8) + bx / 8 : bx; }

__device__ __forceinline__ void phase_attn_a(unsigned char* ws, att::lds_ptr shm) {
    const int G = gridDim.x;
    for (int id = vcu_of_block(); id < 2048; id += G) {
        const int i = id >> 8, v = id & 255, bh = v >> 1, half = v & 1, s = i >> 1; const int qb = (i & 1) ? 15 - (2 * s + half) : 2 * s + half;
        att::Unit U{bh >> 3, bh & 7, 0, 1, 0, qb * 256};
        att::attn_unit<0>(U, ws, shm);
    }
}
__device__ __forceinline__ void phase_attn_b12(unsigned char* ws, att::lds_ptr shm) {
    const int G = gridDim.x;
    for (int id = vcu_of_block(); id < 4096; id += G) {
        const int blk = id >> 8, v = id & 255, bh = v >> 1, half = v & 1;
        att::Unit U{bh >> 3, bh & 7, 1 + half, half ? 4 : 1, half ? (blk >> 2) : 0, half ? (blk & 3) * 256 : blk * 256};
        att::attn_unit<1>(U, ws, shm);
    }
}
__device__ __forceinline__ void phase_attn_b3(unsigned char* ws, att::lds_ptr shm) {
    const int G = gridDim.x;
    for (int id = vcu_of_block(); id < 2048; id += G) {
        const int i = id >> 8, v = id & 255, bh = v >> 1, half = v & 1;
        att::Unit U{bh >> 3, bh & 7, 3, 16, half * 8 + i, 0};
        att::attn_unit<2>(U, ws, shm);
    }
}
__global__ __launch_bounds__(512, 2) void k_attn_a(unsigned char* ws) { extern __shared__ __attribute__((aligned(16))) unsigned char smem[]; phase_attn_a(ws, (att::lds_ptr)smem); }
__global__ __launch_bounds__(512, 2) void k_attn_b12(unsigned char* ws) { extern __shared__ __attribute__((aligned(16))) unsigned char smem[]; phase_attn_b12(ws, (att::lds_ptr)smem); }
__global__ __launch_bounds__(512, 2) void k_attn_b3(unsigned char* ws) { extern __shared__ __attribute__((aligned(16))) unsigned char smem[]; phase_attn_b3(ws, (att::lds_ptr)smem); }
namespace tk {
using bf16x8 = __attribute__((ext_vector_type(8))) short;
using f32x16 = __attribute__((ext_vector_type(16))) float;
using u32x4 = __attribute__((ext_vector_type(4))) unsigned;
#define TLDS __attribute__((address_space(3)))
typedef TLDS unsigned char* lds_ptr;
constexpr int CAP = 448;
constexpr int L_HIST = 0;
constexpr int L_LIST = 0;
constexpr int L_IMG = 114688;
constexpr int L_H2 = 131328;
constexpr int L_SC = 139520;
constexpr int L_FB = 0;
constexpr int LDS_BYTES = 140544;

__device__ __forceinline__ unsigned mono(float s) { const unsigned u = __float_as_uint(s); return (u & 0x80000000u) ? ~u : (u | 0x80000000u); }

__device__ __forceinline__ f32x16 score_block(const bf16_t* __restrict__ KIb, int j, int r32, int hi, const bf16x8 (&qf)[4][4], const float (&w)[4]) {
    bf16x8 kf[4]; const bf16_t* kp = KIb + (size_t)(32 * j + r32) * 64 + hi * 8;
#pragma unroll
    for (int s = 0; s < 4; ++s) kf[s] = *(const bf16x8*)(kp + s * 16);
    f32x16 sc;
#pragma unroll
    for (int r = 0; r < 16; ++r) sc[r] = 0.f;
#pragma unroll
    for (int h = 0; h < 4; ++h) {
        f32x16 a;
#pragma unroll
        for (int r = 0; r < 16; ++r) a[r] = 0.f;
#pragma unroll
        for (int s = 0; s < 4; ++s) a = __builtin_amdgcn_mfma_f32_32x32x16_bf16(kf[s], qf[h][s], a, 0, 0, 0);
#pragma unroll
        for (int r = 0; r < 16; ++r) sc[r] = fmaf(w[h], fmaxf(a[r], 0.f), sc[r]);
    }
    return sc;
}

__device__ __forceinline__ void topk_unit(int b, int qb32, unsigned char* ws, lds_ptr shm) {
    const int tid = threadIdx.x, lane = tid & 63, r32 = lane & 31, hi = lane >> 5; const int wid = __builtin_amdgcn_readfirstlane(tid >> 6);
    const int q0 = 32 * qb32, nkb = qb32 + 1; const size_t rowbase = (size_t)b * SEQ;
    const bf16_t* KIb = (const bf16_t*)(ws + WS_KI) + rowbase * 64;
    TLDS unsigned* hist = (TLDS unsigned*)(shm + L_HIST); TLDS unsigned long long* lists = (TLDS unsigned long long*)(shm + L_LIST); TLDS unsigned long long* img = (TLDS unsigned long long*)(shm + L_IMG);
    TLDS unsigned* h2 = (TLDS unsigned*)(shm + L_H2); TLDS float* tlo = (TLDS float*)(shm + L_SC); TLDS float* thi = tlo + 32; TLDS int* needv = (TLDS int*)(thi + 32); TLDS unsigned* ccnt = (TLDS unsigned*)(needv + 32);
    { TLDS u32x4* hz = (TLDS u32x4*)hist;
#pragma unroll
      for (int i = 0; i < 16; ++i) hz[tid + 512 * i] = (u32x4){0u, 0u, 0u, 0u}; }
    if (tid < 32) ccnt[tid] = 0u;
    bf16x8 qf[4][4]; float w[4];
    { const bf16_t* qp = (const bf16_t*)(ws + WS_QI) + (rowbase + q0 + r32) * 256 + hi * 8;
#pragma unroll
      for (int h = 0; h < 4; ++h)
#pragma unroll
          for (int s = 0; s < 4; ++s) qf[h][s] = *(const bf16x8*)(qp + h * 64 + s * 16);
      const float4 wv = *(const float4*)((const float*)(ws + WS_WI) + (rowbase + q0 + r32) * 4); w[0] = wv.x; w[1] = wv.y; w[2] = wv.z; w[3] = wv.w; }
    __syncthreads();
    for (int j = wid; j < nkb; j += 8) {
        const f32x16 sc = score_block(KIb, j, r32, hi, qf, w); const bool diag = (j == qb32);
#pragma unroll
        for (int r = 0; r < 16; ++r) { const int c = (r & 3) + 8 * (r >> 2) + 4 * hi;
            float bf = fmaf(sc[r], 128.f, 512.f); bf = fminf(fmaxf(bf, 0.f), 1023.5f); const int bin = (int)bf;
            if (!diag || c <= r32) __hip_atomic_fetch_add(hist + r32 * 1024 + bin, 1u, __ATOMIC_RELAXED, __HIP_MEMORY_SCOPE_WORKGROUP); }
    }
    __syncthreads();
    { const int q = tid >> 4, sub = tid & 15; const TLDS unsigned* hq = hist + q * 1024; unsigned csum = 0u;
#pragma unroll
      for (int i = 0; i < 16; ++i) { const u32x4 v = *(const TLDS u32x4*)(hq + 64 * sub + 4 * i); csum += (v.x + v.y) + (v.z + v.w); }
      unsigned incl = csum;
#pragma unroll
      for (int off = 1; off < 16; off <<= 1) { const unsigned t = __shfl_down(incl, off, 16); if (sub + off < 16) incl += t; }
      const unsigned total = __shfl(incl, 0, 16); unsigned above = incl - csum;
      const bool f1 = (above < 256u) && (above + csum >= 256u);
      const unsigned long long bal1 = __ballot(f1); const unsigned g1 = (unsigned)(bal1 >> (16 * ((lane >> 4) & 3))) & 0xffffu;
      if (total < 256u || g1 == 0u) { if (sub == 0) { tlo[q] = -INFINITY; thi[q] = -INFINITY; needv[q] = 0; } }
      else {
          const int cst = __builtin_ctz(g1); const unsigned ab1 = __shfl(above, cst, 16);
          const u32x4 v = *(const TLDS u32x4*)(hq + 64 * cst + 4 * sub); const unsigned c4 = (v.x + v.y) + (v.z + v.w); unsigned in2 = c4;
#pragma unroll
          for (int off = 1; off < 16; off <<= 1) { const unsigned t = __shfl_down(in2, off, 16); if (sub + off < 16) in2 += t; }
          unsigned ab2 = ab1 + (in2 - c4);
          if ((ab2 < 256u) && (ab2 + c4 >= 256u)) { int bs;
              if (ab2 + v.w >= 256u) bs = 3; else { ab2 += v.w; if (ab2 + v.z >= 256u) bs = 2; else { ab2 += v.z; if (ab2 + v.y >= 256u) bs = 1; else { ab2 += v.y; bs = 0; } } }
              const int bstar = 64 * cst + 4 * sub + bs;
              tlo[q] = bstar <= 0 ? -INFINITY : (float)bstar; thi[q] = bstar >= 1023 ? INFINITY : (float)(bstar + 1); needv[q] = 256 - (int)ab2; }
      }
    }
    __syncthreads();
    if (tid < 16) img[nkb * 16 + tid] = 0ull;
    { const float mylo = tlo[r32], myhi = thi[r32];
      for (int j = wid; j < nkb; j += 8) {
        const f32x16 sc = score_block(KIb, j, r32, hi, qf, w); const bool diag = (j == qb32);
        bool anyc = false; bool cand[16];
#pragma unroll
        for (int r = 0; r < 16; ++r) { const int c = (r & 3) + 8 * (r >> 2) + 4 * hi; const float bf = fmaf(sc[r], 128.f, 512.f);
            bool ok = !diag || c <= r32; const bool def = ok && (bf >= myhi); cand[r] = ok && !def && (bf >= mylo); anyc |= cand[r];
            const unsigned long long bal = __ballot(def); if (lane == 0) img[j * 16 + r] = bal; }
        if (__any(anyc)) {
#pragma unroll
            for (int r = 0; r < 16; ++r) if (cand[r]) { const int c = (r & 3) + 8 * (r >> 2) + 4 * hi; const unsigned idx = (unsigned)(32 * j + c);
                const unsigned slot = __hip_atomic_fetch_add(ccnt + r32, 1u, __ATOMIC_RELAXED, __HIP_MEMORY_SCOPE_WORKGROUP);
                if (slot < (unsigned)CAP) lists[r32 * CAP + slot] = ((unsigned long long)mono(sc[r]) << 12) | (unsigned long long)(4095u - idx); }
        }
      }
    }
    __syncthreads();
    { const int q = 4 * wid + (lane >> 4), sub = lane & 15; const unsigned craw = ccnt[q]; const int C = craw > (unsigned)CAP ? CAP : (int)craw; int need = (craw > (unsigned)CAP) ? 0 : needv[q];
      int cm = C; cm = max(cm, __shfl_xor(cm, 16)); cm = max(cm, __shfl_xor(cm, 32));
      const TLDS unsigned long long* list = lists + q * CAP; TLDS unsigned* hq = h2 + q * 64; unsigned long long prefix = 0ull;
      for (int level = 0; level < 8; ++level) {
          const int shift = 42 - 6 * level;
          *(TLDS u32x4*)(hq + 4 * sub) = (u32x4){0u, 0u, 0u, 0u};
          asm volatile("s_waitcnt lgkmcnt(0)" ::: "memory");
          for (int i = sub; i < cm; i += 16) if (i < C) { const unsigned long long ck = list[i]; if ((ck >> (shift + 6)) == prefix) __hip_atomic_fetch_add(hq + (unsigned)((ck >> shift) & 63ull), 1u, __ATOMIC_RELAXED, __HIP_MEMORY_SCOPE_WORKGROUP); }
          asm volatile("s_waitcnt lgkmcnt(0)" ::: "memory");
          const u32x4 v = *(const TLDS u32x4*)(hq + 4 * sub); const unsigned c4 = (v.x + v.y) + (v.z + v.w); unsigned incl = c4;
#pragma unroll
          for (int off = 1; off < 16; off <<= 1) { const unsigned t = __shfl_down(incl, off, 16); if (sub + off < 16) incl += t; }
          unsigned ab = incl - c4; const bool f = need > 0 && ab < (unsigned)need && ab + c4 >= (unsigned)need;
          int d = 0;
          if (f) { if (ab + v.w >= (unsigned)need) d = 3; else { ab += v.w; if (ab + v.z >= (unsigned)need) d = 2; else { ab += v.z; if (ab + v.y >= (unsigned)need) d = 1; else { ab += v.y; d = 0; } } } d += 4 * sub; }
          const unsigned long long bal = __ballot(f); const unsigned g = (unsigned)(bal >> (16 * ((lane >> 4) & 3))) & 0xffffu;
          if (g != 0u) { const int src = __builtin_ctz(g); d = __shfl(d, src, 16); const unsigned abn = __shfl(ab, src, 16); need -= (int)abn; prefix = (prefix << 6) | (unsigned long long)d; }
          else { need = 0; prefix = (prefix << 6); }
      }
      if (need > 0) for (int i = sub; i < C; i += 16) { const unsigned long long ck = list[i];
          if (ck >= prefix) { const unsigned idx = 4095u - (unsigned)(ck & 4095ull), kk = idx & 31u, r = (kk & 3u) | ((kk >> 3) << 2), hh = (kk >> 2) & 1u;
              __hip_atomic_fetch_or((TLDS unsigned*)img + ((idx >> 5) * 16u + r) * 2u + hh, 1u << (q & 31), __ATOMIC_RELAXED, __HIP_MEMORY_SCOPE_WORKGROUP); } }
    }
    __syncthreads();
    for (int ql = 0; ql < 32; ++ql) {
        if (ccnt[ql] <= (unsigned)CAP) continue;
        __syncthreads();
        TLDS float* fsc = (TLDS float*)(shm + L_FB); TLDS unsigned* fh = (TLDS unsigned*)(shm + L_FB + 16384); TLDS unsigned* fcnt = fh + 256; TLDS unsigned* fmisc = fcnt + 512;
        const int q = q0 + ql, n = q + 1; const bf16_t* qrow = (const bf16_t*)(ws + WS_QI) + (rowbase + q) * 256; const float* wq = (const float*)(ws + WS_WI) + (rowbase + q) * 4;
        for (int k = tid; k < n; k += 512) { const bf16_t* kr = KIb + (size_t)k * 64; float s = 0.f;
            for (int h = 0; h < 4; ++h) { float rr = 0.f;
#pragma unroll 8
                for (int d = 0; d < 64; ++d) rr = fmaf(bf2f(qrow[h * 64 + d]), bf2f(kr[d]), rr);
                s = fmaf(wq[h], fmaxf(rr, 0.f), s); }
            fsc[k] = s; }
        if (tid == 0) { fmisc[0] = 0u; fmisc[1] = 256u; }
        __syncthreads();
        for (int pass = 3; pass >= 0; --pass) { const int shift = pass * 8; if (tid < 256) fh[tid] = 0u; __syncthreads();
            const unsigned pfx = fmisc[0], himask = (pass == 3) ? 0u : (0xffffffffu << (shift + 8));
            for (int k = tid; k < n; k += 512) { const unsigned key = mono(fsc[k]); if ((key & himask) == pfx) __hip_atomic_fetch_add(fh + ((key >> shift) & 255u), 1u, __ATOMIC_RELAXED, __HIP_MEMORY_SCOPE_WORKGROUP); }
            __syncthreads();
            if (tid == 0) { unsigned nd = fmisc[1], cum = 0u; int d = 255; for (; d > 0; --d) { if (cum + fh[d] >= nd) break; cum += fh[d]; } fmisc[1] = nd - cum; fmisc[0] = pfx | ((unsigned)d << shift); }
            __syncthreads(); }
        const unsigned T = fmisc[0], nd = fmisc[1];
        unsigned myties = 0u;
        for (int i = 0; i < 8; ++i) { const int k = tid * 8 + i; if (k < n && mono(fsc[k]) == T) ++myties; }
        fcnt[tid] = myties; __syncthreads();
        unsigned before = 0u; for (int i = 0; i < tid; ++i) before += fcnt[i];
        for (int i = 0; i < 8; ++i) { const int k = tid * 8 + i; if (k >= n) break; const unsigned key = mono(fsc[k]); bool sel;
            if (key > T) sel = true; else if (key == T) { sel = before < nd; ++before; } else sel = false;
            const unsigned kk = (unsigned)k & 31u, r = (kk & 3u) | ((kk >> 3) << 2), hh = (kk >> 2) & 1u; TLDS unsigned* wp = (TLDS unsigned*)img + (((unsigned)k >> 5) * 16u + r) * 2u + hh;
            if (sel) __hip_atomic_fetch_or(wp, 1u << ql, __ATOMIC_RELAXED, __HIP_MEMORY_SCOPE_WORKGROUP); else __hip_atomic_fetch_and(wp, ~(1u << ql), __ATOMIC_RELAXED, __HIP_MEMORY_SCOPE_WORKGROUP); }
        __syncthreads();
    }
    { const int nchunk = (nkb + 1) * 8; u32x4* dst = (u32x4*)((unsigned long long*)(ws + WS_MASK) + ((size_t)b * 128 + qb32) * 128 * 16); const TLDS u32x4* src = (const TLDS u32x4*)img;
      const int lim = (qb32 == 127) ? nkb * 8 : nchunk;
      for (int i = tid; i < lim; i += 512) dst[i] = src[i]; }
    __syncthreads();
}
}

__device__ __forceinline__ void phase_topk(unsigned char* ws, tk::lds_ptr shm) {
    const int G = gridDim.x;
    for (int id = vcu_of_block(); id < 2048; id += G) {
        const int i = id >> 8, v = id & 255, b = v >> 4, s = v & 15; const int qb = (i & 1) ? 127 - (16 * (i >> 1) + s) : 16 * (i >> 1) + s;
        tk::topk_unit(b, qb, ws, shm);
    }
}
constexpr int MEGA_LDS = 147456;
__global__ __launch_bounds__(512, 2) void k_topk(unsigned char* ws) { extern __shared__ __attribute__((aligned(16))) unsigned char smem[]; phase_topk(ws, (tk::lds_ptr)smem); }

extern "C" void kernel_launch(void* const* d_in, const int* in_sizes, int n_in, void* d_out, int out_size, void* d_ws, size_t ws_size, hipStream_t stream) {
    const float* x = (const float*)d_in[0]; const float* gain = (const float*)d_in[1]; const float* w_in = (const float*)d_in[2]; const float* w_out = (const float*)d_in[3];
    const float* rel_bias = (const float*)d_in[4]; const float* gqa = (const float*)d_in[5]; const float* gka = (const float*)d_in[6]; const float* gqb = (const float*)d_in[7]; const float* gkb = (const float*)d_in[8];
    unsigned char* ws = (unsigned char*)d_ws; float* out = (float*)d_out;
    if (ws_size < WS_END) { fprintf(stderr, "workspace too small: %zu\n", ws_size); return; }
    bf16_t* WTI = (bf16_t*)(ws + WS_WTI); bf16_t* WTO = (bf16_t*)(ws + WS_WTO); float* bias2 = (float*)(ws + WS_TAB); int* bucket = (int*)(ws + WS_TAB + 4096);
    float* RSTD = (float*)(ws + WS_RSTD); bf16_t* XB = (bf16_t*)(ws + WS_XB); bf16_t* MIX = (bf16_t*)(ws + WS_MIX);
    g_prep_w<<<2048, 256, 0, stream>>>(w_in, gain, w_out, rel_bias, WTI, WTO, bias2, bucket, gqa, gka, gqb, gkb, (float*)(ws + WS_GTAB), (float*)(ws + WS_ATAB));
    g_prep_x<<<2048, 256, 0, stream>>>(x, XB, RSTD);
    static bool attr_done = false;
    if (!attr_done) { (void)hipFuncSetAttribute((const void*)k_gemm_in, hipFuncAttributeMaxDynamicSharedMemorySize, GEMM_LDS); (void)hipFuncSetAttribute((const void*)k_gemm_out, hipFuncAttributeMaxDynamicSharedMemorySize, GEMM_LDS);
        (void)hipFuncSetAttribute((const void*)k_topk, hipFuncAttributeMaxDynamicSharedMemorySize, MEGA_LDS); (void)hipFuncSetAttribute((const void*)k_attn_a, hipFuncAttributeMaxDynamicSharedMemorySize, GEMM_LDS); (void)hipFuncSetAttribute((const void*)k_attn_b12, hipFuncAttributeMaxDynamicSharedMemorySize, GEMM_LDS); (void)hipFuncSetAttribute((const void*)k_attn_b3, hipFuncAttributeMaxDynamicSharedMemorySize, GEMM_LDS); attr_done = true; }
    k_gemm_in<<<256, 512, GEMM_LDS, stream>>>(ws);
    k_topk<<<256, 512, MEGA_LDS, stream>>>(ws);
    k_attn_a<<<256, 512, GEMM_LDS, stream>>>(ws);
    k_attn_b12<<<256, 512, GEMM_LDS, stream>>>(ws);
    k_attn_b3<<<256, 512, GEMM_LDS, stream>>>(ws);
    k_gemm_out<<<256, 512, GEMM_LDS, stream>>>(ws, x, out);
}
```

```cpp
#include <hip/hip_runtime.h>
#include <stdint.h>
#include <cstdio>

typedef unsigned short bf16_t;

constexpr int D_MODEL = 1024, BATCH = 16, SEQ = 4096, M_TOK = BATCH * SEQ;
constexpr int NPHYS = 4608;
constexpr float EPS = 1e-6f;
constexpr float LOG2E = 1.4426950408889634f;
constexpr float QSCALE = 0.125f * LOG2E;
constexpr float IDX_SCALE = 0.0625f;

constexpr size_t MiB = 1u << 20;
constexpr size_t WS_CTL = 0;
constexpr size_t WS_WTI = 2 * MiB;
constexpr size_t WS_WTO = 11 * MiB;
constexpr size_t WS_TAB = 13 * MiB;
constexpr size_t WS_GTAB = WS_TAB + 32768;
constexpr size_t WS_ATAB = WS_TAB + 65536;
constexpr size_t WS_RSTD = 14 * MiB;
constexpr size_t WS_WI = 15 * MiB;
constexpr size_t WS_XB = 16 * MiB;
constexpr size_t WS_MIX = WS_XB;
constexpr size_t WS_QA = 144 * MiB, WS_KA = 208 * MiB, WS_VA = 272 * MiB, WS_ZA = 336 * MiB;
constexpr size_t WS_QB = 400 * MiB, WS_KB = 464 * MiB, WS_VB = 528 * MiB, WS_ZB = 592 * MiB;
constexpr size_t WS_QI = 656 * MiB;
constexpr size_t WS_KI = 688 * MiB;
constexpr size_t WS_MASK = 696 * MiB;
constexpr size_t WS_GM = 728 * MiB;
constexpr size_t WS_PB1 = 760 * MiB, WS_PB2 = 824 * MiB;
constexpr size_t WS_LB1 = 888 * MiB, WS_LB2 = 890 * MiB;
constexpr size_t WS_END = 892 * MiB;

__device__ __forceinline__ float bf2f(bf16_t v) { return __uint_as_float(((unsigned)v) << 16); }
__device__ __forceinline__ bf16_t f2bf(float f) { unsigned u = __float_as_uint(f); return (bf16_t)((u + 0x7fffu + ((u >> 16) & 1u)) >> 16); }

__host__ __device__ __forceinline__ int logical_of_phys(int p) { const int tile = p >> 8, pc = p & 255, bj = pc >> 7, wc = (pc >> 5) & 3, w = pc & 31; return tile * 256 + 64 * wc + 32 * bj + w; }
__host__ __device__ __forceinline__ int src_col_of_logical(int L) {
    if (L < 2048) return L;
    if (L < 4096) return 2372 + (L - 2048);
    if (L < 4352) return 2048 + (L - 4096);
    if (L < 4416) return 2304 + (L - 4352);
    if (L < 4420) return 2368 + (L - 4416);
    return -1;
}
__device__ __forceinline__ int crow(int r, int hi) { return (r & 3) + 8 * (r >> 2) + 4 * hi; }
__device__ __forceinline__ size_t mask_word_index(int b, int q, int k, int& bit) {
    const int qb = q >> 5, kb = k >> 5, kk = k & 31; const int r = (kk & 3) | ((kk >> 3) << 2), hi = (kk >> 2) & 1;
    bit = (q & 31) + 32 * hi;
    return (((size_t)b * 128 + qb) * 128 + kb) * 16 + r;
}

__device__ __forceinline__ void prep_w_body(size_t gid, size_t gsz, const float* __restrict__ w_in, const float* __restrict__ gain, const float* __restrict__ w_out, const float* __restrict__ rel_bias,
                         bf16_t* WTI, bf16_t* WTO, float* bias2, int* bucket, const float* gqa, const float* gka, const float* gqb, const float* gkb, float* gtab, float* atab) {
    for (size_t i = gid; i < 512; i += gsz) bias2[i] = rel_bias[i] * LOG2E;
    for (size_t i = gid; i < 256; i += gsz) { const int w = (int)(i >> 6), d = (int)(i & 63); gtab[i] = w == 0 ? gqa[d] : w == 1 ? gka[d] : w == 2 ? gqb[d] : gkb[d]; }
    for (size_t i = gid; i < 4096; i += gsz) { const int d = (int)i; int bk;
        if (d < 16) bk = d; else { const float df = (float)d; int lg = 16 + (int)(logf(df / 16.f) / logf(8.f) * 16.f); bk = lg < 31 ? lg : 31; }
        bucket[i] = bk; }
    for (size_t e = gid; e < (size_t)32 * 132; e += gsz) { const int kh = (int)(e / 132), j = (int)(e % 132), kind = kh >> 3, h = kh & 7, dil = kind <= 1 ? 1 : (kind == 2 ? 4 : 16), hoff = kind == 0 ? 0 : 8;
        const float far = rel_bias[31 * 16 + hoff + h] * LOG2E; float v = 0.f;
        if (j <= 128) { const int d = j * dil; int bk; if (d < 16) bk = d; else if (d >= 128) bk = 31; else { int lg = 16 + (int)(logf((float)d / 16.f) / logf(8.f) * 16.f); bk = lg < 31 ? lg : 31; }
            v = rel_bias[bk * 16 + hoff + h] * LOG2E - far; }
        else if (j == 129) { float mx = 0.f; for (int bk = 0; bk < 32; ++bk) mx = fmaxf(mx, rel_bias[bk * 16 + hoff + h] * LOG2E - far);
            const float* gq = kind == 0 ? gqa : gqb; const float* gk = kind == 0 ? gka : gkb; float qm = 0.f, km = 0.f;
            for (int d = 0; d < 64; ++d) { qm = fmaxf(qm, fabsf(gq[d])); km = fmaxf(km, fabsf(gk[d])); }
            v = -(64.f * QSCALE * qm * km * 1.02f + mx); }
        atab[e] = v; }
}

__device__ __forceinline__ void prep_x_body(int wave, int nw, int lane, const float* __restrict__ x, bf16_t* XB, float* RSTD) {
    for (int m4 = wave * 4; m4 < M_TOK; m4 += nw * 4) {
        float4 v[4][4]; float s[4];
#pragma unroll
        for (int rr = 0; rr < 4; ++rr) { const float4* xr = (const float4*)(x + (size_t)(m4 + rr) * 1024) + lane;
#pragma unroll
            for (int j = 0; j < 4; ++j) v[rr][j] = xr[64 * j]; }
#pragma unroll
        for (int rr = 0; rr < 4; ++rr) { float a = 0.f;
#pragma unroll
            for (int j = 0; j < 4; ++j) a += v[rr][j].x * v[rr][j].x + v[rr][j].y * v[rr][j].y + v[rr][j].z * v[rr][j].z + v[rr][j].w * v[rr][j].w;
            s[rr] = a; }
#pragma unroll
        for (int o = 1; o < 64; o <<= 1) {
#pragma unroll
            for (int rr = 0; rr < 4; ++rr) s[rr] += __shfl_xor(s[rr], o); }
#pragma unroll
        for (int rr = 0; rr < 4; ++rr) { uint2* o2 = (uint2*)(XB + (size_t)(m4 + rr) * 1024) + lane; const float rs = rsqrtf(s[rr] * (1.f / 1024.f) + EPS);
#pragma unroll
            for (int j = 0; j < 4; ++j) { uint2 w; w.x = f2bf(v[rr][j].x * rs) | ((unsigned)f2bf(v[rr][j].y * rs) << 16); w.y = f2bf(v[rr][j].z * rs) | ((unsigned)f2bf(v[rr][j].w * rs) << 16); o2[64 * j] = w; } }
    }
}

__device__ __forceinline__ void transpose_item(const float* __restrict__ W, int ldw, int src_col0, int nvalid, const float* __restrict__ gain, bf16_t* WTrow0, int k0, __attribute__((address_space(3))) float* scr, int lane) {
    { const int n = lane & 31; const bool ok = src_col0 >= 0 && n < nvalid; const float* wp = W + (size_t)(k0 + (lane >> 5)) * ldw + (ok ? src_col0 + n : 0); float v[32];
#pragma unroll
      for (int i = 0; i < 32; ++i) v[i] = ok ? wp[(size_t)(2 * i) * ldw] : 0.f;
      float gg[32];
#pragma unroll
      for (int i = 0; i < 32; ++i) gg[i] = gain ? gain[k0 + 2 * i + (lane >> 5)] : 1.f;
#pragma unroll
      for (int i = 0; i < 32; ++i) scr[(2 * i + (lane >> 5)) * 33 + n] = v[i] * gg[i]; }
    asm volatile("s_waitcnt lgkmcnt(0)" ::: "memory");
    const int c = lane & 7;
#pragma unroll
    for (int j = 0; j < 4; ++j) { const int n = (lane >> 3) + 8 * j; const __attribute__((address_space(3))) float* s = scr + (8 * c) * 33 + n;
        uint4 o; o.x = f2bf(s[0 * 33]) | ((unsigned)f2bf(s[1 * 33]) << 16); o.y = f2bf(s[2 * 33]) | ((unsigned)f2bf(s[3 * 33]) << 16); o.z = f2bf(s[4 * 33]) | ((unsigned)f2bf(s[5 * 33]) << 16); o.w = f2bf(s[6 * 33]) | ((unsigned)f2bf(s[7 * 33]) << 16);
        *(uint4*)(WTrow0 + (size_t)n * 1024 + k0 + 8 * c) = o; }
    asm volatile("s_waitcnt lgkmcnt(0)" ::: "memory");
}
__device__ __forceinline__ void prep_weights(int gw, int ngw, int lane, const float* __restrict__ w_in, const float* __restrict__ gain, const float* __restrict__ w_out, bf16_t* WTI, bf16_t* WTO, __attribute__((address_space(3))) float* scr) {
    for (int it = gw; it < 2816; it += ngw) {
        if (it < 2304) { const int ng = it >> 4, kg = it & 15; const int L0 = logical_of_phys(ng * 32); const int src0 = src_col_of_logical(L0); const int nvalid = (L0 == 4416) ? 4 : 32;
            transpose_item(w_in, 4420, src0, nvalid, gain, WTI + (size_t)(ng * 32) * 1024, kg * 64, scr, lane); }
        else { const int r = it - 2304, ng = r >> 4, kg = r & 15; transpose_item(w_out, 1024, ng * 32, 32, nullptr, WTO + (size_t)(ng * 32) * 1024, kg * 64, scr, lane); }
    }
}
namespace pg8 {
#define PG8_LAS __attribute__((address_space(3)))
typedef unsigned short bf16_t;
typedef short bf16x8 __attribute__((ext_vector_type(8)));
typedef float f32x4 __attribute__((ext_vector_type(4)));
typedef unsigned u32x4 __attribute__((ext_vector_type(4)));
constexpr int BM = 256, BK = 64, HALF = 128, HTB = HALF * BK * 2  , STAGE_BYTES = 8 * HTB, NXCD = 8, WGM = 8;

__host__ __device__ __forceinline__ int lds_byte(int r, int c) { const int st = (r >> 4) * 2 + (c >> 5), rr = r & 15, cc = c & 31, ob = rr * 64 + cc * 2; return st * 1024 + (ob ^ (((ob >> 9) & 1) << 5)); }
__host__ __device__ __forceinline__ void stage_rc(int b, int& R, int& C) { const int st = b / 1024, sb = b % 1024, swz = sb ^ (((sb >> 9) & 1) << 5); R = (st >> 1) * 16 + swz / 64; C = (st & 1) * 32 + (swz % 64) / 2; }
__host__ __device__ __forceinline__ int perm32(int rho) { const int n = rho >> 4, i = rho & 15; return 8 * (i >> 2) + 4 * n + (i & 3); }

struct Unit { int pm, pn; };
struct Gemm { const bf16_t* A; const bf16_t* Bt; int M, N, K; };

struct StaticOrder {
    int nM, nN, nwg, G, c;
    __host__ __device__ void init(int M, int N, int G_, int c_) { nM = M / BM; nN = N / BM; nwg = nM * nN; G = G_; c = c_; }
    __host__ __device__ bool next(int i, Unit& u) const {
        const long L = (long)i * G + c; if (L >= nwg) return false;
        int wgid = (int)L; { const int q = nwg / NXCD, r = nwg % NXCD, xcd = wgid % NXCD, off = wgid / NXCD; wgid = (xcd < r ? xcd * (q + 1) : r * (q + 1) + (xcd - r) * q) + off; }
        const int nig = WGM * nN, gid = wgid / nig, fm = gid * WGM, gsz = (nM - fm) < WGM ? (nM - fm) : WGM;
        u.pm = fm + ((wgid % nig) % gsz); u.pn = (wgid % nig) / gsz; return true;
    }
    __device__ __forceinline__ void a_ready(const Unit&) const {}
    __device__ __forceinline__ void done(const Unit&) const {}
};
__device__ __forceinline__ unsigned cvt_pk_bf16(float lo, float hi) { unsigned r; asm volatile("v_cvt_pk_bf16_f32 %0, %1, %2" : "=v"(r) : "v"(lo), "v"(hi)); return r; }
typedef float f32x2 __attribute__((ext_vector_type(2)));
template <class Epi, class Sched, bool ALIGN_EPI = false, bool SP2 = false>
__device__ __forceinline__ void gemm_phase(PG8_LAS unsigned char* lds, const Gemm g, const Sched& S, const Epi& E) {
    int tid_ = threadIdx.x; asm volatile("" : "+v"(tid_));
    const int tid = tid_, wid = __builtin_amdgcn_readfirstlane(tid >> 6), lane = tid & 63, wr = wid >> 2, wc = wid & 3, fr = lane & 15, fq = lane >> 4;
    const int K = g.K, nt = K / BK;
    unsigned voffA[2], voffB[2];
#pragma unroll
    for (int i = 0; i < 2; ++i) { int R, C; stage_rc(tid * 16 + i * 8192, R, C); const int Rb = Epi::PERM ? ((R & ~31) + perm32(R & 31)) : R;
        voffA[i] = (unsigned)(R * K + C) * 2u; voffB[i] = (unsigned)(Rb * K + C) * 2u; }
    const size_t kstep = (size_t)(BK * 2);
    const size_t hstep = (size_t)HALF * K * 2;
    const size_t tstep = 2 * hstep;
    const unsigned ldsw = (unsigned)wid * 1024u;
    const int aoff = lds_byte(wr * 64 + fr, fq * 8), boff = lds_byte(wc * 32 + fr, fq * 8);
#define PG8_SA(b, h) (((b) * 2 + (h)) * HTB)
#define PG8_SB(b, h) ((4 + (b) * 2 + (h)) * HTB)
#define PG8_STAGE(bufoff, gbase, voff) do { _Pragma("unroll") for (int _i = 0; _i < 2; ++_i) \
        __builtin_amdgcn_global_load_lds((const unsigned*)((const char*)(gbase) + (voff)[_i]), (PG8_LAS unsigned*)(lds + (bufoff) + ldsw + _i * 8192), 16, 0, 0); } while (0)
#define PG8_LDA(dst, b, h) do { _Pragma("unroll") for (int m = 0; m < 4; ++m) _Pragma("unroll") for (int k = 0; k < 2; ++k) dst[m][k] = *(const PG8_LAS bf16x8*)(lds + PG8_SA(b, h) + aoff + m * 2048 + k * 1024); } while (0)
#define PG8_LDB(dst, b, h) do { _Pragma("unroll") for (int n = 0; n < 2; ++n) _Pragma("unroll") for (int k = 0; k < 2; ++k) dst[n][k] = *(const PG8_LAS bf16x8*)(lds + PG8_SB(b, h) + boff + n * 2048 + k * 1024); } while (0)
#define PG8_MMA(ai, bj, At, Bt) do { __builtin_amdgcn_s_setprio(1); _Pragma("unroll") for (int m = 0; m < 4; ++m) _Pragma("unroll") for (int n = 0; n < 2; ++n) _Pragma("unroll") for (int k = 0; k < 2; ++k) \
        acc[ai][bj][m][n] = __builtin_amdgcn_mfma_f32_16x16x32_bf16(Bt[n][k], At[m][k], acc[ai][bj][m][n], 0, 0, 0); __builtin_amdgcn_s_setprio(0); } while (0)
#define PG8_WAIT_V(n) asm volatile("s_waitcnt vmcnt(" #n ")" ::: "memory")
#define PG8_WAIT_L(n) asm volatile("s_waitcnt lgkmcnt(" #n ")" ::: "memory")
#define PG8_BAR __builtin_amdgcn_s_barrier()
#define PG8_SCHED __builtin_amdgcn_sched_barrier(0)
    Unit cur, nxt; int ui = 0;
    if (!S.next(0, cur)) return;
    f32x4 acc[2][2][4][2];
#pragma unroll
    for (int a = 0; a < 2; ++a)
#pragma unroll
        for (int b = 0; b < 2; ++b)
#pragma unroll
            for (int m = 0; m < 4; ++m)
#pragma unroll
                for (int n = 0; n < 2; ++n) acc[a][b][m][n] = (f32x4){0.f, 0.f, 0.f, 0.f};
    bf16x8 At[4][2], B0[2][2], B1[2][2];
    const char* cA = (const char*)g.A + (size_t)cur.pm * tstep; const char* cB = (const char*)g.Bt + (size_t)cur.pn * tstep;
    S.a_ready(cur);
    if constexpr (SP2) {
        PG8_STAGE(PG8_SB(0, 0), cB, voffB); PG8_STAGE(PG8_SB(0, 1), cB + hstep, voffB); PG8_STAGE(PG8_SA(0, 0), cA, voffA); PG8_STAGE(PG8_SA(0, 1), cA + hstep, voffA);
        if (wr == 1) PG8_BAR;
        PG8_WAIT_V(2); PG8_BAR;
        PG8_STAGE(PG8_SB(1, 0), cB + kstep, voffB); PG8_STAGE(PG8_SA(1, 0), cA + kstep, voffA); PG8_STAGE(PG8_SB(1, 1), cB + hstep + kstep, voffB);
        PG8_WAIT_V(6); PG8_BAR;
    } else {
        PG8_STAGE(PG8_SB(0, 0), cB, voffB); PG8_STAGE(PG8_SA(0, 0), cA, voffA); PG8_STAGE(PG8_SB(0, 1), cB + hstep, voffB); PG8_STAGE(PG8_SA(0, 1), cA + hstep, voffA);
        if (wr == 1) PG8_BAR;
        PG8_WAIT_V(4); PG8_BAR;
        PG8_STAGE(PG8_SB(1, 0), cB + kstep, voffB); PG8_STAGE(PG8_SA(1, 0), cA + kstep, voffA); PG8_STAGE(PG8_SB(1, 1), cB + hstep + kstep, voffB);
        PG8_WAIT_V(6); PG8_BAR;
    }
    for (;;) {
        const bool has_next = S.next(ui + 1, nxt);
        const char* nA = has_next ? (const char*)g.A + (size_t)nxt.pm * tstep : cA; const char* nB = has_next ? (const char*)g.Bt + (size_t)nxt.pn * tstep : cB;
        for (int t = 0; t < nt; t += 2) {
            const bool last = (t == nt - 2);
            const char* a1 = cA + (size_t)(t + 1) * kstep;
            const char* a2 = last ? nA : cA + (size_t)(t + 2) * kstep; const char* b2 = last ? nB : cB + (size_t)(t + 2) * kstep;
            const char* a3 = a2 + kstep; const char* b3 = b2 + kstep;
            if (last && has_next) S.a_ready(nxt);
            if constexpr (SP2) {
            PG8_LDB(B0, 0, 0); PG8_LDB(B1, 0, 1); PG8_SCHED; PG8_LDA(At, 0, 0); PG8_STAGE(PG8_SA(1, 1), a1 + hstep, voffA);
            PG8_WAIT_V(8); PG8_WAIT_L(0); PG8_BAR; PG8_MMA(0, 0, At, B0); PG8_MMA(0, 1, At, B1); PG8_BAR; PG8_SCHED;
            PG8_LDA(At, 0, 1); PG8_STAGE(PG8_SB(0, 0), b2, voffB); PG8_STAGE(PG8_SB(0, 1), b2 + hstep, voffB); PG8_STAGE(PG8_SA(0, 0), a2, voffA);
            PG8_WAIT_V(8); PG8_WAIT_L(0); PG8_BAR; PG8_MMA(1, 0, At, B0); PG8_MMA(1, 1, At, B1); PG8_BAR; PG8_SCHED;
            PG8_LDB(B0, 1, 0); PG8_LDB(B1, 1, 1); PG8_SCHED; PG8_LDA(At, 1, 0); PG8_STAGE(PG8_SA(0, 1), a2 + hstep, voffA);
            PG8_WAIT_V(8); PG8_WAIT_L(0); PG8_BAR; PG8_MMA(0, 0, At, B0); PG8_MMA(0, 1, At, B1); PG8_BAR; PG8_SCHED;
            PG8_LDA(At, 1, 1); PG8_STAGE(PG8_SB(1, 0), b3, voffB); PG8_STAGE(PG8_SB(1, 1), b3 + hstep, voffB); PG8_STAGE(PG8_SA(1, 0), a3, voffA);
            PG8_WAIT_V(8); PG8_WAIT_L(0); PG8_BAR; PG8_MMA(1, 0, At, B0); PG8_MMA(1, 1, At, B1); PG8_BAR; PG8_SCHED;
            } else {
            PG8_LDB(B0, 0, 0); PG8_SCHED; PG8_LDA(At, 0, 0); PG8_STAGE(PG8_SA(1, 1), a1 + hstep, voffA);
            PG8_WAIT_L(8); PG8_BAR; PG8_WAIT_L(0); PG8_MMA(0, 0, At, B0); PG8_BAR; PG8_SCHED;
            PG8_LDB(B1, 0, 1); PG8_STAGE(PG8_SB(0, 0), b2, voffB);
            PG8_BAR; PG8_WAIT_L(0); PG8_MMA(0, 1, At, B1); PG8_BAR;
            PG8_LDA(At, 0, 1); PG8_STAGE(PG8_SA(0, 0), a2, voffA);
            PG8_BAR; PG8_WAIT_L(0); PG8_MMA(1, 0, At, B0); PG8_BAR; PG8_SCHED;
            PG8_STAGE(PG8_SB(0, 1), b2 + hstep, voffB);
            PG8_WAIT_V(6); PG8_BAR; PG8_MMA(1, 1, At, B1); PG8_BAR;
            PG8_LDB(B0, 1, 0); PG8_SCHED; PG8_LDA(At, 1, 0); PG8_STAGE(PG8_SA(0, 1), a2 + hstep, voffA);
            PG8_WAIT_L(8); PG8_BAR; PG8_WAIT_L(0); PG8_MMA(0, 0, At, B0); PG8_BAR; PG8_SCHED;
            PG8_LDB(B1, 1, 1); PG8_STAGE(PG8_SB(1, 0), b3, voffB);
            PG8_BAR; PG8_WAIT_L(0); PG8_MMA(0, 1, At, B1); PG8_BAR;
            PG8_LDA(At, 1, 1); PG8_STAGE(PG8_SA(1, 0), a3, voffA);
            PG8_BAR; PG8_WAIT_L(0); PG8_MMA(1, 0, At, B0); PG8_BAR; PG8_SCHED;
            PG8_STAGE(PG8_SB(1, 1), b3 + hstep, voffB);
            PG8_WAIT_V(6); PG8_BAR; PG8_MMA(1, 1, At, B1); PG8_BAR;
            }
        }
        if constexpr (ALIGN_EPI) { if (wr == 0) PG8_BAR; }
        if constexpr (!Epi::AFTER_DRAIN) { E(acc, cur, wr, wc, fr, fq); S.done(cur); }
        if (!has_next) break;
#pragma unroll
        for (int a = 0; a < 2; ++a)
#pragma unroll
            for (int b = 0; b < 2; ++b)
#pragma unroll
                for (int m = 0; m < 4; ++m)
#pragma unroll
                    for (int n = 0; n < 2; ++n) acc[a][b][m][n] = (f32x4){0.f, 0.f, 0.f, 0.f};
        cur = nxt; cA = nA; cB = nB; ++ui;
        if constexpr (ALIGN_EPI) { if (wr == 1) PG8_BAR; }
    }
    PG8_WAIT_V(0);
    if constexpr (!ALIGN_EPI) { if (wr == 0) PG8_BAR; }
    PG8_BAR;
    if constexpr (Epi::AFTER_DRAIN) { E.fused(acc, cur, wr, wc, fr, fq, lds, wid, lane); S.done(cur); }
#undef PG8_SA
#undef PG8_SB
#undef PG8_STAGE
#undef PG8_LDA
#undef PG8_LDB
#undef PG8_MMA
#undef PG8_WAIT_V
#undef PG8_WAIT_L
#undef PG8_BAR
#undef PG8_SCHED
}
}
namespace pg8 {
struct EpiIn {
    static constexpr bool PERM = true, AFTER_DRAIN = false;
    unsigned char* ws; const PG8_LAS float* gtab;
    __device__ __forceinline__ void operator()(const f32x4 (&acc)[2][2][4][2], const Unit& u, int wr, int wc, int fr, int fq) const {
        const int pn = u.pn; const int row0 = u.pm * BM + wr * 64 + fr;
#define RS(ai, m) 1.f
        if (pn < 16) {
            const int grp = pn >> 1;
            bf16_t* base = (bf16_t*)(ws + WS_QA + (size_t)grp * 64 * MiB) + (pn & 1) * 256 + wc * 64 + 8 * fq;
            if ((grp & 3) < 2) {
                const PG8_LAS float* g = gtab + ((grp >> 2) * 2 + (grp & 1)) * 64; const float sc = (grp & 3) == 0 ? QSCALE : 1.f;
                f32x4 gv[2][2];
#pragma unroll
                for (int bj = 0; bj < 2; ++bj)
#pragma unroll
                    for (int n = 0; n < 2; ++n) gv[bj][n] = *(const PG8_LAS f32x4*)(g + 32 * bj + 8 * fq + 4 * n);
#pragma unroll
                for (int ai = 0; ai < 2; ++ai)
#pragma unroll
                    for (int m = 0; m < 4; ++m) {
                        const float r_ = RS(ai, m); f32x4 y[2][2]; float ss = 0.f;
#pragma unroll
                        for (int bj = 0; bj < 2; ++bj)
#pragma unroll
                            for (int n = 0; n < 2; ++n) { y[bj][n] = acc[ai][bj][m][n] * r_; ss += (y[bj][n][0] * y[bj][n][0] + y[bj][n][1] * y[bj][n][1]) + (y[bj][n][2] * y[bj][n][2] + y[bj][n][3] * y[bj][n][3]); }
                        ss += __shfl_xor(ss, 16); ss += __shfl_xor(ss, 32);
                        const float rn = rsqrtf(ss * (1.f / 64.f) + EPS) * sc;
                        bf16_t* rowp = base + (size_t)(row0 + ai * HALF + m * 16) * 512;
#pragma unroll
                        for (int bj = 0; bj < 2; ++bj) { const f32x4 v0 = y[bj][0] * rn * gv[bj][0], v1 = y[bj][1] * rn * gv[bj][1];
                            u32x4 w; w.x = cvt_pk_bf16(v0[0], v0[1]); w.y = cvt_pk_bf16(v0[2], v0[3]); w.z = cvt_pk_bf16(v1[0], v1[1]); w.w = cvt_pk_bf16(v1[2], v1[3]);
                            *(u32x4*)(rowp + 32 * bj) = w; }
                        asm volatile("" ::: "memory");
                    }
            } else {
#pragma unroll
                for (int ai = 0; ai < 2; ++ai)
#pragma unroll
                    for (int m = 0; m < 4; ++m) { const float r_ = RS(ai, m); bf16_t* rowp = base + (size_t)(row0 + ai * HALF + m * 16) * 512;
#pragma unroll
                        for (int bj = 0; bj < 2; ++bj) { const f32x4 v0 = acc[ai][bj][m][0] * r_, v1 = acc[ai][bj][m][1] * r_;
                            u32x4 w; w.x = cvt_pk_bf16(v0[0], v0[1]); w.y = cvt_pk_bf16(v0[2], v0[3]); w.z = cvt_pk_bf16(v1[0], v1[1]); w.w = cvt_pk_bf16(v1[2], v1[3]);
                            *(u32x4*)(rowp + 32 * bj) = w; } }
            }
        } else if (pn == 16) {
            bf16_t* base = (bf16_t*)(ws + WS_QI) + wc * 64 + 8 * fq;
#pragma unroll
            for (int ai = 0; ai < 2; ++ai)
#pragma unroll
                for (int m = 0; m < 4; ++m) { const float r_ = RS(ai, m); bf16_t* rowp = base + (size_t)(row0 + ai * HALF + m * 16) * 256;
#pragma unroll
                    for (int bj = 0; bj < 2; ++bj) { const f32x4 v0 = acc[ai][bj][m][0] * r_, v1 = acc[ai][bj][m][1] * r_;
                        u32x4 w; w.x = cvt_pk_bf16(v0[0], v0[1]); w.y = cvt_pk_bf16(v0[2], v0[3]); w.z = cvt_pk_bf16(v1[0], v1[1]); w.w = cvt_pk_bf16(v1[2], v1[3]);
                        *(u32x4*)(rowp + 32 * bj) = w; } }
        } else {
            if (wc == 0) {
                bf16_t* base = (bf16_t*)(ws + WS_KI) + 8 * fq;
#pragma unroll
                for (int ai = 0; ai < 2; ++ai)
#pragma unroll
                    for (int m = 0; m < 4; ++m) { const float r_ = RS(ai, m); bf16_t* rowp = base + (size_t)(row0 + ai * HALF + m * 16) * 64;
#pragma unroll
                        for (int bj = 0; bj < 2; ++bj) { const f32x4 v0 = acc[ai][bj][m][0] * r_, v1 = acc[ai][bj][m][1] * r_;
                            u32x4 w; w.x = cvt_pk_bf16(v0[0], v0[1]); w.y = cvt_pk_bf16(v0[2], v0[3]); w.z = cvt_pk_bf16(v1[0], v1[1]); w.w = cvt_pk_bf16(v1[2], v1[3]);
                            *(u32x4*)(rowp + 32 * bj) = w; } }
            } else if (wc == 1) {
                if (fq == 0) {
                    float* wi = (float*)(ws + WS_WI);
#pragma unroll
                    for (int ai = 0; ai < 2; ++ai)
#pragma unroll
                        for (int m = 0; m < 4; ++m) *(f32x4*)(wi + (size_t)(row0 + ai * HALF + m * 16) * 4) = acc[ai][0][m][0] * (RS(ai, m) * IDX_SCALE);
                }
            }
        }
    }
};
#undef RS
struct EpiOut {
    static constexpr bool PERM = false, AFTER_DRAIN = false;
    const float* x; float* out;
    __device__ __forceinline__ void operator()(const f32x4 (&acc)[2][2][4][2], const Unit& u, int wr, int wc, int fr, int fq) const {
        const int row0 = u.pm * BM + wr * 64 + fr, col0 = u.pn * BM + wc * 32 + 4 * fq;
#pragma unroll
        for (int ai = 0; ai < 2; ++ai)
#pragma unroll
            for (int mp = 0; mp < 2; ++mp) {
                f32x4 xin[2][2][2];
#pragma unroll
                for (int mm = 0; mm < 2; ++mm) { const size_t off = (size_t)(row0 + ai * HALF + (2 * mp + mm) * 16) * 1024 + col0;
#pragma unroll
                    for (int bj = 0; bj < 2; ++bj)
#pragma unroll
                        for (int n = 0; n < 2; ++n) xin[mm][bj][n] = *(const f32x4*)(x + off + bj * HALF + n * 16); }
                __builtin_amdgcn_sched_barrier(0);
#pragma unroll
                for (int mm = 0; mm < 2; ++mm) { const size_t off = (size_t)(row0 + ai * HALF + (2 * mp + mm) * 16) * 1024 + col0;
#pragma unroll
                    for (int bj = 0; bj < 2; ++bj)
#pragma unroll
                        for (int n = 0; n < 2; ++n) *(f32x4*)(out + off + bj * HALF + n * 16) = xin[mm][bj][n] + acc[ai][bj][2 * mp + mm][n]; }
                __builtin_amdgcn_sched_barrier(0);
            }
    }
};
}

constexpr int GEMM_LDS = 131072;
namespace att {
using bf16x8 = __attribute__((ext_vector_type(8))) short;
using s16x4 = __attribute__((ext_vector_type(4))) short;
using f32x16 = __attribute__((ext_vector_type(16))) float;
using u32x4 = __attribute__((ext_vector_type(4))) unsigned;
using f32x4 = __attribute__((ext_vector_type(4))) float;
#define ALDS __attribute__((address_space(3)))
typedef ALDS const char* lds_cptr;
typedef ALDS unsigned char* lds_ptr;

constexpr int SLOTB = 8192;
constexpr int LDS_K = 0, LDS_V = 3 * SLOTB, LDS_TAB = 6 * SLOTB, LDS_WS = LDS_TAB + 1024, LDS_OST = LDS_WS + 2048, LDS_BYTES = LDS_OST + 8 * 8192;
constexpr int TABN = 132;

struct Unit { int b, h, kind, dil, rho, u0; };

__device__ __forceinline__ void glds16(const void* gsrc, unsigned lds_dst) { unsigned keep;
    asm volatile("s_mov_b32 %0, m0\n\ts_mov_b32 m0, %2\n\ts_nop 0\n\tglobal_load_lds_dwordx4 %1, off\n\ts_mov_b32 m0, %0" : "=&s"(keep) : "v"(gsrc), "s"(lds_dst) : "memory"); }
__device__ __forceinline__ float cndm(float p, unsigned long long m) { float o; asm("v_cndmask_b32_e64 %0, 0, %1, %2" : "=v"(o) : "v"(p), "s"(m)); return o; }
typedef float f32x2_t __attribute__((ext_vector_type(2))); typedef __bf16 bf16x2_t __attribute__((ext_vector_type(2)));
__device__ __forceinline__ unsigned cvtpk(float lo, float hi) { f32x2_t v = {lo, hi}; bf16x2_t b = __builtin_convertvector(v, bf16x2_t); return __builtin_bit_cast(unsigned, b); }
typedef short v4i16_t __attribute__((ext_vector_type(4)));
__device__ __forceinline__ s16x4 vtr(lds_cptr p) { return __builtin_bit_cast(s16x4, __builtin_amdgcn_ds_read_tr16_b64_v4i16((ALDS v4i16_t*)p)); }
__device__ __forceinline__ float silu(float z) { return z / (1.f + __expf(-z)); }

constexpr int LDS_OSB = LDS_WS + 2048;
constexpr int LDS_CT = LDS_OSB + 8 * 4096;
constexpr int LDS_B_BYTES = LDS_CT + 6 * 8192;
__device__ __forceinline__ void build_ctab(int kind, int h, unsigned char* ws, ALDS unsigned char* shm, int tid) {
    const float* T = (const float*)(ws + WS_ATAB) + (kind * 8 + h) * TABN; const float negb = T[129];
    ALDS float* ct = (ALDS float*)(shm + LDS_CT);
    for (int e = tid; e < 6 * 2048; e += 512) {
        const int c = e & 3, lane = (e >> 2) & 63, g = (e >> 8) & 7, i = e >> 11; const int reg = 4 * g + c, r = reg & 15, r32 = lane & 31, hi = lane >> 5;
        const int j = 32 * i + r32 - 4 * hi - ((r & 3) + 8 * (r >> 2)) - (reg >= 16 ? 32 : 0);
        ct[e] = (j >= 0 && j <= 128) ? T[j] + negb : -1e30f; }
}
__device__ __forceinline__ void unit_start(const Unit U, const bool rebuild, unsigned char* ws, ALDS unsigned char* shm, bf16x8 (&qr)[4], int tid, int lane, int r32, int hi, int wid) {
    const size_t rowbase = (size_t)U.b * SEQ; const int dil = U.dil, rho = U.rho, h = U.h; const unsigned lds0 = (unsigned)(uintptr_t)shm;
    const bf16_t* Qg = (const bf16_t*)(ws + WS_QB) + rowbase * 512 + h * 64; const bf16_t* Kg = (const bf16_t*)(ws + WS_KB) + rowbase * 512 + h * 64; const bf16_t* Vg = (const bf16_t*)(ws + WS_VB) + rowbase * 512 + h * 64;
    const int xw = U.u0 + 32 * wid, kt0 = U.u0 >= 128 ? U.u0 - 128 : 0;
    const bf16_t* ksrc = Kg + ((size_t)(kt0 + 8 * wid + (lane >> 3)) * dil + rho) * 512 + (((lane & 7) ^ ((lane >> 3) & 7)) * 8);
    const bf16_t* vsrc = Vg + ((size_t)(kt0 + 16 * (wid & 3) + (lane >> 2)) * dil + rho) * 512 + (wid >> 2) * 32 + (lane & 3) * 8;
    const size_t tstep = (size_t)64 * dil * 512; const unsigned kdst = lds0 + LDS_K + wid * 1024, vdst = lds0 + LDS_V + wid * 1024;
    glds16(ksrc, (unsigned)__builtin_amdgcn_readfirstlane(kdst)); glds16(vsrc, (unsigned)__builtin_amdgcn_readfirstlane(vdst));
    glds16(ksrc + tstep, (unsigned)__builtin_amdgcn_readfirstlane(kdst + SLOTB)); glds16(vsrc + tstep, (unsigned)__builtin_amdgcn_readfirstlane(vdst + SLOTB));
    const bf16_t* qp = Qg + ((size_t)(xw + r32) * dil + rho) * 512 + hi * 8;
#pragma unroll
    for (int d0 = 0; d0 < 4; ++d0) qr[d0] = *(const bf16x8*)(qp + d0 * 16);
    if (rebuild) build_ctab(U.kind, h, ws, shm, tid);
}
template <int MODE> __device__ __forceinline__ void attn_unit(const Unit U, const bool first, const Unit N, const bool has_next, unsigned char* ws, ALDS unsigned char* shm, bf16x8 (&qr)[4]) {
    int tid_ = threadIdx.x; asm volatile("" : "+v"(tid_));
    const int tid = tid_, lane = tid & 63, r32 = lane & 31, hi = lane >> 5; const int wid = __builtin_amdgcn_readfirstlane(tid >> 6);
    const int dil = U.dil, rho = U.rho, h = U.h; const size_t rowbase = (size_t)U.b * SEQ;
    const bf16_t* Kg = (const bf16_t*)(ws + WS_KB) + rowbase * 512 + h * 64;
    const bf16_t* Vg = (const bf16_t*)(ws + WS_VB) + rowbase * 512 + h * 64;
    const unsigned lds0 = (unsigned)(uintptr_t)shm;
    const int xw = U.u0 + 32 * wid;
    const int kt0 = U.u0 >= 128 ? U.u0 - 128 : 0;
    const int NT = (U.u0 + 256 - kt0) >> 6;
    if (first) unit_start(U, true, ws, shm, qr, tid, lane, r32, hi, wid);
    const bf16_t* ksrc = Kg + ((size_t)(kt0 + 8 * wid + (lane >> 3)) * dil + rho) * 512 + (((lane & 7) ^ ((lane >> 3) & 7)) * 8);
    const bf16_t* vsrc = Vg + ((size_t)(kt0 + 16 * (wid & 3) + (lane >> 2)) * dil + rho) * 512 + (wid >> 2) * 32 + (lane & 3) * 8;
    const size_t tstep = (size_t)64 * dil * 512;
    const unsigned kdst = lds0 + LDS_K + wid * 1024, vdst = lds0 + LDS_V + wid * 1024;
#define ATT_DMA(t, slot) do { glds16(ksrc + (size_t)(t) * tstep, (unsigned)__builtin_amdgcn_readfirstlane(kdst + (slot) * SLOTB)); glds16(vsrc + (size_t)(t) * tstep, (unsigned)__builtin_amdgcn_readfirstlane(vdst + (slot) * SLOTB)); } while (0)
    const lds_cptr kp0 = (lds_cptr)shm + LDS_K + r32 * 128; int kofs[4];
#pragma unroll
    for (int d0 = 0; d0 < 4; ++d0) kofs[d0] = ((2 * d0 + hi) ^ (r32 & 7)) * 16;
    const lds_cptr vp0 = (lds_cptr)shm + LDS_V + ((lane >> 4) & 1) * 32 + (lane & 3) * 8 + (4 * hi + ((lane & 15) >> 2)) * 64;
    const lds_cptr ctp = (lds_cptr)shm + LDS_CT + lane * 16;
    const bf16x8 ones8 = (bf16x8){0x3F80, 0x3F80, 0x3F80, 0x3F80, 0x3F80, 0x3F80, 0x3F80, 0x3F80};
    f32x16 o[3]; o[0] = f32x16{}; o[1] = f32x16{}; o[2] = f32x16{};
    u32x4 eq1[2][2], eq2[2][2], ezz[2][2]; float el[2][2];
    if (MODE == 2) {
#pragma unroll
        for (int d0 = 0; d0 < 2; ++d0)
#pragma unroll
            for (int i = 0; i < 2; ++i) { const int row = i * 16 + (lane >> 2), ch = lane & 3; const size_t tok = rowbase + (size_t)(xw + row) * dil + rho; const int col = h * 64 + d0 * 32 + ch * 8;
                eq1[d0][i] = *(const u32x4*)((const bf16_t*)(ws + WS_PB1) + tok * 512 + col); eq2[d0][i] = *(const u32x4*)((const bf16_t*)(ws + WS_PB2) + tok * 512 + col);
                ezz[d0][i] = *(const u32x4*)((const bf16_t*)(ws + WS_ZB) + tok * 512 + col);
                el[d0][i] = ((const float*)(ws + WS_LB1))[tok * 8 + h] + ((const float*)(ws + WS_LB2))[tok * 8 + h]; }
    }
    int slot = 0;
    for (int t = 0; t < NT; ++t) {
        if (t + 1 < NT) asm volatile("s_waitcnt vmcnt(2) lgkmcnt(0)\n\ts_barrier" ::: "memory");
        else asm volatile("s_waitcnt vmcnt(0) lgkmcnt(0)\n\ts_barrier" ::: "memory");
        if (t + 2 < NT) { const int s2 = slot >= 1 ? slot - 1 : 2; ATT_DMA(t + 2, s2); }
        const int kt = kt0 + 64 * t; const int tau = xw - kt;
        if (tau >= 0 && tau <= 160) {
            f32x16 p0, p1; const lds_cptr cb = ctp + (tau >> 5) * 8192; const lds_cptr kb = kp0 + slot * SLOTB; bf16x8 kfr[8];
#pragma unroll
            for (int d0 = 0; d0 < 4; ++d0) { kfr[2 * d0] = *(const ALDS bf16x8*)(kb + kofs[d0]); kfr[2 * d0 + 1] = *(const ALDS bf16x8*)(kb + kofs[d0] + 4096); }
#pragma unroll
            for (int g = 0; g < 4; ++g) { const f32x4 v0 = *(const ALDS f32x4*)(cb + g * 1024), v1 = *(const ALDS f32x4*)(cb + (4 + g) * 1024);
                p0[4 * g] = v0[0]; p0[4 * g + 1] = v0[1]; p0[4 * g + 2] = v0[2]; p0[4 * g + 3] = v0[3]; p1[4 * g] = v1[0]; p1[4 * g + 1] = v1[1]; p1[4 * g + 2] = v1[2]; p1[4 * g + 3] = v1[3]; }
            __builtin_amdgcn_sched_barrier(0);
#pragma unroll
            for (int d0 = 0; d0 < 4; ++d0) { p0 = __builtin_amdgcn_mfma_f32_32x32x16_bf16(kfr[2 * d0], qr[d0], p0, 0, 0, 0); p1 = __builtin_amdgcn_mfma_f32_32x32x16_bf16(kfr[2 * d0 + 1], qr[d0], p1, 0, 0, 0); }
            __builtin_amdgcn_sched_barrier(0);
            const lds_cptr vp = vp0 + slot * SLOTB; s16x4 vlo[8], vhi[8];
#pragma unroll
            for (int i = 0; i < 8; ++i) { vlo[i] = vtr(vp + ((i >> 2) * 4096 + (i & 3) * 1024)); vhi[i] = vtr(vp + ((i >> 2) * 4096 + (i & 3) * 1024 + 512)); }
            __builtin_amdgcn_sched_barrier(0);
#pragma unroll
            for (int r = 0; r < 16; ++r) { p0[r] = __builtin_amdgcn_exp2f(p0[r]); p1[r] = __builtin_amdgcn_exp2f(p1[r]); }
            u32x4 pw0, pw1, pw2, pw3;
            pw0 = (u32x4){cvtpk(p0[0], p0[1]), cvtpk(p0[2], p0[3]), cvtpk(p0[4], p0[5]), cvtpk(p0[6], p0[7])};
            pw1 = (u32x4){cvtpk(p0[8], p0[9]), cvtpk(p0[10], p0[11]), cvtpk(p0[12], p0[13]), cvtpk(p0[14], p0[15])};
            pw2 = (u32x4){cvtpk(p1[0], p1[1]), cvtpk(p1[2], p1[3]), cvtpk(p1[4], p1[5]), cvtpk(p1[6], p1[7])};
            pw3 = (u32x4){cvtpk(p1[8], p1[9]), cvtpk(p1[10], p1[11]), cvtpk(p1[12], p1[13]), cvtpk(p1[14], p1[15])};
            __builtin_amdgcn_sched_barrier(0);
#define ATT_VF(i) (bf16x8){vlo[i][0], vlo[i][1], vlo[i][2], vlo[i][3], vhi[i][0], vhi[i][1], vhi[i][2], vhi[i][3]}
            o[0] = __builtin_amdgcn_mfma_f32_32x32x16_bf16(__builtin_bit_cast(bf16x8, pw0), ATT_VF(0), o[0], 0, 0, 0); o[1] = __builtin_amdgcn_mfma_f32_32x32x16_bf16(__builtin_bit_cast(bf16x8, pw0), ATT_VF(4), o[1], 0, 0, 0);
            o[2] = __builtin_amdgcn_mfma_f32_32x32x16_bf16(__builtin_bit_cast(bf16x8, pw0), ones8, o[2], 0, 0, 0);
            o[0] = __builtin_amdgcn_mfma_f32_32x32x16_bf16(__builtin_bit_cast(bf16x8, pw1), ATT_VF(1), o[0], 0, 0, 0); o[1] = __builtin_amdgcn_mfma_f32_32x32x16_bf16(__builtin_bit_cast(bf16x8, pw1), ATT_VF(5), o[1], 0, 0, 0);
            o[2] = __builtin_amdgcn_mfma_f32_32x32x16_bf16(__builtin_bit_cast(bf16x8, pw1), ones8, o[2], 0, 0, 0);
            o[0] = __builtin_amdgcn_mfma_f32_32x32x16_bf16(__builtin_bit_cast(bf16x8, pw2), ATT_VF(2), o[0], 0, 0, 0); o[1] = __builtin_amdgcn_mfma_f32_32x32x16_bf16(__builtin_bit_cast(bf16x8, pw2), ATT_VF(6), o[1], 0, 0, 0);
            o[2] = __builtin_amdgcn_mfma_f32_32x32x16_bf16(__builtin_bit_cast(bf16x8, pw2), ones8, o[2], 0, 0, 0);
            o[0] = __builtin_amdgcn_mfma_f32_32x32x16_bf16(__builtin_bit_cast(bf16x8, pw3), ATT_VF(3), o[0], 0, 0, 0); o[1] = __builtin_amdgcn_mfma_f32_32x32x16_bf16(__builtin_bit_cast(bf16x8, pw3), ATT_VF(7), o[1], 0, 0, 0);
            o[2] = __builtin_amdgcn_mfma_f32_32x32x16_bf16(__builtin_bit_cast(bf16x8, pw3), ones8, o[2], 0, 0, 0);
#undef ATT_VF
            __builtin_amdgcn_sched_barrier(0);
        }
        slot = slot == 2 ? 0 : slot + 1;
    }
    asm volatile("s_waitcnt lgkmcnt(0)\n\ts_barrier" ::: "memory");
    bf16x8 qrn[4];
#pragma unroll
    for (int d0 = 0; d0 < 4; ++d0) qrn[d0] = qr[d0];
    if (has_next) unit_start(N, (N.kind != U.kind) || (N.h != U.h), ws, shm, qrn, tid, lane, r32, hi, wid);
    ALDS float* stg = (ALDS float*)(shm + LDS_OSB) + wid * 1024;
    ALDS float* wsf = (ALDS float*)(shm + LDS_WS) + wid * 64;
    if (r32 == 0) {
#pragma unroll
        for (int r = 0; r < 16; ++r) wsf[(r & 3) + 8 * (r >> 2) + 4 * hi] = o[2][r]; }
#pragma unroll
    for (int d0 = 0; d0 < 2; ++d0) {
#pragma unroll
        for (int r = 0; r < 16; ++r) { const int orow = (r & 3) + 8 * (r >> 2) + 4 * hi; stg[orow * 32 + r32] = o[d0][r]; }
        asm volatile("s_waitcnt lgkmcnt(0)" ::: "memory");
#pragma unroll
        for (int i = 0; i < 2; ++i) {
            const int row = i * 16 + (lane >> 2), ch = lane & 3; const size_t tok = rowbase + (size_t)(xw + row) * dil + rho; const int col = h * 64 + d0 * 32 + ch * 8;
            const f32x4 a0 = *(const ALDS f32x4*)(stg + row * 32 + ch * 8), a1 = *(const ALDS f32x4*)(stg + row * 32 + ch * 8 + 4);
            float v[8] = {a0[0], a0[1], a0[2], a0[3], a1[0], a1[1], a1[2], a1[3]};
            float l = wsf[row];
            if (MODE == 1) {
                bf16_t* pb = (bf16_t*)(ws + (U.kind == 1 ? WS_PB1 : WS_PB2)); float* lp = (float*)(ws + (U.kind == 1 ? WS_LB1 : WS_LB2));
                u32x4 w; w.x = cvtpk(v[0], v[1]); w.y = cvtpk(v[2], v[3]); w.z = cvtpk(v[4], v[5]); w.w = cvtpk(v[6], v[7]);
                *(u32x4*)(pb + tok * 512 + col) = w; if (d0 == 0 && ch == 0) lp[tok * 8 + h] = l;
            } else {
                const u32x4 q1 = eq1[d0][i], q2 = eq2[d0][i]; l += el[d0][i];
#pragma unroll
                for (int e = 0; e < 4; ++e) { v[2 * e] += __uint_as_float(q1[e] << 16) + __uint_as_float(q2[e] << 16); v[2 * e + 1] += __uint_as_float(q1[e] & 0xffff0000u) + __uint_as_float(q2[e] & 0xffff0000u); }
                const u32x4 zz = ezz[d0][i]; const float rl = 1.f / l;
#pragma unroll
                for (int e = 0; e < 4; ++e) { v[2 * e] *= rl * silu(__uint_as_float(zz[e] << 16)); v[2 * e + 1] *= rl * silu(__uint_as_float(zz[e] & 0xffff0000u)); }
                u32x4 w; w.x = cvtpk(v[0], v[1]); w.y = cvtpk(v[2], v[3]); w.z = cvtpk(v[4], v[5]); w.w = cvtpk(v[6], v[7]);
                *(u32x4*)((bf16_t*)(ws + WS_MIX) + tok * 1024 + 512 + col) = w;
            }
        }
        asm volatile("s_waitcnt lgkmcnt(0)" ::: "memory");
    }
#undef ATT_DMA
#pragma unroll
    for (int d0 = 0; d0 < 4; ++d0) qr[d0] = qrn[d0];
}
#define SBAR() __builtin_amdgcn_sched_barrier(0)
#define PIN(x) asm volatile("" : "+v"(x))
#define MFMA32(a, b, c) __builtin_amdgcn_mfma_f32_32x32x16_bf16(a, b, c, 0, 0, 0)
__device__ __forceinline__ void kload2(bf16x8* kf, lds_cptr kp, int d0) { kf[2 * d0] = *(const ALDS bf16x8*)(kp + d0 * 2048); kf[2 * d0 + 1] = *(const ALDS bf16x8*)(kp + d0 * 2048 + 512); }
#define MEXP(X, MW, BIT) do { float e_ = __builtin_amdgcn_exp2f(X); int m_; asm("v_bfe_i32 %1, %2, %3, 1\n\tv_and_b32 %0, %0, %1" : "+v"(e_), "=&v"(m_) : "v"(MW), "n"(BIT)); X = e_; } while (0)
__device__ __forceinline__ void bias_near(f32x16& c0, f32x16& c1, const ALDS float* tab, int jb) {
#pragma unroll
    for (int r = 0; r < 16; ++r) { const int c = (r & 3) + 8 * (r >> 2); unsigned j0 = (unsigned)(jb - c), j1 = (unsigned)(jb - c - 32); j0 = j0 < 128u ? j0 : 128u; j1 = j1 < 128u ? j1 : 128u; c0[r] += tab[j0]; c1[r] += tab[j1]; }
}
#define MEXP4(X, i, MW, B0) do { float e0_ = __builtin_amdgcn_exp2f(X[i]), e1_ = __builtin_amdgcn_exp2f(X[(i) + 1]), e2_ = __builtin_amdgcn_exp2f(X[(i) + 2]), e3_ = __builtin_amdgcn_exp2f(X[(i) + 3]); int m0_, m1_, m2_, m3_; \
    asm("v_bfe_i32 %4, %8, %9, 1\n\tv_bfe_i32 %5, %8, %10, 1\n\tv_bfe_i32 %6, %8, %11, 1\n\tv_bfe_i32 %7, %8, %12, 1\n\tv_and_b32 %0, %0, %4\n\tv_and_b32 %1, %1, %5\n\tv_and_b32 %2, %2, %6\n\tv_and_b32 %3, %3, %7" \
        : "+v"(e0_), "+v"(e1_), "+v"(e2_), "+v"(e3_), "=&v"(m0_), "=&v"(m1_), "=&v"(m2_), "=&v"(m3_) : "v"(MW), "n"(B0), "n"((B0) + 1), "n"((B0) + 2), "n"((B0) + 3)); \
    X[i] = e0_; X[(i) + 1] = e1_; X[(i) + 2] = e2_; X[(i) + 3] = e3_; } while (0)
__device__ __forceinline__ void attn_unit_a(int b, int h, int qb, const bool load_tab, unsigned char* ws, lds_ptr shm) {
    int tid_ = threadIdx.x; asm volatile("" : "+v"(tid_));
    const int tid = tid_, lane = tid & 63, r32 = lane & 31, hi = lane >> 5; const int wid = __builtin_amdgcn_readfirstlane(tid >> 6);
    const size_t rowbase = (size_t)b * SEQ; const int u0 = qb * 256, NT = 4 * qb + 4, xw = u0 + 32 * wid;
    const bf16_t* Qg = (const bf16_t*)(ws + WS_QA) + rowbase * 512 + h * 64;
    const bf16_t* Kg = (const bf16_t*)(ws + WS_KA) + rowbase * 512 + h * 64;
    const bf16_t* Vg = (const bf16_t*)(ws + WS_VA) + rowbase * 512 + h * 64;
    const unsigned lds0 = (unsigned)(uintptr_t)shm;
    ALDS float* tab = (ALDS float*)(shm + LDS_TAB);
    if (load_tab) { const float tv = ((const float*)(ws + WS_ATAB))[h * TABN + (tid < TABN ? tid : TABN - 1)]; if (tid < TABN) tab[tid] = tv; }
    const bf16_t* ksrc = Kg + (size_t)lane * 512 + wid * 8;
    const bf16_t* vsrc = Vg + (size_t)(16 * (wid & 3) + (lane >> 2)) * 512 + (wid >> 2) * 32 + (lane & 3) * 8;
    const unsigned kdst = lds0 + LDS_K + wid * 1024, vdst = lds0 + LDS_V + wid * 1024;
#define DMA_K(t, slot) glds16(ksrc + (size_t)(t) * 64 * 512, (unsigned)__builtin_amdgcn_readfirstlane(kdst + (slot)))
#define DMA_V(t, slot) glds16(vsrc + (size_t)(t) * 64 * 512, (unsigned)__builtin_amdgcn_readfirstlane(vdst + (slot)))
    const lds_cptr vp0 = (lds_cptr)shm + LDS_V + ((lane >> 4) & 1) * 32 + (lane & 3) * 8 + (4 * hi + ((lane & 15) >> 2)) * 64;
    const lds_cptr kp0 = (lds_cptr)shm + LDS_K + hi * 1024 + r32 * 16;
    const unsigned* mp = (const unsigned*)(ws + WS_MASK) + (((size_t)b * 128 + (xw >> 5)) * 64) * 64 + lane;
#define MLOAD(dst, tt) asm volatile("global_load_dword %0, %1, off" : "=v"(dst) : "v"(mp + (size_t)(tt) * 64) : "memory")
#define WAIT_BAR(N) asm volatile("s_waitcnt vmcnt(" #N ") lgkmcnt(0)\n\ts_barrier" ::: "memory")
#define WAIT_BAR_P(N, mw) do { asm volatile("s_waitcnt vmcnt(" #N ") lgkmcnt(0)\n\ts_barrier" ::: "memory"); asm volatile("" : "+v"(mw)); } while (0)
    unsigned mwA, mwB;
    DMA_K(0, 0); MLOAD(mwA, 0); DMA_V(0, 0); DMA_K(1, SLOTB);
    bf16x8 qr[4];
    { const bf16_t* qp = Qg + (size_t)(xw + r32) * 512 + hi * 8;
#pragma unroll
      for (int d0 = 0; d0 < 4; ++d0) qr[d0] = *(const bf16x8*)(qp + d0 * 16); }
    const f32x16 zero16 = f32x16{}; const bf16x8 ones8 = (bf16x8){0x3F80, 0x3F80, 0x3F80, 0x3F80, 0x3F80, 0x3F80, 0x3F80, 0x3F80};
    f32x16 o[2]; o[0] = f32x16{}; o[1] = f32x16{}; float l_reg = 0.f;
    f32x16 pA0, pA1, pB0, pB1; bf16x8 kf[8]; s16x4 vlo[8], vhi[8]; u32x4 pw0, pw1, pw2, pw3;
    int sl_prev = 0, sl_cur = 0, sl_next = SLOTB;
#define ROT() do { sl_prev = sl_cur; sl_cur = sl_next; sl_next = (sl_next == 2 * SLOTB) ? 0 : sl_next + SLOTB; } while (0)
    DMA_K(2, 2 * SLOTB);
    WAIT_BAR_P(1, mwA);
    const int jb0 = xw + r32 - 4 * hi;
    _Pragma("unroll") for (int d0 = 0; d0 < 4; ++d0) kload2(kf, kp0, d0);
    pA0 = MFMA32(kf[0], qr[0], zero16); pA1 = MFMA32(kf[1], qr[0], zero16); pA0 = MFMA32(kf[2], qr[1], pA0); pA1 = MFMA32(kf[3], qr[1], pA1);
    pA0 = MFMA32(kf[4], qr[2], pA0); pA1 = MFMA32(kf[5], qr[2], pA1); pA0 = MFMA32(kf[6], qr[3], pA0); pA1 = MFMA32(kf[7], qr[3], pA1);
    if (63 > xw - 128) bias_near(pA0, pA1, tab, jb0);
    MEXP4(pA0, 0, mwA, 0); MEXP4(pA0, 4, mwA, 4); MEXP4(pA0, 8, mwA, 8); MEXP4(pA0, 12, mwA, 12); MEXP4(pA1, 0, mwA, 16); MEXP4(pA1, 4, mwA, 20); MEXP4(pA1, 8, mwA, 24); MEXP4(pA1, 12, mwA, 28);
    WAIT_BAR(0);
    MLOAD(mwB, 1); DMA_K(3, 0); DMA_V(1, SLOTB); ROT();
    _Pragma("unroll") for (int d0 = 0; d0 < 4; ++d0) kload2(kf, kp0 + sl_cur, d0);
    WAIT_BAR_P(2, mwB);
#define PKW(P, i) cvtpk(P[i], P[i + 1])
#define PAF(k) __builtin_bit_cast(bf16x8, pw##k)
#define VFR(i) (bf16x8){vlo[i][0], vlo[i][1], vlo[i][2], vlo[i][3], vhi[i][0], vhi[i][1], vhi[i][2], vhi[i][3]}
#define VRD(i) do { vlo[i] = vtr(vp_ + (((i) >> 2) * 4096 + ((i) & 3) * 1024)); vhi[i] = vtr(vp_ + (((i) >> 2) * 4096 + ((i) & 3) * 1024 + 512)); } while (0)
#define KRD(G, d0) do { if (G) { kload2(kf, kp0 + sl_next, d0); SBAR(); } } while (0)
#define GAPA(MF, a0, a1, a2, a3, W0, W1, PW) do { MF; sacc += a0; sacc += a1; sacc += a2; sacc += a3; W0; W1; PIN(PW); PIN(sacc); SBAR(); } while (0)
#define GAPB(MF, X, i, MW, bo) do { MF; MEXP4(X, i, MW, (bo) + (i)); PIN(X); SBAR(); } while (0)
#define GAPO(k) do { o[2] = MFMA32(PAF(k), ones8, o[2]); SBAR(); } while (0)
#define STEP(C0, C1, P0, P1, t, EDGE, GK, GV, GL, MWC, MWN) do { SBAR(); \
    if (GV) MLOAD(MWN, (t) + 1); \
    const lds_cptr vp_ = vp0 + sl_prev; \
    VRD(0); SBAR(); float sacc = P0[0] + P0[1]; \
                    GAPA(C0 = MFMA32(kf[0], qr[0], zero16), P0[2], P0[3], P0[4], P0[5],     pw0[0] = PKW(P0, 0),  pw0[1] = PKW(P0, 2),  pw0); \
    VRD(4); SBAR(); GAPA(C1 = MFMA32(kf[1], qr[0], zero16), P0[6], P0[7], P0[8], P0[9],     pw0[2] = PKW(P0, 4),  pw0[3] = PKW(P0, 6),  pw0); \
    VRD(1); SBAR(); GAPA(C0 = MFMA32(kf[2], qr[1], C0),   P0[10], P0[11], P0[12], P0[13], pw1[0] = PKW(P0, 8),  pw1[1] = PKW(P0, 10), pw1); \
    VRD(5); SBAR(); GAPA(C1 = MFMA32(kf[3], qr[1], C1),   P0[14], P0[15], P1[0], P1[1],   pw1[2] = PKW(P0, 12), pw1[3] = PKW(P0, 14), pw1); \
    VRD(2); SBAR(); GAPA(C0 = MFMA32(kf[4], qr[2], C0),   P1[2], P1[3], P1[4], P1[5],     pw2[0] = PKW(P1, 0),  pw2[1] = PKW(P1, 2),  pw2); \
    VRD(6); SBAR(); GAPA(C1 = MFMA32(kf[5], qr[2], C1),   P1[6], P1[7], P1[8], P1[9],     pw2[2] = PKW(P1, 4),  pw2[3] = PKW(P1, 6),  pw2); \
    VRD(3); SBAR(); GAPA(C0 = MFMA32(kf[6], qr[3], C0),   P1[10], P1[11], P1[12], P1[13], pw3[0] = PKW(P1, 8),  pw3[1] = PKW(P1, 10), pw3); \
    VRD(7); SBAR(); GAPA(C1 = MFMA32(kf[7], qr[3], C1),   P1[14], P1[15], 0.f, 0.f,       pw3[2] = PKW(P1, 12), pw3[3] = PKW(P1, 14), pw3); \
    l_reg += sacc; \
    if (GK) DMA_K((t) + 3, sl_cur); if (GV) DMA_V((t) + 1, sl_next); \
    if (EDGE) { const int kt_ = 64 * (t); if (kt_ + 63 > xw - 128) bias_near(C0, C1, tab, jb0 - kt_); if (kt_ > xw + 31) MWC = 0u; } \
    SBAR(); \
    GAPB(o[0] = MFMA32(PAF(0), VFR(0), o[0]), C0, 0, MWC, 0);              GAPB(o[1] = MFMA32(PAF(0), VFR(4), o[1]), C0, 4, MWC, 0); \
    KRD(GL, 0); GAPB(o[0] = MFMA32(PAF(1), VFR(1), o[0]), C0, 8, MWC, 0);  KRD(GL, 1); GAPB(o[1] = MFMA32(PAF(1), VFR(5), o[1]), C0, 12, MWC, 0); \
    KRD(GL, 2); GAPB(o[0] = MFMA32(PAF(2), VFR(2), o[0]), C1, 0, MWC, 16); KRD(GL, 3); GAPB(o[1] = MFMA32(PAF(2), VFR(6), o[1]), C1, 4, MWC, 16); \
    GAPB(o[0] = MFMA32(PAF(3), VFR(3), o[0]), C1, 8, MWC, 16);             GAPB(o[1] = MFMA32(PAF(3), VFR(7), o[1]), C1, 12, MWC, 16); \
    } while (0)
    int t = 1;
    for (; t + 7 < NT; t += 2) {
        STEP(pB0, pB1, pA0, pA1, t, false, true, true, true, mwB, mwA);     WAIT_BAR_P(2, mwA); ROT();
        STEP(pA0, pA1, pB0, pB1, t + 1, false, true, true, true, mwA, mwB); WAIT_BAR_P(2, mwB); ROT();
    }
#define ENDW(tt, mw) do { if ((tt) + 3 < NT) { WAIT_BAR(2); } else if ((tt) + 2 < NT) { WAIT_BAR(1); } else { WAIT_BAR(0); } asm volatile("" : "+v"(mw)); } while (0)
    for (; t + 1 < NT; t += 2) {
        STEP(pB0, pB1, pA0, pA1, t, true, (t + 3 < NT), (t + 1 < NT), (t + 1 < NT), mwB, mwA);         ENDW(t, mwA);     ROT();
        STEP(pA0, pA1, pB0, pB1, t + 1, true, (t + 4 < NT), (t + 2 < NT), (t + 2 < NT), mwA, mwB);     ENDW(t + 1, mwB); ROT();
    }
    STEP(pB0, pB1, pA0, pA1, NT - 1, true, false, false, false, mwB, mwA);
    { float sacc = pB0[0] + pB0[1];
#pragma unroll
      for (int r = 2; r < 16; ++r) sacc += pB0[r];
#pragma unroll
      for (int r = 0; r < 16; ++r) sacc += pB1[r];
      l_reg += sacc;
      pw0 = (u32x4){PKW(pB0, 0), PKW(pB0, 2), PKW(pB0, 4), PKW(pB0, 6)}; pw1 = (u32x4){PKW(pB0, 8), PKW(pB0, 10), PKW(pB0, 12), PKW(pB0, 14)};
      pw2 = (u32x4){PKW(pB1, 0), PKW(pB1, 2), PKW(pB1, 4), PKW(pB1, 6)}; pw3 = (u32x4){PKW(pB1, 8), PKW(pB1, 10), PKW(pB1, 12), PKW(pB1, 14)};
      const lds_cptr vp_ = vp0 + sl_cur; _Pragma("unroll") for (int i = 0; i < 8; ++i) VRD(i);
      o[0] = MFMA32(PAF(0), VFR(0), o[0]); o[1] = MFMA32(PAF(0), VFR(4), o[1]); o[0] = MFMA32(PAF(1), VFR(1), o[0]); o[1] = MFMA32(PAF(1), VFR(5), o[1]);
      o[0] = MFMA32(PAF(2), VFR(2), o[0]); o[1] = MFMA32(PAF(2), VFR(6), o[1]); o[0] = MFMA32(PAF(3), VFR(3), o[0]); o[1] = MFMA32(PAF(3), VFR(7), o[1]); }
    asm volatile("s_waitcnt lgkmcnt(0)\n\ts_barrier" ::: "memory");
    u32x4 zzv[4];
#pragma unroll
    for (int i = 0; i < 4; ++i) { const int row = i * 8 + (lane >> 3), ch = lane & 7; zzv[i] = *(const u32x4*)((const bf16_t*)(ws + WS_ZA) + (rowbase + (size_t)(xw + row)) * 512 + h * 64 + ch * 8); }
    { auto rr = __builtin_amdgcn_permlane32_swap(__float_as_uint(l_reg), __float_as_uint(l_reg), false, false); l_reg = __uint_as_float(rr[0]) + __uint_as_float(rr[1]); }
    ALDS float* wsf = (ALDS float*)(shm + LDS_WS) + wid * 64;
    ALDS float* stg = (ALDS float*)(shm + LDS_OST) + wid * 2048;
    if (hi == 0) wsf[r32] = l_reg;
#pragma unroll
    for (int r = 0; r < 16; ++r) { const int orow = (r & 3) + 8 * (r >> 2) + 4 * hi; stg[orow * 64 + r32] = o[0][r]; stg[orow * 64 + 32 + r32] = o[1][r]; }
    asm volatile("s_waitcnt lgkmcnt(0)" ::: "memory");
#pragma unroll
    for (int i = 0; i < 4; ++i) {
        const int row = i * 8 + (lane >> 3), ch = lane & 7; const size_t tok = rowbase + (size_t)(xw + row); const int col = h * 64 + ch * 8;
        const f32x4 a0 = *(const ALDS f32x4*)(stg + row * 64 + ch * 8), a1 = *(const ALDS f32x4*)(stg + row * 64 + ch * 8 + 4); const float rl = 1.f / wsf[row];
        float v[8] = {a0[0], a0[1], a0[2], a0[3], a1[0], a1[1], a1[2], a1[3]};
        const u32x4 zz = zzv[i];
#pragma unroll
        for (int e = 0; e < 4; ++e) { v[2 * e] *= rl * silu(__uint_as_float(zz[e] << 16)); v[2 * e + 1] *= rl * silu(__uint_as_float(zz[e] & 0xffff0000u)); }
        u32x4 w; w.x = cvtpk(v[0], v[1]); w.y = cvtpk(v[2], v[3]); w.z = cvtpk(v[4], v[5]); w.w = cvtpk(v[6], v[7]);
        *(u32x4*)((bf16_t*)(ws + WS_MIX) + tok * 1024 + col) = w;
    }
    asm volatile("s_waitcnt lgkmcnt(0)\n\ts_barrier" ::: "memory");
#undef DMA_K
#undef DMA_V
#undef MLOAD
#undef WAIT_BAR
#undef WAIT_BAR_P
#undef ROT
#undef PKW
#undef PAF
#undef VFR
#undef VRD
#undef KRD
#undef GAPA
#undef GAPB
#undef GAPO
#undef STEP
#undef ENDW
}
}

__device__ __forceinline__ int vcu_of_block() { const int G = gridDim.x, bx = blockIdx.x; return (G % 8 == 0) ? (bx % 8) * (G / 8) + bx / 8 : bx; }

__device__ __forceinline__ void phase_attn_a(unsigned char* ws, att::lds_ptr shm) {
    const int G = gridDim.x;
    int prev_h = -1;
    for (int id = vcu_of_block(); id < 2048; id += G) {
        const int i = id >> 8, v = id & 255, bh = v >> 1, half = v & 1, s = i >> 1; const int qb = (i & 1) ? 15 - (2 * s + half) : 2 * s + half;
        att::attn_unit_a(bh >> 3, bh & 7, qb, (bh & 7) != prev_h, ws, shm); prev_h = bh & 7;
    }
}
__device__ __forceinline__ att::Unit unit_b12(int id) { const int blk = id >> 8, v = id & 255, bh = v >> 1, half = v & 1; return att::Unit{bh >> 3, bh & 7, 1 + half, half ? 4 : 1, half ? (blk >> 2) : 0, half ? (blk & 3) * 256 : blk * 256}; }
__device__ __forceinline__ void phase_attn_b12(unsigned char* ws, att::lds_ptr shm) {
    const int G = gridDim.x; att::bf16x8 qr[4]; bool first = true;
    for (int id = vcu_of_block(); id < 4096; id += G) { const bool hn = id + G < 4096;
        att::attn_unit<1>(unit_b12(id), first, unit_b12(hn ? id + G : id), hn, ws, shm, qr); first = false; }
}
__device__ __forceinline__ att::Unit unit_b3(int id) { const int i = id >> 8, v = id & 255, bh = v >> 1, half = v & 1; return att::Unit{bh >> 3, bh & 7, 3, 16, half * 8 + i, 0}; }
__device__ __forceinline__ void phase_attn_b3(unsigned char* ws, att::lds_ptr shm) {
    const int G = gridDim.x; att::bf16x8 qr[4]; bool first = true;
    for (int id = vcu_of_block(); id < 2048; id += G) { const bool hn = id + G < 2048;
        att::attn_unit<2>(unit_b3(id), first, unit_b3(hn ? id + G : id), hn, ws, shm, qr); first = false; }
}
namespace tk {
using bf16x8 = __attribute__((ext_vector_type(8))) short;
using f32x16 = __attribute__((ext_vector_type(16))) float;
using u32x4 = __attribute__((ext_vector_type(4))) unsigned;
#define TLDS __attribute__((address_space(3)))
typedef TLDS unsigned char* lds_ptr;
constexpr int CAP = 384;
constexpr int HSTR = 1028;
constexpr int L_HIST = 0;
constexpr int L_LIST = 0;
constexpr int L_ZB = 98304;
constexpr int L_IMG = 114688;
constexpr int L_H2 = 131584;
constexpr int L_SC = 139776;
constexpr int L_FB = 0;
constexpr int LDS_BYTES = 140800;

__device__ __forceinline__ unsigned mono(float s) { const unsigned u = __float_as_uint(s); return (u & 0x80000000u) ? ~u : (u | 0x80000000u); }

__device__ __forceinline__ float relu_i(float x) { const int xi = __float_as_int(x); return __int_as_float(xi > 0 ? xi : 0); }
__device__ __forceinline__ void load_kf(bf16x8 (&kf)[4], const bf16_t* __restrict__ KIb, int j, int r32, int hi) {
    const bf16_t* kp = KIb + (size_t)(32 * j + r32) * 64 + hi * 8;
#pragma unroll
    for (int s = 0; s < 4; ++s) kf[s] = *(const bf16x8*)(kp + s * 16);
}
__device__ __forceinline__ f32x16 bscore(const bf16x8 (&kf)[4], const bf16x8 (&qf)[4][4], const float (&w)[4]) {
    f32x16 B;
#pragma unroll
    for (int r = 0; r < 16; ++r) B[r] = 512.f;
#pragma unroll
    for (int h = 0; h < 4; ++h) {
        f32x16 a;
#pragma unroll
        for (int r = 0; r < 16; ++r) a[r] = 0.f;
#pragma unroll
        for (int s = 0; s < 4; ++s) a = __builtin_amdgcn_mfma_f32_32x32x16_bf16(kf[s], qf[h][s], a, 0, 0, 0);
#pragma unroll
        for (int r = 0; r < 16; ++r) B[r] = fmaf(w[h], relu_i(a[r]), B[r]);
    }
    return B;
}
template <bool DIAG> __device__ __forceinline__ void p1_block(const f32x16& B, TLDS unsigned* hrow, int r32, int hi) {
#pragma unroll
    for (int r = 0; r < 16; ++r) { const int c = (r & 3) + 8 * (r >> 2) + 4 * hi; const int bin = (int)__builtin_amdgcn_fmed3f(B[r], 0.f, 1023.5f);
        if (!DIAG || c <= r32) __hip_atomic_fetch_add(hrow + bin, 1u, __ATOMIC_RELAXED, __HIP_MEMORY_SCOPE_WORKGROUP); }
}
__device__ __forceinline__ void img_set(TLDS unsigned* img, unsigned ql, unsigned idx) {
    const unsigned kk = idx & 31u, r = (kk & 3u) | ((kk >> 3) << 2), hh = (kk >> 2) & 1u;
    __hip_atomic_fetch_or(img + (idx >> 6) * 64u + ql + 32u * hh, 1u << (16u * ((idx >> 5) & 1u) + r), __ATOMIC_RELAXED, __HIP_MEMORY_SCOPE_WORKGROUP);
}
template <bool DIAG> __device__ __forceinline__ void p2_block(const f32x16& B, int j, float mylo, float myhi, unsigned kbase, bool ztie, int lane, int r32, int hi, TLDS unsigned* img, TLDS unsigned long long* lists, TLDS unsigned* ccnt, TLDS unsigned* zb) {
    unsigned bits = 0u; bool anyc = false;
#pragma unroll
    for (int r = 0; r < 16; ++r) { const int c = (r & 3) + 8 * (r >> 2) + 4 * hi; const bool ok = !DIAG || c <= r32; const bool def = ok && (B[r] >= myhi); anyc |= ok && !def && (B[r] >= mylo);
        bits |= def ? (1u << r) : 0u; }
    ((TLDS unsigned short*)img)[((j >> 1) * 64 + lane) * 2 + (j & 1)] = (unsigned short)bits;
    if (__any(anyc)) {
#pragma unroll
        for (int r = 0; r < 16; ++r) { const int c = (r & 3) + 8 * (r >> 2) + 4 * hi; const bool ok = !DIAG || c <= r32;
            if (ok && (B[r] >= mylo) && !(B[r] >= myhi)) { unsigned jb_ = (unsigned)(32 * j + 4 * hi); asm volatile("" : "+v"(jb_));
                const unsigned idx = jb_ + (unsigned)((r & 3) + 8 * (r >> 2));
                if (ztie && B[r] == 512.f) __hip_atomic_fetch_or(zb + r32 * 128 + (idx >> 5), 1u << (idx & 31u), __ATOMIC_RELAXED, __HIP_MEMORY_SCOPE_WORKGROUP);
                else { const unsigned slot = __hip_atomic_fetch_add(ccnt + r32, 1u, __ATOMIC_RELAXED, __HIP_MEMORY_SCOPE_WORKGROUP);
                    if (slot < (unsigned)CAP) lists[r32 * CAP + slot] = ((unsigned long long)(mono(B[r]) - kbase) << 12) | (unsigned long long)(4095u - idx); } } }
    }
}

__device__ __forceinline__ void topk_unit(int b, int qb32, unsigned char* ws, lds_ptr shm) {
    int tid_ = threadIdx.x; asm volatile("" : "+v"(tid_));
    const int tid = tid_, lane = tid & 63, r32 = lane & 31, hi = lane >> 5; const int wid = __builtin_amdgcn_readfirstlane(tid >> 6);
    const int q0 = 32 * qb32, nkb = qb32 + 1; const size_t rowbase = (size_t)b * SEQ;
    const bf16_t* KIb = (const bf16_t*)(ws + WS_KI) + rowbase * 64;
    TLDS unsigned* hist = (TLDS unsigned*)(shm + L_HIST); TLDS unsigned long long* lists = (TLDS unsigned long long*)(shm + L_LIST); TLDS unsigned* img = (TLDS unsigned*)(shm + L_IMG);
    TLDS unsigned* h2 = (TLDS unsigned*)(shm + L_H2); TLDS float* tlo = (TLDS float*)(shm + L_SC); TLDS float* thi = tlo + 32; TLDS int* needv = (TLDS int*)(thi + 32); TLDS unsigned* ccnt = (TLDS unsigned*)(needv + 32); TLDS unsigned* zb = (TLDS unsigned*)(shm + L_ZB);
    { TLDS u32x4* hz = (TLDS u32x4*)hist;
#pragma unroll
      for (int i = 0; i < 16; ++i) hz[tid + 512 * i] = (u32x4){0u, 0u, 0u, 0u};
      if (tid < 32) hz[8192 + tid] = (u32x4){0u, 0u, 0u, 0u}; }
    if (tid < 32) ccnt[tid] = 0u;
    bf16x8 qf[4][4]; float w[4];
    { const bf16_t* qp = (const bf16_t*)(ws + WS_QI) + (rowbase + q0 + r32) * 256 + hi * 8;
#pragma unroll
      for (int h = 0; h < 4; ++h)
#pragma unroll
          for (int s = 0; s < 4; ++s) qf[h][s] = *(const bf16x8*)(qp + h * 64 + s * 16);
      const float4 wv = *(const float4*)((const float*)(ws + WS_WI) + (rowbase + q0 + r32) * 4);
      float n2[4];
#pragma unroll
      for (int h = 0; h < 4; ++h) { float a = 0.f;
#pragma unroll
          for (int s2 = 0; s2 < 4; ++s2)
#pragma unroll
              for (int e = 0; e < 8; ++e) { const float v = bf2f((bf16_t)qf[h][s2][e]); a = fmaf(v, v, a); }
          n2[h] = a + __shfl_xor(a, 32); }
      const float S2 = wv.x * wv.x * n2[0] + wv.y * wv.y * n2[1] + wv.z * wv.z * n2[2] + wv.w * wv.w * n2[3];
      const float g = S2 > 1e-30f ? 128.f * rsqrtf(S2) : 0.f; w[0] = wv.x * g; w[1] = wv.y * g; w[2] = wv.z * g; w[3] = wv.w * g; }
    __syncthreads();
    { bf16x8 kf[4], kn[4]; int j = wid; if (j < nkb) load_kf(kf, KIb, j, r32, hi); TLDS unsigned* hrow = hist + r32 * HSTR;
      for (; j < nkb; j += 8) {
        const bool more = j + 8 < nkb; if (more) load_kf(kn, KIb, j + 8, r32, hi);
        const f32x16 B = bscore(kf, qf, w);
        if (j == qb32) p1_block<true>(B, hrow, r32, hi); else p1_block<false>(B, hrow, r32, hi);
        if (more) {
#pragma unroll
            for (int s2 = 0; s2 < 4; ++s2) kf[s2] = kn[s2]; }
      } }
    __syncthreads();
    { const int q = tid >> 4, sub = tid & 15; const TLDS unsigned* hq = hist + q * HSTR; unsigned csum = 0u;
#pragma unroll
      for (int i = 0; i < 16; ++i) { const u32x4 v = *(const TLDS u32x4*)(hq + 64 * sub + 4 * i); csum += (v.x + v.y) + (v.z + v.w); }
      unsigned incl = csum;
#pragma unroll
      for (int off = 1; off < 16; off <<= 1) { const unsigned t = __shfl_down(incl, off, 16); if (sub + off < 16) incl += t; }
      const unsigned total = __shfl(incl, 0, 16); unsigned above = incl - csum;
      const bool f1 = (above < 256u) && (above + csum >= 256u);
      const unsigned long long bal1 = __ballot(f1); const unsigned g1 = (unsigned)(bal1 >> (16 * ((lane >> 4) & 3))) & 0xffffu;
      if (total < 256u || g1 == 0u) { if (sub == 0) { tlo[q] = -INFINITY; thi[q] = -INFINITY; needv[q] = 0; } }
      else {
          const int cst = __builtin_ctz(g1); const unsigned ab1 = __shfl(above, cst, 16);
          const u32x4 v = *(const TLDS u32x4*)(hq + 64 * cst + 4 * sub); const unsigned c4 = (v.x + v.y) + (v.z + v.w); unsigned in2 = c4;
#pragma unroll
          for (int off = 1; off < 16; off <<= 1) { const unsigned t = __shfl_down(in2, off, 16); if (sub + off < 16) in2 += t; }
          unsigned ab2 = ab1 + (in2 - c4);
          if ((ab2 < 256u) && (ab2 + c4 >= 256u)) { int bs;
              if (ab2 + v.w >= 256u) bs = 3; else { ab2 += v.w; if (ab2 + v.z >= 256u) bs = 2; else { ab2 += v.z; if (ab2 + v.y >= 256u) bs = 1; else { ab2 += v.y; bs = 0; } } }
              const int bstar = 64 * cst + 4 * sub + bs;
              tlo[q] = bstar <= 0 ? -INFINITY : (float)bstar; thi[q] = bstar >= 1023 ? INFINITY : (float)(bstar + 1); needv[q] = 256 - (int)ab2; }
      }
    }
    __syncthreads();
    if (tid < 64) img[(qb32 >> 1) * 64 + tid] = 0u;
    { TLDS u32x4* zz = (TLDS u32x4*)zb; zz[tid] = (u32x4){0u, 0u, 0u, 0u}; zz[tid + 512] = (u32x4){0u, 0u, 0u, 0u}; }
    __syncthreads();
    { const float mylo = tlo[r32], myhi = thi[r32]; const unsigned kbase = (mylo == -INFINITY) ? 0u : mono(mylo); const bool ztie = (mylo == 512.f);
      bf16x8 kf[4], kn[4]; int j = wid; if (j < nkb) load_kf(kf, KIb, j, r32, hi);
      for (; j < nkb; j += 8) {
        const bool more = j + 8 < nkb; if (more) load_kf(kn, KIb, j + 8, r32, hi);
        const f32x16 B = bscore(kf, qf, w);
        if (j == qb32) p2_block<true>(B, j, mylo, myhi, kbase, ztie, lane, r32, hi, img, lists, ccnt, zb); else p2_block<false>(B, j, mylo, myhi, kbase, ztie, lane, r32, hi, img, lists, ccnt, zb);
        if (more) {
#pragma unroll
            for (int s2 = 0; s2 < 4; ++s2) kf[s2] = kn[s2]; }
      } }
    __syncthreads();
    { const int q = 4 * wid + (lane >> 4), sub = lane & 15; const unsigned craw = ccnt[q]; const int C = craw > (unsigned)CAP ? CAP : (int)craw; int need = (craw > (unsigned)CAP) ? 0 : needv[q];
      int needz = 0; if (need > C) { needz = need - C; need = C; }
      int cm = C; cm = max(cm, __shfl_xor(cm, 16)); cm = max(cm, __shfl_xor(cm, 32));
      const TLDS unsigned long long* list = lists + q * CAP; TLDS unsigned* hq = h2 + q * 64; unsigned long long prefix = 0ull;
      unsigned long long cr[8]; unsigned long long kmax = 0ull;
#pragma unroll
      for (int e = 0; e < 8; ++e) { const int i = sub + 16 * e; cr[e] = (i < C) ? list[i] : ~0ull; if (i < C) kmax = kmax > cr[e] ? kmax : cr[e]; }
      for (int i = sub + 128; i < cm; i += 16) if (i < C) { const unsigned long long ck = list[i]; kmax = kmax > ck ? kmax : ck; }
#pragma unroll
      for (int o = 1; o < 64; o <<= 1) { const unsigned long long t = __shfl_xor(kmax, o); kmax = kmax > t ? kmax : t; }
      const int nb = 64 - __builtin_clzll(kmax | 1ull); const int L = (nb + 5) / 6;
      for (int level = 0; level < L; ++level) {
          const int shift = 6 * (L - 1 - level);
          *(TLDS u32x4*)(hq + 4 * sub) = (u32x4){0u, 0u, 0u, 0u};
          asm volatile("s_waitcnt lgkmcnt(0)" ::: "memory");
#pragma unroll
          for (int e = 0; e < 8; ++e) { const unsigned long long ck = cr[e]; if (ck != ~0ull && (ck >> (shift + 6)) == prefix) __hip_atomic_fetch_add(hq + (unsigned)((ck >> shift) & 63ull), 1u, __ATOMIC_RELAXED, __HIP_MEMORY_SCOPE_WORKGROUP); }
          for (int i = sub + 128; i < cm; i += 32) { const bool v0 = i < C, v1 = i + 16 < C; const unsigned long long k0 = v0 ? list[i] : 0ull, k1 = v1 ? list[i + 16] : 0ull;
              if (v0 && (k0 >> (shift + 6)) == prefix) __hip_atomic_fetch_add(hq + (unsigned)((k0 >> shift) & 63ull), 1u, __ATOMIC_RELAXED, __HIP_MEMORY_SCOPE_WORKGROUP);
              if (v1 && (k1 >> (shift + 6)) == prefix) __hip_atomic_fetch_add(hq + (unsigned)((k1 >> shift) & 63ull), 1u, __ATOMIC_RELAXED, __HIP_MEMORY_SCOPE_WORKGROUP); }
          asm volatile("s_waitcnt lgkmcnt(0)" ::: "memory");
          const u32x4 v = *(const TLDS u32x4*)(hq + 4 * sub); const unsigned c4 = (v.x + v.y) + (v.z + v.w); unsigned incl = c4;
#pragma unroll
          for (int off = 1; off < 16; off <<= 1) { const unsigned t = __shfl_down(incl, off, 16); if (sub + off < 16) incl += t; }
          unsigned ab = incl - c4; const bool f = need > 0 && ab < (unsigned)need && ab + c4 >= (unsigned)need;
          int d = 0;
          if (f) { if (ab + v.w >= (unsigned)need) d = 3; else { ab += v.w; if (ab + v.z >= (unsigned)need) d = 2; else { ab += v.z; if (ab + v.y >= (unsigned)need) d = 1; else { ab += v.y; d = 0; } } } d += 4 * sub; }
          const unsigned long long bal = __ballot(f); const unsigned g = (unsigned)(bal >> (16 * ((lane >> 4) & 3))) & 0xffffu;
          if (g != 0u) { const int src = __builtin_ctz(g); d = __shfl(d, src, 16); const unsigned abn = __shfl(ab, src, 16); need -= (int)abn; prefix = (prefix << 6) | (unsigned long long)d; }
          else { need = 0; prefix = (prefix << 6); }
      }
      if (need > 0) {
#pragma unroll
          for (int e = 0; e < 8; ++e) { const unsigned long long ck = cr[e];
              if (ck != ~0ull && ck >= prefix) { img_set(img, (unsigned)(q & 31), 4095u - (unsigned)(ck & 4095ull)); } }
          for (int i = sub + 128; i < C; i += 16) { const unsigned long long ck = list[i];
              if (ck >= prefix) { img_set(img, (unsigned)(q & 31), 4095u - (unsigned)(ck & 4095ull)); } }
      }
      if (__any(needz > 0)) {
          unsigned wv[8]; unsigned pc = 0u; const TLDS unsigned* zq = zb + q * 128 + 8 * sub;
#pragma unroll
          for (int e = 0; e < 8; ++e) { wv[e] = needz > 0 ? zq[e] : 0u; pc += __popc(wv[e]); }
          unsigned incl = pc;
#pragma unroll
          for (int off = 1; off < 16; off <<= 1) { const unsigned t = __shfl_up(incl, off, 16); if (sub >= off) incl += t; }
          unsigned below = incl - pc;
#pragma unroll
          for (int e = 0; e < 8; ++e) { unsigned w_ = wv[e];
              while (w_ != 0u && below < (unsigned)needz) { const unsigned bpos = (unsigned)__builtin_ctz(w_); w_ &= w_ - 1u; ++below;
                  img_set(img, (unsigned)(q & 31), 256u * sub + 32u * e + bpos); }
              below += __popc(w_); }
      }
    }
    __syncthreads();
    const unsigned ovf = (unsigned)__ballot(lane < 32 && ccnt[lane & 31] > (unsigned)CAP);
    for (int ql = 0; ql < 32; ++ql) {
        if (!((ovf >> ql) & 1u)) continue;
        __syncthreads();
        TLDS float* fsc = (TLDS float*)(shm + L_FB); TLDS unsigned* fh = (TLDS unsigned*)(shm + L_FB + 16384); TLDS unsigned* ftot = fh + 256; TLDS unsigned* fmisc = ftot + 16; TLDS float* fq = (TLDS float*)(fmisc + 16);
        const int q = q0 + ql, n = q + 1; const bf16_t* qrow = (const bf16_t*)(ws + WS_QI) + (rowbase + q) * 256; const float* wq = (const float*)(ws + WS_WI) + (rowbase + q) * 4;
        if (tid < 256) fq[tid] = bf2f(qrow[tid]);
        const float w0 = wq[0], w1 = wq[1], w2 = wq[2], w3 = wq[3];
        if (tid == 0) { fmisc[0] = 0u; fmisc[1] = 256u; }
        __syncthreads();
        for (int k = tid; k < n; k += 512) { const uint4* kr = (const uint4*)(KIb + (size_t)k * 64); float r0 = 0.f, r1 = 0.f, r2 = 0.f, r3 = 0.f;
#pragma unroll 2
            for (int c = 0; c < 8; ++c) { const uint4 v = kr[c]; const unsigned u[4] = {v.x, v.y, v.z, v.w};
#pragma unroll
                for (int e = 0; e < 4; ++e) { const float a = __uint_as_float(u[e] << 16), bq = __uint_as_float(u[e] & 0xffff0000u); const int d = 8 * c + 2 * e;
                    r0 = fmaf(fq[d], a, r0); r0 = fmaf(fq[d + 1], bq, r0); r1 = fmaf(fq[64 + d], a, r1); r1 = fmaf(fq[64 + d + 1], bq, r1);
                    r2 = fmaf(fq[128 + d], a, r2); r2 = fmaf(fq[128 + d + 1], bq, r2); r3 = fmaf(fq[192 + d], a, r3); r3 = fmaf(fq[192 + d + 1], bq, r3); } }
            fsc[k] = fmaf(w3, fmaxf(r3, 0.f), fmaf(w2, fmaxf(r2, 0.f), fmaf(w1, fmaxf(r1, 0.f), fmaf(w0, fmaxf(r0, 0.f), 0.f)))); }
        __syncthreads();
        for (int pass = 3; pass >= 0; --pass) { const int shift = pass * 8; if (tid < 256) fh[tid] = 0u; __syncthreads();
            const unsigned pfx = fmisc[0], nd = fmisc[1], himask = (pass == 3) ? 0u : (0xffffffffu << (shift + 8));
            for (int k = tid; k < n; k += 512) { const unsigned key = mono(fsc[k]); if ((key & himask) == pfx) __hip_atomic_fetch_add(fh + ((key >> shift) & 255u), 1u, __ATOMIC_RELAXED, __HIP_MEMORY_SCOPE_WORKGROUP); }
            __syncthreads();
            unsigned c = 0u, incl = 0u;
            if (tid < 256) { c = fh[tid]; incl = c;
#pragma unroll
                for (int off = 1; off < 64; off <<= 1) { const unsigned t = __shfl_down(incl, off, 64); if (lane + off < 64) incl += t; }
                if (lane == 0) ftot[wid] = incl; }
            __syncthreads();
            if (tid < 256) { unsigned above = incl - c; for (int w2_ = wid + 1; w2_ < 4; ++w2_) above += ftot[w2_];
                if (above < nd && above + c >= nd) { fmisc[0] = pfx | ((unsigned)tid << shift); fmisc[1] = nd - above; } }
            __syncthreads(); }
        const unsigned T = fmisc[0], nd = fmisc[1];
        unsigned myties = 0u;
        for (int i = 0; i < 8; ++i) { const int k = tid * 8 + i; if (k < n && mono(fsc[k]) == T) ++myties; }
        unsigned inc2 = myties;
#pragma unroll
        for (int off = 1; off < 64; off <<= 1) { const unsigned t = __shfl_up(inc2, off, 64); if (lane >= off) inc2 += t; }
        if (lane == 63) ftot[8 + wid] = inc2;
        __syncthreads();
        unsigned before = inc2 - myties; for (int w2_ = 0; w2_ < wid; ++w2_) before += ftot[8 + w2_];
        for (int i = 0; i < 8; ++i) { const int k = tid * 8 + i; if (k >= n) break; const unsigned key = mono(fsc[k]); bool sel;
            if (key > T) sel = true; else if (key == T) { sel = before < nd; ++before; } else sel = false;
            const unsigned kk = (unsigned)k & 31u, r = (kk & 3u) | ((kk >> 3) << 2), hh = (kk >> 2) & 1u; TLDS unsigned* wp = img + ((unsigned)k >> 6) * 64u + (unsigned)ql + 32u * hh; const unsigned bm = 1u << (16u * (((unsigned)k >> 5) & 1u) + r);
            if (sel) __hip_atomic_fetch_or(wp, bm, __ATOMIC_RELAXED, __HIP_MEMORY_SCOPE_WORKGROUP); else __hip_atomic_fetch_and(wp, ~bm, __ATOMIC_RELAXED, __HIP_MEMORY_SCOPE_WORKGROUP); }
        __syncthreads();
    }
    { const int nchunk = ((qb32 >> 1) + 1) * 16; u32x4* dst = (u32x4*)((unsigned*)(ws + WS_MASK) + (((size_t)b * 128 + qb32) * 64) * 64); const TLDS u32x4* src = (const TLDS u32x4*)img;
      for (int i = tid; i < nchunk; i += 512) dst[i] = src[i]; }
    __syncthreads();
}
}

__device__ __forceinline__ void phase_topk(unsigned char* ws, tk::lds_ptr shm) {
    const int G = gridDim.x;
    for (int id = vcu_of_block(); id < 2048; id += G) {
        const int i = id >> 8, v = id & 255, b = v >> 4, s = v & 15; const int qb = (i & 1) ? 127 - (16 * (i >> 1) + s) : 16 * (i >> 1) + s;
        tk::topk_unit(b, qb, ws, shm);
    }
}
constexpr int MEGA_LDS = 147456;
#define LAS __attribute__((address_space(3)))
#define XB_TMO      128
#define XB_XCNT(j)  (256  + 64 * (j))
#define XB_XSUB(j)  (1280 + 64 * (j))
#define XB_XGEN(j)  (2304 + 64 * (j))
#define XB_TOP      3328
#define XB_TOPGEN   3392
#define XCD_BAR_WORDS 3456
#define XB_SPIN_CAP (1u << 18)

__device__ __forceinline__ unsigned xb_ld(unsigned* p)              { return __hip_atomic_load(p, __ATOMIC_RELAXED, __HIP_MEMORY_SCOPE_AGENT); }
__device__ __forceinline__ unsigned xb_add(unsigned* p, unsigned v) { return __hip_atomic_fetch_add(p, v, __ATOMIC_RELAXED, __HIP_MEMORY_SCOPE_AGENT); }
__device__ __forceinline__ unsigned xb_xcc_id() { return (unsigned)__builtin_amdgcn_s_getreg((3 << 11) | 20) & 0xFu; }
#define XB_SPIN(cond, bar) do { unsigned _sp = 0; while (cond) { __builtin_amdgcn_s_sleep(1); \
    if ((++_sp & 255u) == 0u) { if (xb_ld(&(bar)[XB_TMO])) break; if (_sp > XB_SPIN_CAP) { atomicAdd(&(bar)[XB_TMO], 1u); break; } } } } while (0)

struct XcdBarrier {
    unsigned* bar; unsigned x;
    volatile LAS unsigned* st;
};

__device__ __forceinline__ XcdBarrier xcd_barrier_post(unsigned* bar, volatile LAS unsigned* st) {
    XcdBarrier b; b.bar = bar; b.x = xb_xcc_id(); b.st = st;
    if (threadIdx.x == 0) (void)xb_add(&bar[XB_XCNT(b.x)], 1u);
    return b;
}
__device__ __forceinline__ void xcd_barrier_complete(unsigned* bar, unsigned x, unsigned& nloc, unsigned& nx) {
    const unsigned G = gridDim.x * gridDim.y * gridDim.z;
    unsigned sum, cnt, mine, sp = 0u;
    for (;;) {
        sum = 0u; cnt = 0u; mine = 0u;
#pragma unroll
        for (unsigned j = 0; j < 16; ++j) { const unsigned c = xb_ld(&bar[XB_XCNT(j)]); sum += c; cnt += (c > 0u) ? 1u : 0u; mine = (j == x) ? c : mine; }
        if (sum == G) break;
        __builtin_amdgcn_s_sleep(1);
        if ((++sp & 255u) == 0u) { if (xb_ld(&bar[XB_TMO])) break; if (sp > XB_SPIN_CAP) { atomicAdd(&bar[XB_TMO], 1u); break; } }
    }
    nloc = mine > 0u ? mine : 1u; nx = cnt > 0u ? cnt : 1u;
}

__device__ __forceinline__ void xcd_barrier(const XcdBarrier& b) {
    asm volatile("s_waitcnt vmcnt(0)" ::: "memory");
    __syncthreads();
    if (threadIdx.x == 0) {
        unsigned* bar = b.bar;
        __builtin_amdgcn_s_waitcnt(0);
        unsigned nloc = b.st[0], nx = b.st[1];
        if (nloc == 0u) { xcd_barrier_complete(bar, b.x, nloc, nx); b.st[0] = nloc; b.st[1] = nx; }
        const unsigned old = xb_add(&bar[XB_XSUB(b.x)], 1u);
        const unsigned gen = old / nloc;
        if (old + 1u == (gen + 1u) * nloc) {
            __builtin_amdgcn_fence(__ATOMIC_RELEASE, "agent");
            asm volatile("s_waitcnt vmcnt(0)" ::: "memory");
            const unsigned og = xb_add(&bar[XB_TOP], 1u);
            const unsigned tg = og / nx;
            if (og + 1u == (tg + 1u) * nx) xb_add(&bar[XB_TOPGEN], 1u);
            else XB_SPIN(xb_ld(&bar[XB_TOPGEN]) == tg, bar);
            __builtin_amdgcn_fence(__ATOMIC_ACQUIRE, "agent");
            xb_add(&bar[XB_XGEN(b.x)], 1u);
            asm volatile("s_waitcnt vmcnt(0)" ::: "memory");
        } else {
            XB_SPIN(xb_ld(&bar[XB_XGEN(b.x)]) == gen, bar);
            __builtin_amdgcn_fence(__ATOMIC_ACQUIRE, "agent");
            asm volatile("s_waitcnt vmcnt(0)" ::: "memory");
        }
    }
    __syncthreads();
}
struct MegaArgs { const float* x; const float* gain; const float* w_in; const float* w_out; const float* rel_bias; const float* gqa; const float* gka; const float* gqb; const float* gkb; float* out; unsigned char* ws; };
#define XCD_SYNC() xcd_barrier(xbar)
__global__ __launch_bounds__(512, 2) void mega_fwd(MegaArgs a) {
    extern __shared__ __attribute__((aligned(16))) unsigned char smem[];
    unsigned char* ws = a.ws;
    volatile LAS unsigned* MISC = (volatile LAS unsigned*)((LAS unsigned char*)smem + MEGA_LDS - 64);
    if (threadIdx.x < 16) MISC[threadIdx.x] = 0u;
    __syncthreads();
    XcdBarrier xbar = xcd_barrier_post((unsigned*)(ws + WS_CTL + 16384), MISC);
    { const size_t gid = (size_t)blockIdx.x * 512 + threadIdx.x, gsz = (size_t)gridDim.x * 512; const int wv = __builtin_amdgcn_readfirstlane(threadIdx.x >> 6);
      prep_w_body(gid, gsz, a.w_in, a.gain, a.w_out, a.rel_bias, (bf16_t*)(ws + WS_WTI), (bf16_t*)(ws + WS_WTO), (float*)(ws + WS_TAB), (int*)(ws + WS_TAB + 4096), a.gqa, a.gka, a.gqb, a.gkb, (float*)(ws + WS_GTAB), (float*)(ws + WS_ATAB));
      prep_weights((int)(gid >> 6), (int)(gsz >> 6), threadIdx.x & 63, a.w_in, a.gain, a.w_out, (bf16_t*)(ws + WS_WTI), (bf16_t*)(ws + WS_WTO), (__attribute__((address_space(3))) float*)(smem + wv * 16384));
      prep_x_body((int)(gid >> 6), (int)(gsz >> 6), threadIdx.x & 63, a.x, (bf16_t*)(ws + WS_XB), (float*)(ws + WS_RSTD)); }
    XCD_SYNC();
    { pg8::Gemm g{(const bf16_t*)(ws + WS_XB), (const bf16_t*)(ws + WS_WTI), M_TOK, NPHYS, 1024}; pg8::StaticOrder S; S.init(M_TOK, NPHYS, gridDim.x, blockIdx.x);
      PG8_LAS float* gl = (PG8_LAS float*)((PG8_LAS unsigned char*)smem + 131072);
      if (threadIdx.x < 256) gl[threadIdx.x] = threadIdx.x < 64 ? a.gqa[threadIdx.x] : threadIdx.x < 128 ? a.gka[threadIdx.x - 64] : threadIdx.x < 192 ? a.gqb[threadIdx.x - 128] : a.gkb[threadIdx.x - 192];
      __syncthreads();
      pg8::EpiIn E{ws, gl};
      pg8::gemm_phase<pg8::EpiIn, pg8::StaticOrder, true, true>((PG8_LAS unsigned char*)smem, g, S, E); }
    XCD_SYNC();
    phase_topk(ws, (tk::lds_ptr)smem);
    phase_attn_b12(ws, (att::lds_ptr)smem);
    XCD_SYNC();
    phase_attn_a(ws, (att::lds_ptr)smem);
    phase_attn_b3(ws, (att::lds_ptr)smem);
    XCD_SYNC();
    { pg8::Gemm g{(const bf16_t*)(ws + WS_MIX), (const bf16_t*)(ws + WS_WTO), M_TOK, 1024, 1024}; pg8::StaticOrder S; S.init(M_TOK, 1024, gridDim.x, blockIdx.x);
      pg8::EpiOut E{a.x, a.out};
      pg8::gemm_phase<pg8::EpiOut, pg8::StaticOrder, true, true>((PG8_LAS unsigned char*)smem, g, S, E); }
}

extern "C" void kernel_launch(void* const* d_in, const int* in_sizes, int n_in, void* d_out, int out_size, void* d_ws, size_t ws_size, hipStream_t stream) {
    static int grid_blocks = 0;
    if (grid_blocks == 0) {
        if (n_in != 9 || ws_size < WS_END) { fprintf(stderr, "kernel_launch: unexpected inputs (n_in %d, ws %zu)\n", n_in, ws_size); grid_blocks = -1; return; }
        int dev = 0, cus = 0, per_cu = 0;
        (void)hipGetDevice(&dev); (void)hipDeviceGetAttribute(&cus, hipDeviceAttributeMultiprocessorCount, dev);
        (void)hipFuncSetAttribute((const void*)mega_fwd, hipFuncAttributeMaxDynamicSharedMemorySize, MEGA_LDS);
        (void)hipOccupancyMaxActiveBlocksPerMultiprocessor(&per_cu, (const void*)mega_fwd, 512, MEGA_LDS);
        if (per_cu < 1) { fprintf(stderr, "kernel_launch: occupancy query says %d blocks per CU\n", per_cu); per_cu = 1; }
        grid_blocks = cus;
    }
    if (grid_blocks < 0) return;
    (void)hipMemsetAsync((unsigned char*)d_ws + WS_CTL, 0, 65536, stream);
    MegaArgs a{};
    a.x = (const float*)d_in[0]; a.gain = (const float*)d_in[1]; a.w_in = (const float*)d_in[2]; a.w_out = (const float*)d_in[3]; a.rel_bias = (const float*)d_in[4];
    a.gqa = (const float*)d_in[5]; a.gka = (const float*)d_in[6]; a.gqb = (const float*)d_in[7]; a.gkb = (const float*)d_in[8]; a.out = (float*)d_out; a.ws = (unsigned char*)d_ws;
    hipLaunchKernelGGL(mega_fwd, dim3(grid_blocks), dim3(512), MEGA_LDS, stream, a);
    const hipError_t e = hipPeekAtLastError();
    if (e != hipSuccess) fprintf(stderr, "launch failed: %s (grid %d)\n", hipGetErrorString(e), grid_blocks);
}
```

```cpp
#include <hip/hip_runtime.h>
#include <stdint.h>
#include <cstdio>

typedef unsigned short bf16_t;

constexpr int D_MODEL = 1024, BATCH = 16, SEQ = 4096, M_TOK = BATCH * SEQ;
constexpr int NPHYS = 4608;
constexpr float EPS = 1e-6f;
constexpr float LOG2E = 1.4426950408889634f;
constexpr float QSCALE = 0.125f * LOG2E;
constexpr float IDX_SCALE = 0.0625f;

constexpr size_t MiB = 1u << 20;
constexpr size_t WS_CTL = 0;
constexpr size_t WS_WTI = 2 * MiB;
constexpr size_t WS_WTO = 11 * MiB;
constexpr size_t WS_TAB = 13 * MiB;
constexpr size_t WS_GTAB = WS_TAB + 32768;
constexpr size_t WS_ATAB = WS_TAB + 65536;
constexpr size_t WS_RSTD = 14 * MiB;
constexpr size_t WS_WI = 15 * MiB;
constexpr size_t WS_XB = 16 * MiB;
constexpr size_t WS_MIX = WS_XB;
constexpr size_t WS_QA = 144 * MiB, WS_KA = 208 * MiB, WS_VA = 272 * MiB, WS_ZA = 336 * MiB;
constexpr size_t WS_QB = 400 * MiB, WS_KB = 464 * MiB, WS_VB = 528 * MiB, WS_ZB = 592 * MiB;
constexpr size_t WS_QI = 656 * MiB;
constexpr size_t WS_KI = 688 * MiB;
constexpr size_t WS_MASK = 696 * MiB;
constexpr size_t WS_GM = 728 * MiB;
constexpr size_t WS_PB1 = 760 * MiB, WS_PB2 = 824 * MiB;
constexpr size_t WS_LB1 = 888 * MiB, WS_LB2 = 890 * MiB;
constexpr size_t WS_END = 892 * MiB;

__device__ __forceinline__ float bf2f(bf16_t v) { return __uint_as_float(((unsigned)v) << 16); }
__device__ __forceinline__ bf16_t f2bf(float f) { unsigned u = __float_as_uint(f); return (bf16_t)((u + 0x7fffu + ((u >> 16) & 1u)) >> 16); }

__host__ __device__ __forceinline__ int logical_of_phys(int p) { const int tile = p >> 8, pc = p & 255, bj = pc >> 7, wc = (pc >> 5) & 3, w = pc & 31; return tile * 256 + 64 * wc + 32 * bj + w; }
__host__ __device__ __forceinline__ int src_col_of_logical(int L) {
    if (L < 2048) return L;
    if (L < 4096) return 2372 + (L - 2048);
    if (L < 4352) return 2048 + (L - 4096);
    if (L < 4416) return 2304 + (L - 4352);
    if (L < 4420) return 2368 + (L - 4416);
    return -1;
}
__device__ __forceinline__ int crow(int r, int hi) { return (r & 3) + 8 * (r >> 2) + 4 * hi; }
__device__ __forceinline__ size_t mask_word_index(int b, int q, int k, int& bit) {
    const int qb = q >> 5, kb = k >> 5, kk = k & 31; const int r = (kk & 3) | ((kk >> 3) << 2), hi = (kk >> 2) & 1;
    bit = (q & 31) + 32 * hi;
    return (((size_t)b * 128 + qb) * 128 + kb) * 16 + r;
}

__device__ __forceinline__ void prep_w_body(size_t gid, size_t gsz, const float* __restrict__ w_in, const float* __restrict__ gain, const float* __restrict__ w_out, const float* __restrict__ rel_bias,
                         bf16_t* WTI, bf16_t* WTO, float* bias2, int* bucket, const float* gqa, const float* gka, const float* gqb, const float* gkb, float* gtab, float* atab) {
    for (size_t i = gid; i < 512; i += gsz) bias2[i] = rel_bias[i] * LOG2E;
    for (size_t i = gid; i < 256; i += gsz) { const int w = (int)(i >> 6), d = (int)(i & 63); gtab[i] = w == 0 ? gqa[d] : w == 1 ? gka[d] : w == 2 ? gqb[d] : gkb[d]; }
    for (size_t i = gid; i < 4096; i += gsz) { const int d = (int)i; int bk;
        if (d < 16) bk = d; else { const float df = (float)d; int lg = 16 + (int)(logf(df / 16.f) / logf(8.f) * 16.f); bk = lg < 31 ? lg : 31; }
        bucket[i] = bk; }
    for (size_t e = gid; e < (size_t)32 * 132; e += gsz) { const int kh = (int)(e / 132), j = (int)(e % 132), kind = kh >> 3, h = kh & 7, dil = kind <= 1 ? 1 : (kind == 2 ? 4 : 16), hoff = kind == 0 ? 0 : 8;
        const float far = rel_bias[31 * 16 + hoff + h] * LOG2E; float v = 0.f;
        if (j <= 128) { const int d = j * dil; int bk; if (d < 16) bk = d; else if (d >= 128) bk = 31; else { int lg = 16 + (int)(logf((float)d / 16.f) / logf(8.f) * 16.f); bk = lg < 31 ? lg : 31; }
            v = rel_bias[bk * 16 + hoff + h] * LOG2E - far; }
        else if (j == 129) { float mx = 0.f; for (int bk = 0; bk < 32; ++bk) mx = fmaxf(mx, rel_bias[bk * 16 + hoff + h] * LOG2E - far);
            const float* gq = kind == 0 ? gqa : gqb; const float* gk = kind == 0 ? gka : gkb; float qm = 0.f, km = 0.f;
            for (int d = 0; d < 64; ++d) { qm = fmaxf(qm, fabsf(gq[d])); km = fmaxf(km, fabsf(gk[d])); }
            v = -(64.f * QSCALE * qm * km * 1.02f + mx); }
        atab[e] = v; }
}

__device__ __forceinline__ void prep_x_body(int wave, int nw, int lane, const float* __restrict__ x, bf16_t* XB, float* RSTD) {
    for (int m4 = wave * 4; m4 < M_TOK; m4 += nw * 4) {
        float4 v[4][4]; float s[4];
#pragma unroll
        for (int rr = 0; rr < 4; ++rr) { const float4* xr = (const float4*)(x + (size_t)(m4 + rr) * 1024) + lane;
#pragma unroll
            for (int j = 0; j < 4; ++j) v[rr][j] = xr[64 * j]; }
#pragma unroll
        for (int rr = 0; rr < 4; ++rr) { float a = 0.f;
#pragma unroll
            for (int j = 0; j < 4; ++j) a += v[rr][j].x * v[rr][j].x + v[rr][j].y * v[rr][j].y + v[rr][j].z * v[rr][j].z + v[rr][j].w * v[rr][j].w;
            s[rr] = a; }
#pragma unroll
        for (int o = 1; o < 64; o <<= 1) {
#pragma unroll
            for (int rr = 0; rr < 4; ++rr) s[rr] += __shfl_xor(s[rr], o); }
#pragma unroll
        for (int rr = 0; rr < 4; ++rr) { uint2* o2 = (uint2*)(XB + (size_t)(m4 + rr) * 1024) + lane; const float rs = rsqrtf(s[rr] * (1.f / 1024.f) + EPS);
#pragma unroll
            for (int j = 0; j < 4; ++j) { uint2 w; w.x = f2bf(v[rr][j].x * rs) | ((unsigned)f2bf(v[rr][j].y * rs) << 16); w.y = f2bf(v[rr][j].z * rs) | ((unsigned)f2bf(v[rr][j].w * rs) << 16); o2[64 * j] = w; } }
    }
}

__device__ __forceinline__ void transpose_item(const float* __restrict__ W, int ldw, int src_col0, int nvalid, const float* __restrict__ gain, bf16_t* WTrow0, int k0, __attribute__((address_space(3))) float* scr, int lane) {
    { const int n = lane & 31; const bool ok = src_col0 >= 0 && n < nvalid; const float* wp = W + (size_t)(k0 + (lane >> 5)) * ldw + (ok ? src_col0 + n : 0); float v[32];
#pragma unroll
      for (int i = 0; i < 32; ++i) v[i] = ok ? wp[(size_t)(2 * i) * ldw] : 0.f;
      float gg[32];
#pragma unroll
      for (int i = 0; i < 32; ++i) gg[i] = gain ? gain[k0 + 2 * i + (lane >> 5)] : 1.f;
#pragma unroll
      for (int i = 0; i < 32; ++i) scr[(2 * i + (lane >> 5)) * 33 + n] = v[i] * gg[i]; }
    asm volatile("s_waitcnt lgkmcnt(0)" ::: "memory");
    const int c = lane & 7;
#pragma unroll
    for (int j = 0; j < 4; ++j) { const int n = (lane >> 3) + 8 * j; const __attribute__((address_space(3))) float* s = scr + (8 * c) * 33 + n;
        uint4 o; o.x = f2bf(s[0 * 33]) | ((unsigned)f2bf(s[1 * 33]) << 16); o.y = f2bf(s[2 * 33]) | ((unsigned)f2bf(s[3 * 33]) << 16); o.z = f2bf(s[4 * 33]) | ((unsigned)f2bf(s[5 * 33]) << 16); o.w = f2bf(s[6 * 33]) | ((unsigned)f2bf(s[7 * 33]) << 16);
        *(uint4*)(WTrow0 + (size_t)n * 1024 + k0 + 8 * c) = o; }
    asm volatile("s_waitcnt lgkmcnt(0)" ::: "memory");
}
__device__ __forceinline__ void prep_weights(int gw, int ngw, int lane, const float* __restrict__ w_in, const float* __restrict__ gain, const float* __restrict__ w_out, bf16_t* WTI, bf16_t* WTO, __attribute__((address_space(3))) float* scr) {
    for (int it = gw; it < 2816; it += ngw) {
        if (it < 2304) { const int ng = it >> 4, kg = it & 15; const int L0 = logical_of_phys(ng * 32); const int src0 = src_col_of_logical(L0); const int nvalid = (L0 == 4416) ? 4 : 32;
            transpose_item(w_in, 4420, src0, nvalid, gain, WTI + (size_t)(ng * 32) * 1024, kg * 64, scr, lane); }
        else { const int r = it - 2304, ng = r >> 4, kg = r & 15; transpose_item(w_out, 1024, ng * 32, 32, nullptr, WTO + (size_t)(ng * 32) * 1024, kg * 64, scr, lane); }
    }
}
namespace pg8 {
#define PG8_LAS __attribute__((address_space(3)))
typedef unsigned short bf16_t;
typedef short bf16x8 __attribute__((ext_vector_type(8)));
typedef float f32x4 __attribute__((ext_vector_type(4)));
typedef unsigned u32x4 __attribute__((ext_vector_type(4)));
constexpr int BM = 256, BK = 64, HALF = 128, HTB = HALF * BK * 2  , STAGE_BYTES = 8 * HTB, NXCD = 8, WGM = 8;

__host__ __device__ __forceinline__ int lds_byte(int r, int c) { const int st = (r >> 4) * 2 + (c >> 5), rr = r & 15, cc = c & 31, ob = rr * 64 + cc * 2; return st * 1024 + (ob ^ (((ob >> 9) & 1) << 5)); }
__host__ __device__ __forceinline__ void stage_rc(int b, int& R, int& C) { const int st = b / 1024, sb = b % 1024, swz = sb ^ (((sb >> 9) & 1) << 5); R = (st >> 1) * 16 + swz / 64; C = (st & 1) * 32 + (swz % 64) / 2; }
__host__ __device__ __forceinline__ int perm32(int rho) { const int n = rho >> 4, i = rho & 15; return 8 * (i >> 2) + 4 * n + (i & 3); }

struct Unit { int pm, pn; };
struct Gemm { const bf16_t* A; const bf16_t* Bt; int M, N, K; };

struct StaticOrder {
    int nM, nN, nwg, G, c;
    __host__ __device__ void init(int M, int N, int G_, int c_) { nM = M / BM; nN = N / BM; nwg = nM * nN; G = G_; c = c_; }
    __host__ __device__ bool next(int i, Unit& u) const {
        const long L = (long)i * G + c; if (L >= nwg) return false;
        int wgid = (int)L; { const int q = nwg / NXCD, r = nwg % NXCD, xcd = wgid % NXCD, off = wgid / NXCD; wgid = (xcd < r ? xcd * (q + 1) : r * (q + 1) + (xcd - r) * q) + off; }
        const int nig = WGM * nN, gid = wgid / nig, fm = gid * WGM, gsz = (nM - fm) < WGM ? (nM - fm) : WGM;
        u.pm = fm + ((wgid % nig) % gsz); u.pn = (wgid % nig) / gsz; return true;
    }
    __device__ __forceinline__ void a_ready(const Unit&) const {}
    __device__ __forceinline__ void done(const Unit&) const {}
};
__device__ __forceinline__ unsigned cvt_pk_bf16(float lo, float hi) { unsigned r; asm volatile("v_cvt_pk_bf16_f32 %0, %1, %2" : "=v"(r) : "v"(lo), "v"(hi)); return r; }
typedef float f32x2 __attribute__((ext_vector_type(2)));
template <class Epi, class Sched, bool ALIGN_EPI = false, bool SP2 = false>
__device__ __forceinline__ void gemm_phase(PG8_LAS unsigned char* lds, const Gemm g, const Sched& S, const Epi& E) {
    int tid_ = threadIdx.x; asm volatile("" : "+v"(tid_));
    const int tid = tid_, wid = __builtin_amdgcn_readfirstlane(tid >> 6), lane = tid & 63, wr = wid >> 2, wc = wid & 3, fr = lane & 15, fq = lane >> 4;
    const int K = g.K, nt = K / BK;
    unsigned voffA[2], voffB[2];
#pragma unroll
    for (int i = 0; i < 2; ++i) { int R, C; stage_rc(tid * 16 + i * 8192, R, C); const int Rb = Epi::PERM ? ((R & ~31) + perm32(R & 31)) : R;
        voffA[i] = (unsigned)(R * K + C) * 2u; voffB[i] = (unsigned)(Rb * K + C) * 2u; }
    const size_t kstep = (size_t)(BK * 2);
    const size_t hstep = (size_t)HALF * K * 2;
    const size_t tstep = 2 * hstep;
    const unsigned ldsw = (unsigned)wid * 1024u;
    const int aoff = lds_byte(wr * 64 + fr, fq * 8), boff = lds_byte(wc * 32 + fr, fq * 8);
#define PG8_SA(b, h) (((b) * 2 + (h)) * HTB)
#define PG8_SB(b, h) ((4 + (b) * 2 + (h)) * HTB)
#define PG8_STAGE(bufoff, gbase, voff) do { _Pragma("unroll") for (int _i = 0; _i < 2; ++_i) \
        __builtin_amdgcn_global_load_lds((const unsigned*)((const char*)(gbase) + (voff)[_i]), (PG8_LAS unsigned*)(lds + (bufoff) + ldsw + _i * 8192), 16, 0, 0); } while (0)
#define PG8_LDA(dst, b, h) do { _Pragma("unroll") for (int m = 0; m < 4; ++m) _Pragma("unroll") for (int k = 0; k < 2; ++k) dst[m][k] = *(const PG8_LAS bf16x8*)(lds + PG8_SA(b, h) + aoff + m * 2048 + k * 1024); } while (0)
#define PG8_LDB(dst, b, h) do { _Pragma("unroll") for (int n = 0; n < 2; ++n) _Pragma("unroll") for (int k = 0; k < 2; ++k) dst[n][k] = *(const PG8_LAS bf16x8*)(lds + PG8_SB(b, h) + boff + n * 2048 + k * 1024); } while (0)
#define PG8_MMA(ai, bj, At, Bt) do { __builtin_amdgcn_s_setprio(1); _Pragma("unroll") for (int m = 0; m < 4; ++m) _Pragma("unroll") for (int n = 0; n < 2; ++n) _Pragma("unroll") for (int k = 0; k < 2; ++k) \
        acc[ai][bj][m][n] = __builtin_amdgcn_mfma_f32_16x16x32_bf16(Bt[n][k], At[m][k], acc[ai][bj][m][n], 0, 0, 0); __builtin_amdgcn_s_setprio(0); } while (0)
#define PG8_WAIT_V(n) asm volatile("s_waitcnt vmcnt(" #n ")" ::: "memory")
#define PG8_WAIT_L(n) asm volatile("s_waitcnt lgkmcnt(" #n ")" ::: "memory")
#define PG8_BAR __builtin_amdgcn_s_barrier()
#define PG8_SCHED __builtin_amdgcn_sched_barrier(0)
    Unit cur, nxt; int ui = 0;
    if (!S.next(0, cur)) return;
    f32x4 acc[2][2][4][2];
#pragma unroll
    for (int a = 0; a < 2; ++a)
#pragma unroll
        for (int b = 0; b < 2; ++b)
#pragma unroll
            for (int m = 0; m < 4; ++m)
#pragma unroll
                for (int n = 0; n < 2; ++n) acc[a][b][m][n] = (f32x4){0.f, 0.f, 0.f, 0.f};
    bf16x8 At[4][2], B0[2][2], B1[2][2];
    const char* cA = (const char*)g.A + (size_t)cur.pm * tstep; const char* cB = (const char*)g.Bt + (size_t)cur.pn * tstep;
    S.a_ready(cur);
    if constexpr (SP2) {
        PG8_STAGE(PG8_SB(0, 0), cB, voffB); PG8_STAGE(PG8_SB(0, 1), cB + hstep, voffB); PG8_STAGE(PG8_SA(0, 0), cA, voffA); PG8_STAGE(PG8_SA(0, 1), cA + hstep, voffA);
        if (wr == 1) PG8_BAR;
        PG8_WAIT_V(2); PG8_BAR;
        PG8_STAGE(PG8_SB(1, 0), cB + kstep, voffB); PG8_STAGE(PG8_SA(1, 0), cA + kstep, voffA); PG8_STAGE(PG8_SB(1, 1), cB + hstep + kstep, voffB);
        PG8_WAIT_V(6); PG8_BAR;
    } else {
        PG8_STAGE(PG8_SB(0, 0), cB, voffB); PG8_STAGE(PG8_SA(0, 0), cA, voffA); PG8_STAGE(PG8_SB(0, 1), cB + hstep, voffB); PG8_STAGE(PG8_SA(0, 1), cA + hstep, voffA);
        if (wr == 1) PG8_BAR;
        PG8_WAIT_V(4); PG8_BAR;
        PG8_STAGE(PG8_SB(1, 0), cB + kstep, voffB); PG8_STAGE(PG8_SA(1, 0), cA + kstep, voffA); PG8_STAGE(PG8_SB(1, 1), cB + hstep + kstep, voffB);
        PG8_WAIT_V(6); PG8_BAR;
    }
    for (;;) {
        const bool has_next = S.next(ui + 1, nxt);
        const char* nA = has_next ? (const char*)g.A + (size_t)nxt.pm * tstep : cA; const char* nB = has_next ? (const char*)g.Bt + (size_t)nxt.pn * tstep : cB;
        for (int t = 0; t < nt; t += 2) {
            const bool last = (t == nt - 2);
            const char* a1 = cA + (size_t)(t + 1) * kstep;
            const char* a2 = last ? nA : cA + (size_t)(t + 2) * kstep; const char* b2 = last ? nB : cB + (size_t)(t + 2) * kstep;
            const char* a3 = a2 + kstep; const char* b3 = b2 + kstep;
            if (last && has_next) S.a_ready(nxt);
            if constexpr (SP2) {
            PG8_LDB(B0, 0, 0); PG8_LDB(B1, 0, 1); PG8_SCHED; PG8_LDA(At, 0, 0); PG8_STAGE(PG8_SA(1, 1), a1 + hstep, voffA);
            PG8_WAIT_V(8); PG8_WAIT_L(0); PG8_BAR; PG8_MMA(0, 0, At, B0); PG8_MMA(0, 1, At, B1); PG8_BAR; PG8_SCHED;
            PG8_LDA(At, 0, 1); PG8_STAGE(PG8_SB(0, 0), b2, voffB); PG8_STAGE(PG8_SB(0, 1), b2 + hstep, voffB); PG8_STAGE(PG8_SA(0, 0), a2, voffA);
            PG8_WAIT_V(8); PG8_WAIT_L(0); PG8_BAR; PG8_MMA(1, 0, At, B0); PG8_MMA(1, 1, At, B1); PG8_BAR; PG8_SCHED;
            PG8_LDB(B0, 1, 0); PG8_LDB(B1, 1, 1); PG8_SCHED; PG8_LDA(At, 1, 0); PG8_STAGE(PG8_SA(0, 1), a2 + hstep, voffA);
            PG8_WAIT_V(8); PG8_WAIT_L(0); PG8_BAR; PG8_MMA(0, 0, At, B0); PG8_MMA(0, 1, At, B1); PG8_BAR; PG8_SCHED;
            PG8_LDA(At, 1, 1); PG8_STAGE(PG8_SB(1, 0), b3, voffB); PG8_STAGE(PG8_SB(1, 1), b3 + hstep, voffB); PG8_STAGE(PG8_SA(1, 0), a3, voffA);
            PG8_WAIT_V(8); PG8_WAIT_L(0); PG8_BAR; PG8_MMA(1, 0, At, B0); PG8_MMA(1, 1, At, B1); PG8_BAR; PG8_SCHED;
            } else {
            PG8_LDB(B0, 0, 0); PG8_SCHED; PG8_LDA(At, 0, 0); PG8_STAGE(PG8_SA(1, 1), a1 + hstep, voffA);
            PG8_WAIT_L(8); PG8_BAR; PG8_WAIT_L(0); PG8_MMA(0, 0, At, B0); PG8_BAR; PG8_SCHED;
            PG8_LDB(B1, 0, 1); PG8_STAGE(PG8_SB(0, 0), b2, voffB);
            PG8_BAR; PG8_WAIT_L(0); PG8_MMA(0, 1, At, B1); PG8_BAR;
            PG8_LDA(At, 0, 1); PG8_STAGE(PG8_SA(0, 0), a2, voffA);
            PG8_BAR; PG8_WAIT_L(0); PG8_MMA(1, 0, At, B0); PG8_BAR; PG8_SCHED;
            PG8_STAGE(PG8_SB(0, 1), b2 + hstep, voffB);
            PG8_WAIT_V(6); PG8_BAR; PG8_MMA(1, 1, At, B1); PG8_BAR;
            PG8_LDB(B0, 1, 0); PG8_SCHED; PG8_LDA(At, 1, 0); PG8_STAGE(PG8_SA(0, 1), a2 + hstep, voffA);
            PG8_WAIT_L(8); PG8_BAR; PG8_WAIT_L(0); PG8_MMA(0, 0, At, B0); PG8_BAR; PG8_SCHED;
            PG8_LDB(B1, 1, 1); PG8_STAGE(PG8_SB(1, 0), b3, voffB);
            PG8_BAR; PG8_WAIT_L(0); PG8_MMA(0, 1, At, B1); PG8_BAR;
            PG8_LDA(At, 1, 1); PG8_STAGE(PG8_SA(1, 0), a3, voffA);
            PG8_BAR; PG8_WAIT_L(0); PG8_MMA(1, 0, At, B0); PG8_BAR; PG8_SCHED;
            PG8_STAGE(PG8_SB(1, 1), b3 + hstep, voffB);
            PG8_WAIT_V(6); PG8_BAR; PG8_MMA(1, 1, At, B1); PG8_BAR;
            }
        }
        if constexpr (ALIGN_EPI) { if (wr == 0) PG8_BAR; }
        if constexpr (!Epi::AFTER_DRAIN) { E(acc, cur, wr, wc, fr, fq); S.done(cur); }
        if (!has_next) break;
#pragma unroll
        for (int a = 0; a < 2; ++a)
#pragma unroll
            for (int b = 0; b < 2; ++b)
#pragma unroll
                for (int m = 0; m < 4; ++m)
#pragma unroll
                    for (int n = 0; n < 2; ++n) acc[a][b][m][n] = (f32x4){0.f, 0.f, 0.f, 0.f};
        cur = nxt; cA = nA; cB = nB; ++ui;
        if constexpr (ALIGN_EPI) { if (wr == 1) PG8_BAR; }
    }
    PG8_WAIT_V(0);
    if constexpr (!ALIGN_EPI) { if (wr == 0) PG8_BAR; }
    PG8_BAR;
    if constexpr (Epi::AFTER_DRAIN) { E.fused(acc, cur, wr, wc, fr, fq, lds, wid, lane); S.done(cur); }
#undef PG8_SA
#undef PG8_SB
#undef PG8_STAGE
#undef PG8_LDA
#undef PG8_LDB
#undef PG8_MMA
#undef PG8_WAIT_V
#undef PG8_WAIT_L
#undef PG8_BAR
#undef PG8_SCHED
}
}
namespace pg8 {
struct EpiIn {
    static constexpr bool PERM = true, AFTER_DRAIN = false;
    unsigned char* ws; const PG8_LAS float* gtab;
    __device__ __forceinline__ void operator()(const f32x4 (&acc)[2][2][4][2], const Unit& u, int wr, int wc, int fr, int fq) const {
        const int pn = u.pn; const int row0 = u.pm * BM + wr * 64 + fr;
#define RS(ai, m) 1.f
        if (pn < 16) {
            const int grp = pn >> 1;
            bf16_t* base = (bf16_t*)(ws + WS_QA + (size_t)grp * 64 * MiB) + (pn & 1) * 256 + wc * 64 + 8 * fq;
            if ((grp & 3) < 2) {
                const PG8_LAS float* g = gtab + ((grp >> 2) * 2 + (grp & 1)) * 64; const float sc = (grp & 3) == 0 ? QSCALE : 1.f;
                f32x4 gv[2][2];
#pragma unroll
                for (int bj = 0; bj < 2; ++bj)
#pragma unroll
                    for (int n = 0; n < 2; ++n) gv[bj][n] = *(const PG8_LAS f32x4*)(g + 32 * bj + 8 * fq + 4 * n);
#pragma unroll
                for (int ai = 0; ai < 2; ++ai)
#pragma unroll
                    for (int m = 0; m < 4; ++m) {
                        const float r_ = RS(ai, m); f32x4 y[2][2]; float ss = 0.f;
#pragma unroll
                        for (int bj = 0; bj < 2; ++bj)
#pragma unroll
                            for (int n = 0; n < 2; ++n) { y[bj][n] = acc[ai][bj][m][n] * r_; ss += (y[bj][n][0] * y[bj][n][0] + y[bj][n][1] * y[bj][n][1]) + (y[bj][n][2] * y[bj][n][2] + y[bj][n][3] * y[bj][n][3]); }
                        ss += __shfl_xor(ss, 16); ss += __shfl_xor(ss, 32);
                        const float rn = rsqrtf(ss * (1.f / 64.f) + EPS) * sc;
                        bf16_t* rowp = base + (size_t)(row0 + ai * HALF + m * 16) * 512;
#pragma unroll
                        for (int bj = 0; bj < 2; ++bj) { const f32x4 v0 = y[bj][0] * rn * gv[bj][0], v1 = y[bj][1] * rn * gv[bj][1];
                            u32x4 w; w.x = cvt_pk_bf16(v0[0], v0[1]); w.y = cvt_pk_bf16(v0[2], v0[3]); w.z = cvt_pk_bf16(v1[0], v1[1]); w.w = cvt_pk_bf16(v1[2], v1[3]);
                            *(u32x4*)(rowp + 32 * bj) = w; }
                        asm volatile("" ::: "memory");
                    }
            } else {
#pragma unroll
                for (int ai = 0; ai < 2; ++ai)
#pragma unroll
                    for (int m = 0; m < 4; ++m) { const float r_ = RS(ai, m); bf16_t* rowp = base + (size_t)(row0 + ai * HALF + m * 16) * 512;
#pragma unroll
                        for (int bj = 0; bj < 2; ++bj) { const f32x4 v0 = acc[ai][bj][m][0] * r_, v1 = acc[ai][bj][m][1] * r_;
                            u32x4 w; w.x = cvt_pk_bf16(v0[0], v0[1]); w.y = cvt_pk_bf16(v0[2], v0[3]); w.z = cvt_pk_bf16(v1[0], v1[1]); w.w = cvt_pk_bf16(v1[2], v1[3]);
                            *(u32x4*)(rowp + 32 * bj) = w; } }
            }
        } else if (pn == 16) {
            bf16_t* base = (bf16_t*)(ws + WS_QI) + wc * 64 + 8 * fq;
#pragma unroll
            for (int ai = 0; ai < 2; ++ai)
#pragma unroll
                for (int m = 0; m < 4; ++m) { const float r_ = RS(ai, m); bf16_t* rowp = base + (size_t)(row0 + ai * HALF + m * 16) * 256;
#pragma unroll
                    for (int bj = 0; bj < 2; ++bj) { const f32x4 v0 = acc[ai][bj][m][0] * r_, v1 = acc[ai][bj][m][1] * r_;
                        u32x4 w; w.x = cvt_pk_bf16(v0[0], v0[1]); w.y = cvt_pk_bf16(v0[2], v0[3]); w.z = cvt_pk_bf16(v1[0], v1[1]); w.w = cvt_pk_bf16(v1[2], v1[3]);
                        *(u32x4*)(rowp + 32 * bj) = w; } }
        } else {
            if (wc == 0) {
                bf16_t* base = (bf16_t*)(ws + WS_KI) + 8 * fq;
#pragma unroll
                for (int ai = 0; ai < 2; ++ai)
#pragma unroll
                    for (int m = 0; m < 4; ++m) { const float r_ = RS(ai, m); bf16_t* rowp = base + (size_t)(row0 + ai * HALF + m * 16) * 64;
#pragma unroll
                        for (int bj = 0; bj < 2; ++bj) { const f32x4 v0 = acc[ai][bj][m][0] * r_, v1 = acc[ai][bj][m][1] * r_;
                            u32x4 w; w.x = cvt_pk_bf16(v0[0], v0[1]); w.y = cvt_pk_bf16(v0[2], v0[3]); w.z = cvt_pk_bf16(v1[0], v1[1]); w.w = cvt_pk_bf16(v1[2], v1[3]);
                            *(u32x4*)(rowp + 32 * bj) = w; } }
            } else if (wc == 1) {
                if (fq == 0) {
                    float* wi = (float*)(ws + WS_WI);
#pragma unroll
                    for (int ai = 0; ai < 2; ++ai)
#pragma unroll
                        for (int m = 0; m < 4; ++m) *(f32x4*)(wi + (size_t)(row0 + ai * HALF + m * 16) * 4) = acc[ai][0][m][0] * (RS(ai, m) * IDX_SCALE);
                }
            }
        }
    }
};
#undef RS
struct EpiOut {
    static constexpr bool PERM = false, AFTER_DRAIN = false;
    const float* x; float* out;
    __device__ __forceinline__ void operator()(const f32x4 (&acc)[2][2][4][2], const Unit& u, int wr, int wc, int fr, int fq) const {
        const int row0 = u.pm * BM + wr * 64 + fr, col0 = u.pn * BM + wc * 32 + 4 * fq;
#pragma unroll
        for (int ai = 0; ai < 2; ++ai)
#pragma unroll
            for (int mp = 0; mp < 2; ++mp) {
                f32x4 xin[2][2][2];
#pragma unroll
                for (int mm = 0; mm < 2; ++mm) { const size_t off = (size_t)(row0 + ai * HALF + (2 * mp + mm) * 16) * 1024 + col0;
#pragma unroll
                    for (int bj = 0; bj < 2; ++bj)
#pragma unroll
                        for (int n = 0; n < 2; ++n) xin[mm][bj][n] = *(const f32x4*)(x + off + bj * HALF + n * 16); }
                __builtin_amdgcn_sched_barrier(0);
#pragma unroll
                for (int mm = 0; mm < 2; ++mm) { const size_t off = (size_t)(row0 + ai * HALF + (2 * mp + mm) * 16) * 1024 + col0;
#pragma unroll
                    for (int bj = 0; bj < 2; ++bj)
#pragma unroll
                        for (int n = 0; n < 2; ++n) *(f32x4*)(out + off + bj * HALF + n * 16) = xin[mm][bj][n] + acc[ai][bj][2 * mp + mm][n]; }
                __builtin_amdgcn_sched_barrier(0);
            }
    }
};
}

constexpr int GEMM_LDS = 131072;
namespace att {
using bf16x8 = __attribute__((ext_vector_type(8))) short;
using s16x4 = __attribute__((ext_vector_type(4))) short;
using f32x16 = __attribute__((ext_vector_type(16))) float;
using u32x4 = __attribute__((ext_vector_type(4))) unsigned;
using f32x4 = __attribute__((ext_vector_type(4))) float;
#define ALDS __attribute__((address_space(3)))
typedef ALDS const char* lds_cptr;
typedef ALDS unsigned char* lds_ptr;

constexpr int SLOTB = 8192;
constexpr int LDS_K = 0, LDS_V = 3 * SLOTB, LDS_TAB = 6 * SLOTB, LDS_WS = LDS_TAB + 1024, LDS_OST = LDS_WS + 2048, LDS_BYTES = LDS_OST + 8 * 8192;
constexpr int TABN = 132;

struct Unit { int b, h, kind, dil, rho, u0; };

__device__ __forceinline__ void glds16(const void* gsrc, unsigned lds_dst) { unsigned keep;
    asm volatile("s_mov_b32 %0, m0\n\ts_mov_b32 m0, %2\n\ts_nop 0\n\tglobal_load_lds_dwordx4 %1, off\n\ts_mov_b32 m0, %0" : "=&s"(keep) : "v"(gsrc), "s"(lds_dst) : "memory"); }
__device__ __forceinline__ void glds16s(const void* sbase, unsigned voff, unsigned lds_dst) { unsigned keep;
    asm volatile("s_mov_b32 %0, m0\n\ts_mov_b32 m0, %3\n\ts_nop 0\n\tglobal_load_lds_dwordx4 %1, %2\n\ts_mov_b32 m0, %0" : "=&s"(keep) : "v"(voff), "s"(sbase), "s"(lds_dst) : "memory"); }
__device__ __forceinline__ float cndm(float p, unsigned long long m) { float o; asm("v_cndmask_b32_e64 %0, 0, %1, %2" : "=v"(o) : "v"(p), "s"(m)); return o; }
typedef float f32x2_t __attribute__((ext_vector_type(2))); typedef __bf16 bf16x2_t __attribute__((ext_vector_type(2)));
__device__ __forceinline__ unsigned cvtpk(float lo, float hi) { f32x2_t v = {lo, hi}; bf16x2_t b = __builtin_convertvector(v, bf16x2_t); return __builtin_bit_cast(unsigned, b); }
typedef short v4i16_t __attribute__((ext_vector_type(4)));
__device__ __forceinline__ s16x4 vtr(lds_cptr p) { return __builtin_bit_cast(s16x4, __builtin_amdgcn_ds_read_tr16_b64_v4i16((ALDS v4i16_t*)p)); }
__device__ __forceinline__ float silu(float z) { return z / (1.f + __expf(-z)); }

constexpr int LDS_OSB = LDS_WS + 2048;
constexpr int LDS_CT = LDS_OSB + 8 * 4096;
constexpr int LDS_B_BYTES = LDS_CT + 6 * 8192;
__device__ __forceinline__ void build_ctab(int kind, int h, unsigned char* ws, ALDS unsigned char* shm, int tid) {
    const float* T = (const float*)(ws + WS_ATAB) + (kind * 8 + h) * TABN; const float negb = T[129];
    ALDS float* ct = (ALDS float*)(shm + LDS_CT);
    for (int e = tid; e < 6 * 2048; e += 512) {
        const int c = e & 3, lane = (e >> 2) & 63, g = (e >> 8) & 7, i = e >> 11; const int reg = 4 * g + c, r = reg & 15, r32 = lane & 31, hi = lane >> 5;
        const int j = 32 * i + r32 - 4 * hi - ((r & 3) + 8 * (r >> 2)) - (reg >= 16 ? 32 : 0);
        ct[e] = (j >= 0 && j <= 128) ? T[j] + negb : -1e30f; }
}
__device__ __forceinline__ void unit_start(const Unit U, const bool rebuild, unsigned char* ws, ALDS unsigned char* shm, bf16x8 (&qr)[4], int tid, int lane, int r32, int hi, int wid) {
    const size_t rowbase = (size_t)U.b * SEQ; const int dil = U.dil, rho = U.rho, h = U.h; const unsigned lds0 = (unsigned)(uintptr_t)shm;
    const bf16_t* Qg = (const bf16_t*)(ws + WS_QB) + rowbase * 512 + h * 64; const bf16_t* Kg = (const bf16_t*)(ws + WS_KB) + rowbase * 512 + h * 64; const bf16_t* Vg = (const bf16_t*)(ws + WS_VB) + rowbase * 512 + h * 64;
    const int xw = U.u0 + 32 * wid, kt0 = U.u0 >= 128 ? U.u0 - 128 : 0;
    const bf16_t* ksrc = Kg + ((size_t)(kt0 + 8 * wid + (lane >> 3)) * dil + rho) * 512 + (((lane & 7) ^ ((lane >> 3) & 7)) * 8);
    const bf16_t* vsrc = Vg + ((size_t)(kt0 + 16 * (wid & 3) + (lane >> 2)) * dil + rho) * 512 + (wid >> 2) * 32 + (lane & 3) * 8;
    const size_t tstep = (size_t)64 * dil * 512; const unsigned kdst = lds0 + LDS_K + wid * 1024, vdst = lds0 + LDS_V + wid * 1024;
    glds16(ksrc, (unsigned)__builtin_amdgcn_readfirstlane(kdst)); glds16(vsrc, (unsigned)__builtin_amdgcn_readfirstlane(vdst));
    glds16(ksrc + tstep, (unsigned)__builtin_amdgcn_readfirstlane(kdst + SLOTB)); glds16(vsrc + tstep, (unsigned)__builtin_amdgcn_readfirstlane(vdst + SLOTB));
    const bf16_t* qp = Qg + ((size_t)(xw + r32) * dil + rho) * 512 + hi * 8;
#pragma unroll
    for (int d0 = 0; d0 < 4; ++d0) qr[d0] = *(const bf16x8*)(qp + d0 * 16);
    if (rebuild) build_ctab(U.kind, h, ws, shm, tid);
}
template <int MODE> __device__ __forceinline__ void attn_unit(const Unit U, const bool first, const Unit N, const bool has_next, unsigned char* ws, ALDS unsigned char* shm, bf16x8 (&qr)[4]) {
    int tid_ = threadIdx.x; asm volatile("" : "+v"(tid_));
    const int tid = tid_, lane = tid & 63, r32 = lane & 31, hi = lane >> 5; const int wid = __builtin_amdgcn_readfirstlane(tid >> 6);
    const int dil = U.dil, rho = U.rho, h = U.h; const size_t rowbase = (size_t)U.b * SEQ;
    const bf16_t* Kg = (const bf16_t*)(ws + WS_KB) + rowbase * 512 + h * 64;
    const bf16_t* Vg = (const bf16_t*)(ws + WS_VB) + rowbase * 512 + h * 64;
    const unsigned lds0 = (unsigned)(uintptr_t)shm;
    const int xw = U.u0 + 32 * wid;
    const int kt0 = U.u0 >= 128 ? U.u0 - 128 : 0;
    const int NT = (U.u0 + 256 - kt0) >> 6;
    if (first) unit_start(U, true, ws, shm, qr, tid, lane, r32, hi, wid);
    const bf16_t* ksrc = Kg + ((size_t)(kt0 + 8 * wid + (lane >> 3)) * dil + rho) * 512 + (((lane & 7) ^ ((lane >> 3) & 7)) * 8);
    const bf16_t* vsrc = Vg + ((size_t)(kt0 + 16 * (wid & 3) + (lane >> 2)) * dil + rho) * 512 + (wid >> 2) * 32 + (lane & 3) * 8;
    const size_t tstep = (size_t)64 * dil * 512;
    const unsigned kdst = lds0 + LDS_K + wid * 1024, vdst = lds0 + LDS_V + wid * 1024;
#define ATT_DMA(t, slot) do { glds16(ksrc + (size_t)(t) * tstep, (unsigned)__builtin_amdgcn_readfirstlane(kdst + (slot) * SLOTB)); glds16(vsrc + (size_t)(t) * tstep, (unsigned)__builtin_amdgcn_readfirstlane(vdst + (slot) * SLOTB)); } while (0)
    const lds_cptr kp0 = (lds_cptr)shm + LDS_K + r32 * 128; int kofs[4];
#pragma unroll
    for (int d0 = 0; d0 < 4; ++d0) kofs[d0] = ((2 * d0 + hi) ^ (r32 & 7)) * 16;
    const lds_cptr vp0 = (lds_cptr)shm + LDS_V + ((lane >> 4) & 1) * 32 + (lane & 3) * 8 + (4 * hi + ((lane & 15) >> 2)) * 64;
    const lds_cptr ctp = (lds_cptr)shm + LDS_CT + lane * 16;
    const bf16x8 ones8 = (bf16x8){0x3F80, 0x3F80, 0x3F80, 0x3F80, 0x3F80, 0x3F80, 0x3F80, 0x3F80};
    f32x16 o[3]; o[0] = f32x16{}; o[1] = f32x16{}; o[2] = f32x16{};
    u32x4 eq1[2][2], eq2[2][2], ezz[2][2]; float el[2][2];
    if (MODE == 2) {
#pragma unroll
        for (int d0 = 0; d0 < 2; ++d0)
#pragma unroll
            for (int i = 0; i < 2; ++i) { const int row = i * 16 + (lane >> 2), ch = lane & 3; const size_t tok = rowbase + (size_t)(xw + row) * dil + rho; const int col = h * 64 + d0 * 32 + ch * 8;
                eq1[d0][i] = *(const u32x4*)((const bf16_t*)(ws + WS_PB1) + tok * 512 + col); eq2[d0][i] = *(const u32x4*)((const bf16_t*)(ws + WS_PB2) + tok * 512 + col);
                ezz[d0][i] = *(const u32x4*)((const bf16_t*)(ws + WS_ZB) + tok * 512 + col);
                el[d0][i] = ((const float*)(ws + WS_LB1))[tok * 8 + h] + ((const float*)(ws + WS_LB2))[tok * 8 + h]; }
    }
    int slot = 0;
    for (int t = 0; t < NT; ++t) {
        if (t + 1 < NT) asm volatile("s_waitcnt vmcnt(2) lgkmcnt(0)\n\ts_barrier" ::: "memory");
        else asm volatile("s_waitcnt vmcnt(0) lgkmcnt(0)\n\ts_barrier" ::: "memory");
        if (t + 2 < NT) { const int s2 = slot >= 1 ? slot - 1 : 2; ATT_DMA(t + 2, s2); }
        const int kt = kt0 + 64 * t; const int tau = xw - kt;
        if (tau >= 0 && tau <= 160) {
            f32x16 p0, p1; const lds_cptr cb = ctp + (tau >> 5) * 8192; const lds_cptr kb = kp0 + slot * SLOTB; bf16x8 kfr[8];
#pragma unroll
            for (int d0 = 0; d0 < 4; ++d0) { kfr[2 * d0] = *(const ALDS bf16x8*)(kb + kofs[d0]); kfr[2 * d0 + 1] = *(const ALDS bf16x8*)(kb + kofs[d0] + 4096); }
#pragma unroll
            for (int g = 0; g < 4; ++g) { const f32x4 v0 = *(const ALDS f32x4*)(cb + g * 1024), v1 = *(const ALDS f32x4*)(cb + (4 + g) * 1024);
                p0[4 * g] = v0[0]; p0[4 * g + 1] = v0[1]; p0[4 * g + 2] = v0[2]; p0[4 * g + 3] = v0[3]; p1[4 * g] = v1[0]; p1[4 * g + 1] = v1[1]; p1[4 * g + 2] = v1[2]; p1[4 * g + 3] = v1[3]; }
            __builtin_amdgcn_sched_barrier(0);
#pragma unroll
            for (int d0 = 0; d0 < 4; ++d0) { p0 = __builtin_amdgcn_mfma_f32_32x32x16_bf16(kfr[2 * d0], qr[d0], p0, 0, 0, 0); p1 = __builtin_amdgcn_mfma_f32_32x32x16_bf16(kfr[2 * d0 + 1], qr[d0], p1, 0, 0, 0); }
            __builtin_amdgcn_sched_barrier(0);
            const lds_cptr vp = vp0 + slot * SLOTB; s16x4 vlo[8], vhi[8];
#pragma unroll
            for (int i = 0; i < 8; ++i) { vlo[i] = vtr(vp + ((i >> 2) * 4096 + (i & 3) * 1024)); vhi[i] = vtr(vp + ((i >> 2) * 4096 + (i & 3) * 1024 + 512)); }
            __builtin_amdgcn_sched_barrier(0);
#pragma unroll
            for (int r = 0; r < 16; ++r) { p0[r] = __builtin_amdgcn_exp2f(p0[r]); p1[r] = __builtin_amdgcn_exp2f(p1[r]); }
            u32x4 pw0, pw1, pw2, pw3;
            pw0 = (u32x4){cvtpk(p0[0], p0[1]), cvtpk(p0[2], p0[3]), cvtpk(p0[4], p0[5]), cvtpk(p0[6], p0[7])};
            pw1 = (u32x4){cvtpk(p0[8], p0[9]), cvtpk(p0[10], p0[11]), cvtpk(p0[12], p0[13]), cvtpk(p0[14], p0[15])};
            pw2 = (u32x4){cvtpk(p1[0], p1[1]), cvtpk(p1[2], p1[3]), cvtpk(p1[4], p1[5]), cvtpk(p1[6], p1[7])};
            pw3 = (u32x4){cvtpk(p1[8], p1[9]), cvtpk(p1[10], p1[11]), cvtpk(p1[12], p1[13]), cvtpk(p1[14], p1[15])};
            __builtin_amdgcn_sched_barrier(0);
#define ATT_VF(i) (bf16x8){vlo[i][0], vlo[i][1], vlo[i][2], vlo[i][3], vhi[i][0], vhi[i][1], vhi[i][2], vhi[i][3]}
            o[0] = __builtin_amdgcn_mfma_f32_32x32x16_bf16(__builtin_bit_cast(bf16x8, pw0), ATT_VF(0), o[0], 0, 0, 0); o[1] = __builtin_amdgcn_mfma_f32_32x32x16_bf16(__builtin_bit_cast(bf16x8, pw0), ATT_VF(4), o[1], 0, 0, 0);
            o[2] = __builtin_amdgcn_mfma_f32_32x32x16_bf16(__builtin_bit_cast(bf16x8, pw0), ones8, o[2], 0, 0, 0);
            o[0] = __builtin_amdgcn_mfma_f32_32x32x16_bf16(__builtin_bit_cast(bf16x8, pw1), ATT_VF(1), o[0], 0, 0, 0); o[1] = __builtin_amdgcn_mfma_f32_32x32x16_bf16(__builtin_bit_cast(bf16x8, pw1), ATT_VF(5), o[1], 0, 0, 0);
            o[2] = __builtin_amdgcn_mfma_f32_32x32x16_bf16(__builtin_bit_cast(bf16x8, pw1), ones8, o[2], 0, 0, 0);
            o[0] = __builtin_amdgcn_mfma_f32_32x32x16_bf16(__builtin_bit_cast(bf16x8, pw2), ATT_VF(2), o[0], 0, 0, 0); o[1] = __builtin_amdgcn_mfma_f32_32x32x16_bf16(__builtin_bit_cast(bf16x8, pw2), ATT_VF(6), o[1], 0, 0, 0);
            o[2] = __builtin_amdgcn_mfma_f32_32x32x16_bf16(__builtin_bit_cast(bf16x8, pw2), ones8, o[2], 0, 0, 0);
            o[0] = __builtin_amdgcn_mfma_f32_32x32x16_bf16(__builtin_bit_cast(bf16x8, pw3), ATT_VF(3), o[0], 0, 0, 0); o[1] = __builtin_amdgcn_mfma_f32_32x32x16_bf16(__builtin_bit_cast(bf16x8, pw3), ATT_VF(7), o[1], 0, 0, 0);
            o[2] = __builtin_amdgcn_mfma_f32_32x32x16_bf16(__builtin_bit_cast(bf16x8, pw3), ones8, o[2], 0, 0, 0);
#undef ATT_VF
            __builtin_amdgcn_sched_barrier(0);
        }
        slot = slot == 2 ? 0 : slot + 1;
    }
    asm volatile("s_waitcnt lgkmcnt(0)\n\ts_barrier" ::: "memory");
    bf16x8 qrn[4];
#pragma unroll
    for (int d0 = 0; d0 < 4; ++d0) qrn[d0] = qr[d0];
    if (has_next) unit_start(N, (N.kind != U.kind) || (N.h != U.h), ws, shm, qrn, tid, lane, r32, hi, wid);
    ALDS float* stg = (ALDS float*)(shm + LDS_OSB) + wid * 1024;
    ALDS float* wsf = (ALDS float*)(shm + LDS_WS) + wid * 64;
    if (r32 == 0) {
#pragma unroll
        for (int r = 0; r < 16; ++r) wsf[(r & 3) + 8 * (r >> 2) + 4 * hi] = o[2][r]; }
#pragma unroll
    for (int d0 = 0; d0 < 2; ++d0) {
#pragma unroll
        for (int r = 0; r < 16; ++r) { const int orow = (r & 3) + 8 * (r >> 2) + 4 * hi; stg[orow * 32 + r32] = o[d0][r]; }
        asm volatile("s_waitcnt lgkmcnt(0)" ::: "memory");
#pragma unroll
        for (int i = 0; i < 2; ++i) {
            const int row = i * 16 + (lane >> 2), ch = lane & 3; const size_t tok = rowbase + (size_t)(xw + row) * dil + rho; const int col = h * 64 + d0 * 32 + ch * 8;
            const f32x4 a0 = *(const ALDS f32x4*)(stg + row * 32 + ch * 8), a1 = *(const ALDS f32x4*)(stg + row * 32 + ch * 8 + 4);
            float v[8] = {a0[0], a0[1], a0[2], a0[3], a1[0], a1[1], a1[2], a1[3]};
            float l = wsf[row];
            if (MODE == 1) {
                bf16_t* pb = (bf16_t*)(ws + (U.kind == 1 ? WS_PB1 : WS_PB2)); float* lp = (float*)(ws + (U.kind == 1 ? WS_LB1 : WS_LB2));
                u32x4 w; w.x = cvtpk(v[0], v[1]); w.y = cvtpk(v[2], v[3]); w.z = cvtpk(v[4], v[5]); w.w = cvtpk(v[6], v[7]);
                *(u32x4*)(pb + tok * 512 + col) = w; if (d0 == 0 && ch == 0) lp[tok * 8 + h] = l;
            } else {
                const u32x4 q1 = eq1[d0][i], q2 = eq2[d0][i]; l += el[d0][i];
#pragma unroll
                for (int e = 0; e < 4; ++e) { v[2 * e] += __uint_as_float(q1[e] << 16) + __uint_as_float(q2[e] << 16); v[2 * e + 1] += __uint_as_float(q1[e] & 0xffff0000u) + __uint_as_float(q2[e] & 0xffff0000u); }
                const u32x4 zz = ezz[d0][i]; const float rl = 1.f / l;
#pragma unroll
                for (int e = 0; e < 4; ++e) { v[2 * e] *= rl * silu(__uint_as_float(zz[e] << 16)); v[2 * e + 1] *= rl * silu(__uint_as_float(zz[e] & 0xffff0000u)); }
                u32x4 w; w.x = cvtpk(v[0], v[1]); w.y = cvtpk(v[2], v[3]); w.z = cvtpk(v[4], v[5]); w.w = cvtpk(v[6], v[7]);
                *(u32x4*)((bf16_t*)(ws + WS_MIX) + tok * 1024 + 512 + col) = w;
            }
        }
        asm volatile("s_waitcnt lgkmcnt(0)" ::: "memory");
    }
#undef ATT_DMA
#pragma unroll
    for (int d0 = 0; d0 < 4; ++d0) qr[d0] = qrn[d0];
}
#define SBAR() __builtin_amdgcn_sched_barrier(0)
#define PIN(x) asm volatile("" : "+v"(x))
#define MFMA32(a, b, c) __builtin_amdgcn_mfma_f32_32x32x16_bf16(a, b, c, 0, 0, 0)
__device__ __forceinline__ void kload2(bf16x8* kf, lds_cptr kp, int d0) { kf[2 * d0] = *(const ALDS bf16x8*)(kp + d0 * 2048); kf[2 * d0 + 1] = *(const ALDS bf16x8*)(kp + d0 * 2048 + 512); }
#define MEXP(X, MW, BIT) do { float e_ = __builtin_amdgcn_exp2f(X); int m_; asm("v_bfe_i32 %1, %2, %3, 1\n\tv_and_b32 %0, %0, %1" : "+v"(e_), "=&v"(m_) : "v"(MW), "n"(BIT)); X = e_; } while (0)
__device__ __forceinline__ void bias_near(f32x16& c0, f32x16& c1, const ALDS float* tab, int jb) {
#pragma unroll
    for (int r = 0; r < 16; ++r) { const int c = (r & 3) + 8 * (r >> 2); unsigned j0 = (unsigned)(jb - c), j1 = (unsigned)(jb - c - 32); j0 = j0 < 128u ? j0 : 128u; j1 = j1 < 128u ? j1 : 128u; c0[r] += tab[j0]; c1[r] += tab[j1]; }
}
#define MEXP4(X, i, MW, B0) do { float e0_ = __builtin_amdgcn_exp2f(X[i]), e1_ = __builtin_amdgcn_exp2f(X[(i) + 1]), e2_ = __builtin_amdgcn_exp2f(X[(i) + 2]), e3_ = __builtin_amdgcn_exp2f(X[(i) + 3]); int m0_, m1_, m2_, m3_; \
    asm("v_bfe_i32 %4, %8, %9, 1\n\tv_bfe_i32 %5, %8, %10, 1\n\tv_bfe_i32 %6, %8, %11, 1\n\tv_bfe_i32 %7, %8, %12, 1\n\tv_and_b32 %0, %0, %4\n\tv_and_b32 %1, %1, %5\n\tv_and_b32 %2, %2, %6\n\tv_and_b32 %3, %3, %7" \
        : "+v"(e0_), "+v"(e1_), "+v"(e2_), "+v"(e3_), "=&v"(m0_), "=&v"(m1_), "=&v"(m2_), "=&v"(m3_) : "v"(MW), "n"(B0), "n"((B0) + 1), "n"((B0) + 2), "n"((B0) + 3)); \
    X[i] = e0_; X[(i) + 1] = e1_; X[(i) + 2] = e2_; X[(i) + 3] = e3_; } while (0)
__device__ __forceinline__ void attn_unit_a(int b, int h, int qb, const bool load_tab, unsigned char* ws, lds_ptr shm) {
    int tid_ = threadIdx.x; asm volatile("" : "+v"(tid_));
    const int tid = tid_, lane = tid & 63, r32 = lane & 31, hi = lane >> 5; const int wid = __builtin_amdgcn_readfirstlane(tid >> 6);
    const size_t rowbase = (size_t)b * SEQ; const int u0 = qb * 256, NT = 4 * qb + 4, xw = u0 + 32 * wid;
    const bf16_t* Qg = (const bf16_t*)(ws + WS_QA) + rowbase * 512 + h * 64;
    const bf16_t* Kg = (const bf16_t*)(ws + WS_KA) + rowbase * 512 + h * 64;
    const bf16_t* Vg = (const bf16_t*)(ws + WS_VA) + rowbase * 512 + h * 64;
    const unsigned lds0 = (unsigned)(uintptr_t)shm;
    ALDS float* tab = (ALDS float*)(shm + LDS_TAB);
    if (load_tab) { const float tv = ((const float*)(ws + WS_ATAB))[h * TABN + (tid < TABN ? tid : TABN - 1)]; if (tid < TABN) tab[tid] = tv; }
    const bf16_t* ksrc = Kg + (size_t)lane * 512 + wid * 8;
    const bf16_t* vsrc = Vg + (size_t)(16 * (wid & 3) + (lane >> 2)) * 512 + (wid >> 2) * 32 + (lane & 3) * 8;
    const unsigned kdst = lds0 + LDS_K + wid * 1024, vdst = lds0 + LDS_V + wid * 1024;
#define DMA_K(t, slot) glds16(ksrc + (size_t)(t) * 64 * 512, (unsigned)__builtin_amdgcn_readfirstlane(kdst + (slot)))
#define DMA_V(t, slot) glds16(vsrc + (size_t)(t) * 64 * 512, (unsigned)__builtin_amdgcn_readfirstlane(vdst + (slot)))
    const lds_cptr vp0 = (lds_cptr)shm + LDS_V + ((lane >> 4) & 1) * 32 + (lane & 3) * 8 + (4 * hi + ((lane & 15) >> 2)) * 64;
    const lds_cptr kp0 = (lds_cptr)shm + LDS_K + hi * 1024 + r32 * 16;
    const unsigned* mp = (const unsigned*)(ws + WS_MASK) + (((size_t)b * 128 + (xw >> 5)) * 64) * 64 + lane;
#define MLOAD(dst, tt) asm volatile("global_load_dword %0, %1, off" : "=v"(dst) : "v"(mp + (size_t)(tt) * 64) : "memory")
#define WAIT_BAR(N) asm volatile("s_waitcnt vmcnt(" #N ") lgkmcnt(0)\n\ts_barrier" ::: "memory")
#define WAIT_BAR_P(N, mw) do { asm volatile("s_waitcnt vmcnt(" #N ") lgkmcnt(0)\n\ts_barrier" ::: "memory"); asm volatile("" : "+v"(mw)); } while (0)
    unsigned mwA, mwB;
    DMA_K(0, 0); MLOAD(mwA, 0); DMA_V(0, 0); DMA_K(1, SLOTB);
    bf16x8 qr[4];
    { const bf16_t* qp = Qg + (size_t)(xw + r32) * 512 + hi * 8;
#pragma unroll
      for (int d0 = 0; d0 < 4; ++d0) qr[d0] = *(const bf16x8*)(qp + d0 * 16); }
    const f32x16 zero16 = f32x16{}; const bf16x8 ones8 = (bf16x8){0x3F80, 0x3F80, 0x3F80, 0x3F80, 0x3F80, 0x3F80, 0x3F80, 0x3F80};
    f32x16 o[2]; o[0] = f32x16{}; o[1] = f32x16{}; float l_reg = 0.f;
    f32x16 pA0, pA1, pB0, pB1; bf16x8 kf[8]; s16x4 vlo[8], vhi[8]; u32x4 pw0, pw1, pw2, pw3;
    int sl_prev = 0, sl_cur = 0, sl_next = SLOTB;
#define ROT() do { sl_prev = sl_cur; sl_cur = sl_next; sl_next = (sl_next == 2 * SLOTB) ? 0 : sl_next + SLOTB; } while (0)
    DMA_K(2, 2 * SLOTB);
    WAIT_BAR_P(1, mwA);
    const int jb0 = xw + r32 - 4 * hi;
    _Pragma("unroll") for (int d0 = 0; d0 < 4; ++d0) kload2(kf, kp0, d0);
    pA0 = MFMA32(kf[0], qr[0], zero16); pA1 = MFMA32(kf[1], qr[0], zero16); pA0 = MFMA32(kf[2], qr[1], pA0); pA1 = MFMA32(kf[3], qr[1], pA1);
    pA0 = MFMA32(kf[4], qr[2], pA0); pA1 = MFMA32(kf[5], qr[2], pA1); pA0 = MFMA32(kf[6], qr[3], pA0); pA1 = MFMA32(kf[7], qr[3], pA1);
    if (63 > xw - 128) bias_near(pA0, pA1, tab, jb0);
    MEXP4(pA0, 0, mwA, 0); MEXP4(pA0, 4, mwA, 4); MEXP4(pA0, 8, mwA, 8); MEXP4(pA0, 12, mwA, 12); MEXP4(pA1, 0, mwA, 16); MEXP4(pA1, 4, mwA, 20); MEXP4(pA1, 8, mwA, 24); MEXP4(pA1, 12, mwA, 28);
    WAIT_BAR(0);
    MLOAD(mwB, 1); DMA_K(3, 0); DMA_V(1, SLOTB); ROT();
    _Pragma("unroll") for (int d0 = 0; d0 < 4; ++d0) kload2(kf, kp0 + sl_cur, d0);
    WAIT_BAR_P(2, mwB);
#define PKW(P, i) cvtpk(P[i], P[i + 1])
#define PAF(k) __builtin_bit_cast(bf16x8, pw##k)
#define VFR(i) (bf16x8){vlo[i][0], vlo[i][1], vlo[i][2], vlo[i][3], vhi[i][0], vhi[i][1], vhi[i][2], vhi[i][3]}
#define VRD(i) do { vlo[i] = vtr(vp_ + (((i) >> 2) * 4096 + ((i) & 3) * 1024)); vhi[i] = vtr(vp_ + (((i) >> 2) * 4096 + ((i) & 3) * 1024 + 512)); } while (0)
#define KRD(G, d0) do { if (G) { kload2(kf, kp0 + sl_next, d0); SBAR(); } } while (0)
#define GAPA(MF, a0, a1, a2, a3, W0, W1, PW) do { MF; sacc += a0; sacc += a1; sacc += a2; sacc += a3; W0; W1; PIN(PW); PIN(sacc); SBAR(); } while (0)
#define GAPB(MF, X, i, MW, bo) do { MF; MEXP4(X, i, MW, (bo) + (i)); PIN(X); SBAR(); } while (0)
#define GAPO(k) do { o[2] = MFMA32(PAF(k), ones8, o[2]); SBAR(); } while (0)
#define STEP(C0, C1, P0, P1, t, EDGE, GK, GV, GL, MWC, MWN) do { SBAR(); \
    if (GV) MLOAD(MWN, (t) + 1); \
    const lds_cptr vp_ = vp0 + sl_prev; \
    VRD(0); SBAR(); float sacc = P0[0] + P0[1]; \
                    GAPA(C0 = MFMA32(kf[0], qr[0], zero16), P0[2], P0[3], P0[4], P0[5],     pw0[0] = PKW(P0, 0),  pw0[1] = PKW(P0, 2),  pw0); \
    VRD(4); SBAR(); GAPA(C1 = MFMA32(kf[1], qr[0], zero16), P0[6], P0[7], P0[8], P0[9],     pw0[2] = PKW(P0, 4),  pw0[3] = PKW(P0, 6),  pw0); \
    VRD(1); SBAR(); GAPA(C0 = MFMA32(kf[2], qr[1], C0),   P0[10], P0[11], P0[12], P0[13], pw1[0] = PKW(P0, 8),  pw1[1] = PKW(P0, 10), pw1); \
    VRD(5); SBAR(); GAPA(C1 = MFMA32(kf[3], qr[1], C1),   P0[14], P0[15], P1[0], P1[1],   pw1[2] = PKW(P0, 12), pw1[3] = PKW(P0, 14), pw1); \
    VRD(2); SBAR(); GAPA(C0 = MFMA32(kf[4], qr[2], C0),   P1[2], P1[3], P1[4], P1[5],     pw2[0] = PKW(P1, 0),  pw2[1] = PKW(P1, 2),  pw2); \
    VRD(6); SBAR(); GAPA(C1 = MFMA32(kf[5], qr[2], C1),   P1[6], P1[7], P1[8], P1[9],     pw2[2] = PKW(P1, 4),  pw2[3] = PKW(P1, 6),  pw2); \
    VRD(3); SBAR(); GAPA(C0 = MFMA32(kf[6], qr[3], C0),   P1[10], P1[11], P1[12], P1[13], pw3[0] = PKW(P1, 8),  pw3[1] = PKW(P1, 10), pw3); \
    VRD(7); SBAR(); GAPA(C1 = MFMA32(kf[7], qr[3], C1),   P1[14], P1[15], 0.f, 0.f,       pw3[2] = PKW(P1, 12), pw3[3] = PKW(P1, 14), pw3); \
    l_reg += sacc; \
    if (GK) DMA_K((t) + 3, sl_cur); if (GV) DMA_V((t) + 1, sl_next); \
    if (EDGE) { const int kt_ = 64 * (t); if (kt_ + 63 > xw - 128) bias_near(C0, C1, tab, jb0 - kt_); if (kt_ > xw + 31) MWC = 0u; } \
    SBAR(); \
    GAPB(o[0] = MFMA32(PAF(0), VFR(0), o[0]), C0, 0, MWC, 0);              GAPB(o[1] = MFMA32(PAF(0), VFR(4), o[1]), C0, 4, MWC, 0); \
    KRD(GL, 0); GAPB(o[0] = MFMA32(PAF(1), VFR(1), o[0]), C0, 8, MWC, 0);  KRD(GL, 1); GAPB(o[1] = MFMA32(PAF(1), VFR(5), o[1]), C0, 12, MWC, 0); \
    KRD(GL, 2); GAPB(o[0] = MFMA32(PAF(2), VFR(2), o[0]), C1, 0, MWC, 16); KRD(GL, 3); GAPB(o[1] = MFMA32(PAF(2), VFR(6), o[1]), C1, 4, MWC, 16); \
    GAPB(o[0] = MFMA32(PAF(3), VFR(3), o[0]), C1, 8, MWC, 16);             GAPB(o[1] = MFMA32(PAF(3), VFR(7), o[1]), C1, 12, MWC, 16); \
    } while (0)
    int t = 1;
    for (; t + 7 < NT; t += 2) {
        STEP(pB0, pB1, pA0, pA1, t, false, true, true, true, mwB, mwA);     WAIT_BAR_P(2, mwA); ROT();
        STEP(pA0, pA1, pB0, pB1, t + 1, false, true, true, true, mwA, mwB); WAIT_BAR_P(2, mwB); ROT();
    }
#define ENDW(tt, mw) do { if ((tt) + 3 < NT) { WAIT_BAR(2); } else if ((tt) + 2 < NT) { WAIT_BAR(1); } else { WAIT_BAR(0); } asm volatile("" : "+v"(mw)); } while (0)
    for (; t + 1 < NT; t += 2) {
        STEP(pB0, pB1, pA0, pA1, t, true, (t + 3 < NT), (t + 1 < NT), (t + 1 < NT), mwB, mwA);         ENDW(t, mwA);     ROT();
        STEP(pA0, pA1, pB0, pB1, t + 1, true, (t + 4 < NT), (t + 2 < NT), (t + 2 < NT), mwA, mwB);     ENDW(t + 1, mwB); ROT();
    }
    STEP(pB0, pB1, pA0, pA1, NT - 1, true, false, false, false, mwB, mwA);
    { float sacc = pB0[0] + pB0[1];
#pragma unroll
      for (int r = 2; r < 16; ++r) sacc += pB0[r];
#pragma unroll
      for (int r = 0; r < 16; ++r) sacc += pB1[r];
      l_reg += sacc;
      pw0 = (u32x4){PKW(pB0, 0), PKW(pB0, 2), PKW(pB0, 4), PKW(pB0, 6)}; pw1 = (u32x4){PKW(pB0, 8), PKW(pB0, 10), PKW(pB0, 12), PKW(pB0, 14)};
      pw2 = (u32x4){PKW(pB1, 0), PKW(pB1, 2), PKW(pB1, 4), PKW(pB1, 6)}; pw3 = (u32x4){PKW(pB1, 8), PKW(pB1, 10), PKW(pB1, 12), PKW(pB1, 14)};
      const lds_cptr vp_ = vp0 + sl_cur; _Pragma("unroll") for (int i = 0; i < 8; ++i) VRD(i);
      o[0] = MFMA32(PAF(0), VFR(0), o[0]); o[1] = MFMA32(PAF(0), VFR(4), o[1]); o[0] = MFMA32(PAF(1), VFR(1), o[0]); o[1] = MFMA32(PAF(1), VFR(5), o[1]);
      o[0] = MFMA32(PAF(2), VFR(2), o[0]); o[1] = MFMA32(PAF(2), VFR(6), o[1]); o[0] = MFMA32(PAF(3), VFR(3), o[0]); o[1] = MFMA32(PAF(3), VFR(7), o[1]); }
    asm volatile("s_waitcnt lgkmcnt(0)\n\ts_barrier" ::: "memory");
    u32x4 zzv[4];
#pragma unroll
    for (int i = 0; i < 4; ++i) { const int row = i * 8 + (lane >> 3), ch = lane & 7; zzv[i] = *(const u32x4*)((const bf16_t*)(ws + WS_ZA) + (rowbase + (size_t)(xw + row)) * 512 + h * 64 + ch * 8); }
    { auto rr = __builtin_amdgcn_permlane32_swap(__float_as_uint(l_reg), __float_as_uint(l_reg), false, false); l_reg = __uint_as_float(rr[0]) + __uint_as_float(rr[1]); }
    ALDS float* wsf = (ALDS float*)(shm + LDS_WS) + wid * 64;
    ALDS float* stg = (ALDS float*)(shm + LDS_OST) + wid * 2048;
    if (hi == 0) wsf[r32] = l_reg;
#pragma unroll
    for (int r = 0; r < 16; ++r) { const int orow = (r & 3) + 8 * (r >> 2) + 4 * hi; stg[orow * 64 + r32] = o[0][r]; stg[orow * 64 + 32 + r32] = o[1][r]; }
    asm volatile("s_waitcnt lgkmcnt(0)" ::: "memory");
#pragma unroll
    for (int i = 0; i < 4; ++i) {
        const int row = i * 8 + (lane >> 3), ch = lane & 7; const size_t tok = rowbase + (size_t)(xw + row); const int col = h * 64 + ch * 8;
        const f32x4 a0 = *(const ALDS f32x4*)(stg + row * 64 + ch * 8), a1 = *(const ALDS f32x4*)(stg + row * 64 + ch * 8 + 4); const float rl = 1.f / wsf[row];
        float v[8] = {a0[0], a0[1], a0[2], a0[3], a1[0], a1[1], a1[2], a1[3]};
        const u32x4 zz = zzv[i];
#pragma unroll
        for (int e = 0; e < 4; ++e) { v[2 * e] *= rl * silu(__uint_as_float(zz[e] << 16)); v[2 * e + 1] *= rl * silu(__uint_as_float(zz[e] & 0xffff0000u)); }
        u32x4 w; w.x = cvtpk(v[0], v[1]); w.y = cvtpk(v[2], v[3]); w.z = cvtpk(v[4], v[5]); w.w = cvtpk(v[6], v[7]);
        *(u32x4*)((bf16_t*)(ws + WS_MIX) + tok * 1024 + col) = w;
    }
    asm volatile("s_waitcnt lgkmcnt(0)\n\ts_barrier" ::: "memory");
#undef DMA_K
#undef DMA_V
#undef MLOAD
#undef WAIT_BAR
#undef WAIT_BAR_P
#undef ROT
#undef PKW
#undef PAF
#undef VFR
#undef VRD
#undef KRD
#undef GAPA
#undef GAPB
#undef GAPO
#undef STEP
#undef ENDW
}
#define A2_MLOAD(dst, ptr, tt) asm volatile("global_load_dword %0, %1, %2" : "=v"(dst) : "v"(mvo), "s"((ptr) + (size_t)(tt) * 64) : "memory")
#define A2_PKW(P, i) cvtpk(P[i], P[(i) + 1])
#define A2_BC(x) __builtin_bit_cast(bf16x8, x)
__device__ __forceinline__ void bias_near4(f32x16& c0, f32x16& c1, const ALDS float* tab, int jb) {
#pragma unroll
    for (int g = 0; g < 4; ++g) {
#pragma unroll
        for (int rr = 0; rr < 4; ++rr) { const int r = 4 * g + rr; const int c = (r & 3) + 8 * (r >> 2); unsigned j0 = (unsigned)(jb - c), j1 = (unsigned)(jb - c - 32); j0 = j0 < 128u ? j0 : 128u; j1 = j1 < 128u ? j1 : 128u; c0[r] += tab[j0]; c1[r] += tab[j1]; }
        __builtin_amdgcn_sched_barrier(0); }
}
__device__ __forceinline__ void attn_unit_a2(int b, int h, int qb, const bool load_tab, unsigned char* ws, lds_ptr shm) {
    int tid_ = threadIdx.x; asm volatile("" : "+v"(tid_));
    const int tid = tid_, lane = tid & 63, r32 = lane & 31, hi = lane >> 5; const int wid = __builtin_amdgcn_readfirstlane(tid >> 6);
    const int grp = wid >> 2;
    const size_t rowbase = (size_t)b * SEQ; const int u0 = qb * 512, NT = 8 * qb + 8;
    const int xa = u0 + 32 * wid, xb = u0 + 32 * (15 - wid);
    const int TS = xa >= 191 ? (xa - 191) / 64 + 1 : 0;
    const bf16_t* Qg = (const bf16_t*)(ws + WS_QA) + rowbase * 512 + h * 64;
    const bf16_t* Kg = (const bf16_t*)(ws + WS_KA) + rowbase * 512 + h * 64;
    const bf16_t* Vg = (const bf16_t*)(ws + WS_VA) + rowbase * 512 + h * 64;
    const unsigned lds0 = (unsigned)(uintptr_t)shm;
    ALDS float* tab = (ALDS float*)(shm + LDS_TAB);
    if (load_tab) { const float tv = ((const float*)(ws + WS_ATAB))[h * TABN + (tid < TABN ? tid : TABN - 1)]; if (tid < TABN) tab[tid] = tv; }
    const unsigned kvo = (unsigned)(lane * 1024 + wid * 16), vvo = (unsigned)((16 * (wid & 3) + (lane >> 2)) * 1024 + (wid >> 2) * 64 + (lane & 3) * 16), mvo = (unsigned)(lane * 4);
    const unsigned kdst = lds0 + LDS_K + wid * 1024, vdst = lds0 + LDS_V + wid * 1024;
#define A2_DMA_K(t, slot) glds16s(Kg + (size_t)(t) * 64 * 512, kvo, (unsigned)__builtin_amdgcn_readfirstlane(kdst + (slot)))
#define A2_DMA_V(t, slot) glds16s(Vg + (size_t)(t) * 64 * 512, vvo, (unsigned)__builtin_amdgcn_readfirstlane(vdst + (slot)))
    const lds_cptr vp0 = (lds_cptr)shm + LDS_V + ((lane >> 4) & 1) * 32 + (lane & 3) * 8 + (4 * hi + ((lane & 15) >> 2)) * 64;
    const lds_cptr kp0 = (lds_cptr)shm + LDS_K + hi * 1024 + r32 * 16;
    const unsigned* mpa = (const unsigned*)(ws + WS_MASK) + (((size_t)b * 128 + (xa >> 5)) * 64) * 64;
    const unsigned* mpb = (const unsigned*)(ws + WS_MASK) + (((size_t)b * 128 + (xb >> 5)) * 64) * 64;
    bf16x8 qa[4], qbv[4];
    { const bf16_t* qp = Qg + (size_t)(xa + r32) * 512 + hi * 8; const bf16_t* qp2 = Qg + (size_t)(xb + r32) * 512 + hi * 8;
#pragma unroll
      for (int d0 = 0; d0 < 4; ++d0) { qa[d0] = *(const bf16x8*)(qp + d0 * 16); qbv[d0] = *(const bf16x8*)(qp2 + d0 * 16); } }
    unsigned man, mbn, mac = 0u, mbc = 0u, map_ = 0u, mbp = 0u;
    A2_DMA_K(0, 0); A2_MLOAD(man, mpa, 0); A2_MLOAD(mbn, mpb, 0); A2_DMA_K(1, SLOTB); A2_DMA_V(0, 0);
    const f32x16 zero16 = f32x16{};
    f32x16 oa0 = f32x16{}, oa1 = f32x16{}, ob0 = f32x16{}, ob1 = f32x16{}; float la = 0.f, lb = 0.f;
    f32x16 sa0 = f32x16{}, sa1 = f32x16{}, sb0 = f32x16{}, sb1 = f32x16{}; u32x4 pwa[4], pwb[4];
#pragma unroll
    for (int i = 0; i < 4; ++i) { pwa[i] = (u32x4){0u, 0u, 0u, 0u}; pwb[i] = (u32x4){0u, 0u, 0u, 0u}; }
    const int jba = xa + r32 - 4 * hi;
#define jbb (jba + (xb - xa))
    asm volatile("s_waitcnt vmcnt(2) lgkmcnt(0)\n\ts_barrier" ::: "memory");
    asm volatile("" : "+v"(man), "+v"(mbn));
#pragma unroll
    for (int d0 = 0; d0 < 4; ++d0) asm volatile("" : "+v"(qa[d0]), "+v"(qbv[d0]));
    mac = man; mbc = mbn;
    int s_prev = 2 * SLOTB, s_cur = 0, s_next = SLOTB;
#define A2_SOFT(S0, S1, PW, L, MW, NEAR, JB, x) do { \
        if (NEAR) bias_near4(S0, S1, tab, (JB) - 64 * (x)); \
        MEXP4(S0, 0, MW, 0); MEXP4(S0, 4, MW, 4); MEXP4(S0, 8, MW, 8); MEXP4(S0, 12, MW, 12); MEXP4(S1, 0, MW, 16); MEXP4(S1, 4, MW, 20); MEXP4(S1, 8, MW, 24); MEXP4(S1, 12, MW, 28); \
        _Pragma("unroll") for (int r = 0; r < 16; ++r) asm("v_add_f32 %0, %0, %1" : "+v"(L) : "v"(S0[r])); \
        _Pragma("unroll") for (int r = 0; r < 16; ++r) asm("v_add_f32 %0, %0, %1" : "+v"(L) : "v"(S1[r])); \
        PW[0] = (u32x4){A2_PKW(S0, 0), A2_PKW(S0, 2), A2_PKW(S0, 4), A2_PKW(S0, 6)}; PW[1] = (u32x4){A2_PKW(S0, 8), A2_PKW(S0, 10), A2_PKW(S0, 12), A2_PKW(S0, 14)}; \
        PW[2] = (u32x4){A2_PKW(S1, 0), A2_PKW(S1, 2), A2_PKW(S1, 4), A2_PKW(S1, 6)}; PW[3] = (u32x4){A2_PKW(S1, 8), A2_PKW(S1, 10), A2_PKW(S1, 12), A2_PKW(S1, 14)}; } while (0)
#define A2_SPART(x, MA, MB) do { if ((x) >= 0 && (x) < NT) { \
        if (64 * (x) <= xb + 31) { A2_SOFT(sb0, sb1, pwb, lb, MB, 64 * (x) + 63 > xb - 128, jbb, x); } \
        if (64 * (x) <= xa + 31) { A2_SOFT(sa0, sa1, pwa, la, MA, 64 * (x) + 63 > xa - 128, jba, x); } } \
        __builtin_amdgcn_sched_barrier(0); } while (0)
#define A2_SSTEADY(MA, MB) do { A2_SOFT(sb0, sb1, pwb, lb, MB, false, jbb, 0); A2_SOFT(sa0, sa1, pwa, la, MA, false, jba, 0); __builtin_amdgcn_sched_barrier(0); } while (0)
#define A2_VRD2(k, VL0, VH0, VL1, VH1) do { VL0 = vtr(vp_ + (k) * 1024); VH0 = vtr(vp_ + (k) * 1024 + 512); VL1 = vtr(vp_ + 4096 + (k) * 1024); VH1 = vtr(vp_ + 4096 + (k) * 1024 + 512); } while (0)
#define A2_V8(L, H) (bf16x8){L[0], L[1], L[2], L[3], H[0], H[1], H[2], H[3]}
#define A2_PV(BOTH) do { const lds_cptr vp_ = vp0 + s_prev; s16x4 l0, h0, l1, h1, l0n, h0n, l1n, h1n; \
            A2_VRD2(0, l0, h0, l1, h1); \
            _Pragma("unroll") for (int k = 0; k < 4; ++k) { \
                if (k < 3) A2_VRD2(k + 1, l0n, h0n, l1n, h1n); \
                __builtin_amdgcn_sched_barrier(0); \
                ob0 = MFMA32(A2_BC(pwb[k]), A2_V8(l0, h0), ob0); ob1 = MFMA32(A2_BC(pwb[k]), A2_V8(l1, h1), ob1); \
                if (BOTH) { oa0 = MFMA32(A2_BC(pwa[k]), A2_V8(l0, h0), oa0); oa1 = MFMA32(A2_BC(pwa[k]), A2_V8(l1, h1), oa1); } \
                __builtin_amdgcn_sched_barrier(0); \
                l0 = l0n; h0 = h0n; l1 = l1n; h1 = h1n; } } while (0)
#define A2_QK(BOTH) do { const lds_cptr kb_ = kp0 + s_cur; bf16x8 k0 = *(const ALDS bf16x8*)(kb_), k1 = *(const ALDS bf16x8*)(kb_ + 512), k0n, k1n; \
            _Pragma("unroll") for (int d0 = 0; d0 < 4; ++d0) { \
                if (d0 < 3) { k0n = *(const ALDS bf16x8*)(kb_ + (d0 + 1) * 2048); k1n = *(const ALDS bf16x8*)(kb_ + (d0 + 1) * 2048 + 512); } \
                __builtin_amdgcn_sched_barrier(0); \
                sb0 = MFMA32(k0, qbv[d0], d0 == 0 ? zero16 : sb0); sb1 = MFMA32(k1, qbv[d0], d0 == 0 ? zero16 : sb1); \
                if (BOTH) { sa0 = MFMA32(k0, qa[d0], d0 == 0 ? zero16 : sa0); sa1 = MFMA32(k1, qa[d0], d0 == 0 ? zero16 : sa1); } \
                __builtin_amdgcn_sched_barrier(0); \
                k0 = k0n; k1 = k1n; } } while (0)
#define A2_MPART(t) do { \
        if ((t) >= 1 && 64 * ((t) - 1) <= xb + 31) { { const bool bo_ = 64 * ((t) - 1) <= xa + 31; A2_PV(bo_); } } \
        if ((t) < NT && 64 * (t) <= xb + 31) { { const bool bo_ = 64 * (t) <= xa + 31; A2_QK(bo_); } } } while (0)
#define A2_MSTEADY() do { A2_PV(true); A2_QK(true); } while (0)
#define A2_ISSUE(t) do { if ((t) + 1 < NT) { A2_MLOAD(man, mpa, (t) + 1); A2_MLOAD(mbn, mpb, (t) + 1); } if ((t) + 2 < NT) A2_DMA_K((t) + 2, s_prev); if ((t) + 1 < NT) A2_DMA_V((t) + 1, s_next); } while (0)
#define A2_ISSUE_S(t) do { A2_MLOAD(man, mpa, (t) + 1); A2_MLOAD(mbn, mpb, (t) + 1); A2_DMA_K((t) + 2, s_prev); A2_DMA_V((t) + 1, s_next); } while (0)
#define A2_ROT() do { asm volatile("" : "+v"(man), "+v"(mbn)); map_ = mac; mbp = mbc; mac = man; mbc = mbn; { const int tmp = s_prev; s_prev = s_cur; s_cur = s_next; s_next = tmp; } } while (0)
#define A2_CLOSE(t) do { \
        if ((t) + 2 < NT) asm volatile("s_waitcnt vmcnt(2) lgkmcnt(0)\n\ts_barrier" ::: "memory"); \
        else if ((t) + 1 < NT) asm volatile("s_waitcnt vmcnt(1) lgkmcnt(0)\n\ts_barrier" ::: "memory"); \
        else asm volatile("s_waitcnt vmcnt(0) lgkmcnt(0)\n\ts_barrier" ::: "memory"); \
        A2_ROT(); } while (0)
#define A2_CLOSE_S() do { asm volatile("s_waitcnt vmcnt(2) lgkmcnt(0)\n\ts_barrier" ::: "memory"); A2_ROT(); } while (0)
    if (grp == 0) {
        A2_ISSUE(0); A2_MPART(0); A2_SPART(0, mac, mbc); A2_CLOSE(0);
        int t = 1;
        for (; t < TS; ++t) { A2_ISSUE_S(t); A2_MSTEADY(); A2_SSTEADY(mac, mbc); A2_CLOSE_S(); }
        for (; t < NT; ++t) { A2_ISSUE(t); A2_MPART(t); A2_SPART(t, mac, mbc); A2_CLOSE(t); }
        A2_MPART(NT);
    } else {
        A2_ISSUE(0); A2_MPART(0); A2_CLOSE(0);
        int t = 1;
        for (; t < TS; ++t) { A2_ISSUE_S(t); A2_SSTEADY(map_, mbp); A2_MSTEADY(); A2_CLOSE_S(); }
        for (; t < NT; ++t) { A2_ISSUE(t); A2_SPART(t - 1, map_, mbp); A2_MPART(t); A2_CLOSE(t); }
        A2_SPART(NT - 1, map_, mbp); A2_MPART(NT);
    }
    asm volatile("s_waitcnt lgkmcnt(0)\n\ts_barrier" ::: "memory");
    ALDS float* wsf = (ALDS float*)(shm + LDS_WS) + wid * 64;
    ALDS float* stg = (ALDS float*)(shm + LDS_OST) + wid * 2048;
#define A2_EPI(O0, O1, L, X) do { u32x4 zzv[4]; \
        _Pragma("unroll") for (int i = 0; i < 4; ++i) { const int row = i * 8 + (lane >> 3), ch = lane & 7; zzv[i] = *(const u32x4*)((const bf16_t*)(ws + WS_ZA) + (rowbase + (size_t)((X) + row)) * 512 + h * 64 + ch * 8); } \
        float l_ = L; { auto rr = __builtin_amdgcn_permlane32_swap(__float_as_uint(l_), __float_as_uint(l_), false, false); l_ = __uint_as_float(rr[0]) + __uint_as_float(rr[1]); } \
        if (hi == 0) wsf[r32] = l_; \
        _Pragma("unroll") for (int r = 0; r < 16; ++r) { const int orow = (r & 3) + 8 * (r >> 2) + 4 * hi; stg[orow * 64 + r32] = O0[r]; stg[orow * 64 + 32 + r32] = O1[r]; } \
        asm volatile("s_waitcnt lgkmcnt(0)" ::: "memory"); \
        _Pragma("unroll") for (int i = 0; i < 4; ++i) { \
            const int row = i * 8 + (lane >> 3), ch = lane & 7; const size_t tok = rowbase + (size_t)((X) + row); const int col = h * 64 + ch * 8; \
            const f32x4 a0 = *(const ALDS f32x4*)(stg + row * 64 + ch * 8), a1 = *(const ALDS f32x4*)(stg + row * 64 + ch * 8 + 4); const float rl = 1.f / wsf[row]; \
            float v[8] = {a0[0], a0[1], a0[2], a0[3], a1[0], a1[1], a1[2], a1[3]}; const u32x4 zz = zzv[i]; \
            _Pragma("unroll") for (int e = 0; e < 4; ++e) { v[2 * e] *= rl * silu(__uint_as_float(zz[e] << 16)); v[2 * e + 1] *= rl * silu(__uint_as_float(zz[e] & 0xffff0000u)); } \
            u32x4 w; w.x = cvtpk(v[0], v[1]); w.y = cvtpk(v[2], v[3]); w.z = cvtpk(v[4], v[5]); w.w = cvtpk(v[6], v[7]); \
            *(u32x4*)((bf16_t*)(ws + WS_MIX) + tok * 1024 + col) = w; } \
        asm volatile("s_waitcnt lgkmcnt(0)" ::: "memory"); } while (0)
    A2_EPI(oa0, oa1, la, xa);
    A2_EPI(ob0, ob1, lb, xb);
    asm volatile("s_waitcnt lgkmcnt(0)\n\ts_barrier" ::: "memory");
#undef A2_DMA_K
#undef A2_DMA_V
#undef A2_SOFT
#undef A2_SPART
#undef A2_SSTEADY
#undef A2_VRD2
#undef A2_V8
#undef A2_PV
#undef A2_QK
#undef A2_MPART
#undef A2_MSTEADY
#undef A2_ISSUE
#undef A2_ISSUE_S
#undef A2_ROT
#undef A2_CLOSE
#undef A2_CLOSE_S
#undef A2_EPI
#undef jbb
}
}

__device__ __forceinline__ int vcu_of_block() { const int G = gridDim.x, bx = blockIdx.x; return (G % 8 == 0) ? (bx % 8) * (G / 8) + bx / 8 : bx; }

__device__ __forceinline__ void phase_attn_a(unsigned char* ws, att::lds_ptr shm) {
    const int G = gridDim.x;
    int prev_h = -1;
    for (int id = vcu_of_block(); id < 1024; id += G) {
        const int i = id >> 8, v = id & 255, bh = v >> 1, half = v & 1, s = i >> 1; const int qb = (i & 1) ? 7 - (2 * s + half) : 2 * s + half;
        att::attn_unit_a2(bh >> 3, bh & 7, qb, (bh & 7) != prev_h, ws, shm); prev_h = bh & 7;
    }
}
__device__ __forceinline__ att::Unit unit_b12(int id) { const int blk = id >> 8, v = id & 255, bh = v >> 1, half = v & 1; return att::Unit{bh >> 3, bh & 7, 1 + half, half ? 4 : 1, half ? (blk & 3) : 0, half ? (blk >> 2) * 256 : blk * 256}; }
__device__ __forceinline__ void phase_attn_b12(unsigned char* ws, att::lds_ptr shm) {
    const int G = gridDim.x; att::bf16x8 qr[4]; bool first = true;
    for (int id = vcu_of_block(); id < 4096; id += G) { const bool hn = id + G < 4096;
        att::attn_unit<1>(unit_b12(id), first, unit_b12(hn ? id + G : id), hn, ws, shm, qr); first = false; }
}
__device__ __forceinline__ att::Unit unit_b3(int id) { const int i = id >> 8, v = id & 255, bh = v >> 1, half = v & 1; return att::Unit{bh >> 3, bh & 7, 3, 16, half * 8 + i, 0}; }
__device__ __forceinline__ void phase_attn_b3(unsigned char* ws, att::lds_ptr shm) {
    const int G = gridDim.x; att::bf16x8 qr[4]; bool first = true;
    for (int id = vcu_of_block(); id < 2048; id += G) { const bool hn = id + G < 2048;
        att::attn_unit<2>(unit_b3(id), first, unit_b3(hn ? id + G : id), hn, ws, shm, qr); first = false; }
}
namespace tk {
using bf16x8 = __attribute__((ext_vector_type(8))) short;
using f32x16 = __attribute__((ext_vector_type(16))) float;
using u32x4 = __attribute__((ext_vector_type(4))) unsigned;
#define TLDS __attribute__((address_space(3)))
typedef TLDS unsigned char* lds_ptr;
constexpr int CAP = 384;
constexpr int HSTR = 1028;
constexpr int L_HIST = 0;
constexpr int L_LIST = 0;
constexpr int L_ZB = 98304;
constexpr int L_IMG = 114688;
constexpr int L_H2 = 131584;
constexpr int L_SC = 139776;
constexpr int L_FB = 0;
constexpr int LDS_BYTES = 140800;

__device__ __forceinline__ unsigned mono(float s) { const unsigned u = __float_as_uint(s); return (u & 0x80000000u) ? ~u : (u | 0x80000000u); }

__device__ __forceinline__ float relu_i(float x) { const int xi = __float_as_int(x); return __int_as_float(xi > 0 ? xi : 0); }
__device__ __forceinline__ void load_kf(bf16x8 (&kf)[4], const bf16_t* __restrict__ KIb, int j, int r32, int hi) {
    const bf16_t* kp = KIb + (size_t)(32 * j + r32) * 64 + hi * 8;
#pragma unroll
    for (int s = 0; s < 4; ++s) kf[s] = *(const bf16x8*)(kp + s * 16);
}
__device__ __forceinline__ f32x16 bscore(const bf16x8 (&kf)[4], const bf16x8 (&qf)[4][4], const float (&w)[4]) {
    f32x16 B;
#pragma unroll
    for (int r = 0; r < 16; ++r) B[r] = 512.f;
#pragma unroll
    for (int h = 0; h < 4; ++h) {
        f32x16 a;
#pragma unroll
        for (int r = 0; r < 16; ++r) a[r] = 0.f;
#pragma unroll
        for (int s = 0; s < 4; ++s) a = __builtin_amdgcn_mfma_f32_32x32x16_bf16(kf[s], qf[h][s], a, 0, 0, 0);
#pragma unroll
        for (int r = 0; r < 16; ++r) B[r] = fmaf(w[h], relu_i(a[r]), B[r]);
    }
    return B;
}
template <bool DIAG> __device__ __forceinline__ void p1_block(const f32x16& B, TLDS unsigned* hrow, int r32, int hi) {
#pragma unroll
    for (int r = 0; r < 16; ++r) { const int c = (r & 3) + 8 * (r >> 2) + 4 * hi; const int bin = (int)__builtin_amdgcn_fmed3f(B[r], 0.f, 1023.5f);
        if (!DIAG || c <= r32) __hip_atomic_fetch_add(hrow + bin, 1u, __ATOMIC_RELAXED, __HIP_MEMORY_SCOPE_WORKGROUP); }
}
__device__ __forceinline__ void img_set(TLDS unsigned* img, unsigned ql, unsigned idx) {
    const unsigned kk = idx & 31u, r = (kk & 3u) | ((kk >> 3) << 2), hh = (kk >> 2) & 1u;
    __hip_atomic_fetch_or(img + (idx >> 6) * 64u + ql + 32u * hh, 1u << (16u * ((idx >> 5) & 1u) + r), __ATOMIC_RELAXED, __HIP_MEMORY_SCOPE_WORKGROUP);
}
template <bool DIAG> __device__ __forceinline__ void p2_block(const f32x16& B, int j, float mylo, float myhi, unsigned kbase, bool ztie, int lane, int r32, int hi, TLDS unsigned* img, TLDS unsigned long long* lists, TLDS unsigned* ccnt, TLDS unsigned* zb) {
    unsigned bits = 0u; bool anyc = false;
#pragma unroll
    for (int r = 0; r < 16; ++r) { const int c = (r & 3) + 8 * (r >> 2) + 4 * hi; const bool ok = !DIAG || c <= r32; const bool def = ok && (B[r] >= myhi); anyc |= ok && !def && (B[r] >= mylo);
        bits |= def ? (1u << r) : 0u; }
    ((TLDS unsigned short*)img)[((j >> 1) * 64 + lane) * 2 + (j & 1)] = (unsigned short)bits;
    if (__any(anyc)) {
#pragma unroll
        for (int r = 0; r < 16; ++r) { const int c = (r & 3) + 8 * (r >> 2) + 4 * hi; const bool ok = !DIAG || c <= r32;
            if (ok && (B[r] >= mylo) && !(B[r] >= myhi)) { unsigned jb_ = (unsigned)(32 * j + 4 * hi); asm volatile("" : "+v"(jb_));
                const unsigned idx = jb_ + (unsigned)((r & 3) + 8 * (r >> 2));
                if (ztie && B[r] == 512.f) __hip_atomic_fetch_or(zb + r32 * 128 + (idx >> 5), 1u << (idx & 31u), __ATOMIC_RELAXED, __HIP_MEMORY_SCOPE_WORKGROUP);
                else { const unsigned slot = __hip_atomic_fetch_add(ccnt + r32, 1u, __ATOMIC_RELAXED, __HIP_MEMORY_SCOPE_WORKGROUP);
                    if (slot < (unsigned)CAP) lists[r32 * CAP + slot] = ((unsigned long long)(mono(B[r]) - kbase) << 12) | (unsigned long long)(4095u - idx); } } }
    }
}

__device__ __forceinline__ void topk_unit(int b, int qb32, unsigned char* ws, lds_ptr shm) {
    int tid_ = threadIdx.x; asm volatile("" : "+v"(tid_));
    const int tid = tid_, lane = tid & 63, r32 = lane & 31, hi = lane >> 5; const int wid = __builtin_amdgcn_readfirstlane(tid >> 6);
    const int q0 = 32 * qb32, nkb = qb32 + 1; const size_t rowbase = (size_t)b * SEQ;
    const bf16_t* KIb = (const bf16_t*)(ws + WS_KI) + rowbase * 64;
    TLDS unsigned* hist = (TLDS unsigned*)(shm + L_HIST); TLDS unsigned long long* lists = (TLDS unsigned long long*)(shm + L_LIST); TLDS unsigned* img = (TLDS unsigned*)(shm + L_IMG);
    TLDS unsigned* h2 = (TLDS unsigned*)(shm + L_H2); TLDS float* tlo = (TLDS float*)(shm + L_SC); TLDS float* thi = tlo + 32; TLDS int* needv = (TLDS int*)(thi + 32); TLDS unsigned* ccnt = (TLDS unsigned*)(needv + 32); TLDS unsigned* zb = (TLDS unsigned*)(shm + L_ZB);
    { TLDS u32x4* hz = (TLDS u32x4*)hist;
#pragma unroll
      for (int i = 0; i < 16; ++i) hz[tid + 512 * i] = (u32x4){0u, 0u, 0u, 0u};
      if (tid < 32) hz[8192 + tid] = (u32x4){0u, 0u, 0u, 0u}; }
    if (tid < 32) ccnt[tid] = 0u;
    bf16x8 qf[4][4]; float w[4];
    { const bf16_t* qp = (const bf16_t*)(ws + WS_QI) + (rowbase + q0 + r32) * 256 + hi * 8;
#pragma unroll
      for (int h = 0; h < 4; ++h)
#pragma unroll
          for (int s = 0; s < 4; ++s) qf[h][s] = *(const bf16x8*)(qp + h * 64 + s * 16);
      const float4 wv = *(const float4*)((const float*)(ws + WS_WI) + (rowbase + q0 + r32) * 4);
      float n2[4];
#pragma unroll
      for (int h = 0; h < 4; ++h) { float a = 0.f;
#pragma unroll
          for (int s2 = 0; s2 < 4; ++s2)
#pragma unroll
              for (int e = 0; e < 8; ++e) { const float v = bf2f((bf16_t)qf[h][s2][e]); a = fmaf(v, v, a); }
          n2[h] = a + __shfl_xor(a, 32); }
      const float S2 = wv.x * wv.x * n2[0] + wv.y * wv.y * n2[1] + wv.z * wv.z * n2[2] + wv.w * wv.w * n2[3];
      const float g = S2 > 1e-30f ? 128.f * rsqrtf(S2) : 0.f; w[0] = wv.x * g; w[1] = wv.y * g; w[2] = wv.z * g; w[3] = wv.w * g; }
    __syncthreads();
    { bf16x8 kf[4], kn[4]; int j = wid; if (j < nkb) load_kf(kf, KIb, j, r32, hi); TLDS unsigned* hrow = hist + r32 * HSTR;
      for (; j < nkb; j += 8) {
        const bool more = j + 8 < nkb; if (more) load_kf(kn, KIb, j + 8, r32, hi);
        const f32x16 B = bscore(kf, qf, w);
        if (j == qb32) p1_block<true>(B, hrow, r32, hi); else p1_block<false>(B, hrow, r32, hi);
        if (more) {
#pragma unroll
            for (int s2 = 0; s2 < 4; ++s2) kf[s2] = kn[s2]; }
      } }
    __syncthreads();
    { const int q = tid >> 4, sub = tid & 15; const TLDS unsigned* hq = hist + q * HSTR; unsigned csum = 0u;
#pragma unroll
      for (int i = 0; i < 16; ++i) { const u32x4 v = *(const TLDS u32x4*)(hq + 64 * sub + 4 * i); csum += (v.x + v.y) + (v.z + v.w); }
      unsigned incl = csum;
#pragma unroll
      for (int off = 1; off < 16; off <<= 1) { const unsigned t = __shfl_down(incl, off, 16); if (sub + off < 16) incl += t; }
      const unsigned total = __shfl(incl, 0, 16); unsigned above = incl - csum;
      const bool f1 = (above < 256u) && (above + csum >= 256u);
      const unsigned long long bal1 = __ballot(f1); const unsigned g1 = (unsigned)(bal1 >> (16 * ((lane >> 4) & 3))) & 0xffffu;
      if (total < 256u || g1 == 0u) { if (sub == 0) { tlo[q] = -INFINITY; thi[q] = -INFINITY; needv[q] = 0; } }
      else {
          const int cst = __builtin_ctz(g1); const unsigned ab1 = __shfl(above, cst, 16);
          const u32x4 v = *(const TLDS u32x4*)(hq + 64 * cst + 4 * sub); const unsigned c4 = (v.x + v.y) + (v.z + v.w); unsigned in2 = c4;
#pragma unroll
          for (int off = 1; off < 16; off <<= 1) { const unsigned t = __shfl_down(in2, off, 16); if (sub + off < 16) in2 += t; }
          unsigned ab2 = ab1 + (in2 - c4);
          if ((ab2 < 256u) && (ab2 + c4 >= 256u)) { int bs;
              if (ab2 + v.w >= 256u) bs = 3; else { ab2 += v.w; if (ab2 + v.z >= 256u) bs = 2; else { ab2 += v.z; if (ab2 + v.y >= 256u) bs = 1; else { ab2 += v.y; bs = 0; } } }
              const int bstar = 64 * cst + 4 * sub + bs;
              tlo[q] = bstar <= 0 ? -INFINITY : (float)bstar; thi[q] = bstar >= 1023 ? INFINITY : (float)(bstar + 1); needv[q] = 256 - (int)ab2; }
      }
    }
    __syncthreads();
    if (tid < 64) img[(qb32 >> 1) * 64 + tid] = 0u;
    { TLDS u32x4* zz = (TLDS u32x4*)zb; zz[tid] = (u32x4){0u, 0u, 0u, 0u}; zz[tid + 512] = (u32x4){0u, 0u, 0u, 0u}; }
    __syncthreads();
    { const float mylo = tlo[r32], myhi = thi[r32]; const unsigned kbase = (mylo == -INFINITY) ? 0u : mono(mylo); const bool ztie = (mylo == 512.f);
      bf16x8 kf[4], kn[4]; int j = wid; if (j < nkb) load_kf(kf, KIb, j, r32, hi);
      for (; j < nkb; j += 8) {
        const bool more = j + 8 < nkb; if (more) load_kf(kn, KIb, j + 8, r32, hi);
        const f32x16 B = bscore(kf, qf, w);
        if (j == qb32) p2_block<true>(B, j, mylo, myhi, kbase, ztie, lane, r32, hi, img, lists, ccnt, zb); else p2_block<false>(B, j, mylo, myhi, kbase, ztie, lane, r32, hi, img, lists, ccnt, zb);
        if (more) {
#pragma unroll
            for (int s2 = 0; s2 < 4; ++s2) kf[s2] = kn[s2]; }
      } }
    __syncthreads();
    { const int q = 4 * wid + (lane >> 4), sub = lane & 15; const unsigned craw = ccnt[q]; const int C = craw > (unsigned)CAP ? CAP : (int)craw; int need = (craw > (unsigned)CAP) ? 0 : needv[q];
      int needz = 0; if (need > C) { needz = need - C; need = C; }
      int cm = C; cm = max(cm, __shfl_xor(cm, 16)); cm = max(cm, __shfl_xor(cm, 32));
      const TLDS unsigned long long* list = lists + q * CAP; TLDS unsigned* hq = h2 + q * 64; unsigned long long prefix = 0ull;
      unsigned long long cr[8]; unsigned long long kmax = 0ull;
#pragma unroll
      for (int e = 0; e < 8; ++e) { const int i = sub + 16 * e; cr[e] = (i < C) ? list[i] : ~0ull; if (i < C) kmax = kmax > cr[e] ? kmax : cr[e]; }
      for (int i = sub + 128; i < cm; i += 16) if (i < C) { const unsigned long long ck = list[i]; kmax = kmax > ck ? kmax : ck; }
#pragma unroll
      for (int o = 1; o < 64; o <<= 1) { const unsigned long long t = __shfl_xor(kmax, o); kmax = kmax > t ? kmax : t; }
      const int nb = 64 - __builtin_clzll(kmax | 1ull); const int L = (nb + 5) / 6;
      for (int level = 0; level < L; ++level) {
          const int shift = 6 * (L - 1 - level);
          *(TLDS u32x4*)(hq + 4 * sub) = (u32x4){0u, 0u, 0u, 0u};
          asm volatile("s_waitcnt lgkmcnt(0)" ::: "memory");
#pragma unroll
          for (int e = 0; e < 8; ++e) { const unsigned long long ck = cr[e]; if (ck != ~0ull && (ck >> (shift + 6)) == prefix) __hip_atomic_fetch_add(hq + (unsigned)((ck >> shift) & 63ull), 1u, __ATOMIC_RELAXED, __HIP_MEMORY_SCOPE_WORKGROUP); }
          for (int i = sub + 128; i < cm; i += 32) { const bool v0 = i < C, v1 = i + 16 < C; const unsigned long long k0 = v0 ? list[i] : 0ull, k1 = v1 ? list[i + 16] : 0ull;
              if (v0 && (k0 >> (shift + 6)) == prefix) __hip_atomic_fetch_add(hq + (unsigned)((k0 >> shift) & 63ull), 1u, __ATOMIC_RELAXED, __HIP_MEMORY_SCOPE_WORKGROUP);
              if (v1 && (k1 >> (shift + 6)) == prefix) __hip_atomic_fetch_add(hq + (unsigned)((k1 >> shift) & 63ull), 1u, __ATOMIC_RELAXED, __HIP_MEMORY_SCOPE_WORKGROUP); }
          asm volatile("s_waitcnt lgkmcnt(0)" ::: "memory");
          const u32x4 v = *(const TLDS u32x4*)(hq + 4 * sub); const unsigned c4 = (v.x + v.y) + (v.z + v.w); unsigned incl = c4;
#pragma unroll
          for (int off = 1; off < 16; off <<= 1) { const unsigned t = __shfl_down(incl, off, 16); if (sub + off < 16) incl += t; }
          unsigned ab = incl - c4; const bool f = need > 0 && ab < (unsigned)need && ab + c4 >= (unsigned)need;
          int d = 0;
          if (f) { if (ab + v.w >= (unsigned)need) d = 3; else { ab += v.w; if (ab + v.z >= (unsigned)need) d = 2; else { ab += v.z; if (ab + v.y >= (unsigned)need) d = 1; else { ab += v.y; d = 0; } } } d += 4 * sub; }
          const unsigned long long bal = __ballot(f); const unsigned g = (unsigned)(bal >> (16 * ((lane >> 4) & 3))) & 0xffffu;
          if (g != 0u) { const int src = __builtin_ctz(g); d = __shfl(d, src, 16); const unsigned abn = __shfl(ab, src, 16); need -= (int)abn; prefix = (prefix << 6) | (unsigned long long)d; }
          else { need = 0; prefix = (prefix << 6); }
      }
      if (need > 0) {
#pragma unroll
          for (int e = 0; e < 8; ++e) { const unsigned long long ck = cr[e];
              if (ck != ~0ull && ck >= prefix) { img_set(img, (unsigned)(q & 31), 4095u - (unsigned)(ck & 4095ull)); } }
          for (int i = sub + 128; i < C; i += 16) { const unsigned long long ck = list[i];
              if (ck >= prefix) { img_set(img, (unsigned)(q & 31), 4095u - (unsigned)(ck & 4095ull)); } }
      }
      if (__any(needz > 0)) {
          unsigned wv[8]; unsigned pc = 0u; const TLDS unsigned* zq = zb + q * 128 + 8 * sub;
#pragma unroll
          for (int e = 0; e < 8; ++e) { wv[e] = needz > 0 ? zq[e] : 0u; pc += __popc(wv[e]); }
          unsigned incl = pc;
#pragma unroll
          for (int off = 1; off < 16; off <<= 1) { const unsigned t = __shfl_up(incl, off, 16); if (sub >= off) incl += t; }
          unsigned below = incl - pc;
#pragma unroll
          for (int e = 0; e < 8; ++e) { unsigned w_ = wv[e];
              while (w_ != 0u && below < (unsigned)needz) { const unsigned bpos = (unsigned)__builtin_ctz(w_); w_ &= w_ - 1u; ++below;
                  img_set(img, (unsigned)(q & 31), 256u * sub + 32u * e + bpos); }
              below += __popc(w_); }
      }
    }
    __syncthreads();
    const unsigned ovf = (unsigned)__ballot(lane < 32 && ccnt[lane & 31] > (unsigned)CAP);
    for (int ql = 0; ql < 32; ++ql) {
        if (!((ovf >> ql) & 1u)) continue;
        __syncthreads();
        TLDS float* fsc = (TLDS float*)(shm + L_FB); TLDS unsigned* fh = (TLDS unsigned*)(shm + L_FB + 16384); TLDS unsigned* ftot = fh + 256; TLDS unsigned* fmisc = ftot + 16; TLDS float* fq = (TLDS float*)(fmisc + 16);
        const int q = q0 + ql, n = q + 1; const bf16_t* qrow = (const bf16_t*)(ws + WS_QI) + (rowbase + q) * 256; const float* wq = (const float*)(ws + WS_WI) + (rowbase + q) * 4;
        if (tid < 256) fq[tid] = bf2f(qrow[tid]);
        const float w0 = wq[0], w1 = wq[1], w2 = wq[2], w3 = wq[3];
        if (tid == 0) { fmisc[0] = 0u; fmisc[1] = 256u; }
        __syncthreads();
        for (int k = tid; k < n; k += 512) { const uint4* kr = (const uint4*)(KIb + (size_t)k * 64); float r0 = 0.f, r1 = 0.f, r2 = 0.f, r3 = 0.f;
#pragma unroll 2
            for (int c = 0; c < 8; ++c) { const uint4 v = kr[c]; const unsigned u[4] = {v.x, v.y, v.z, v.w};
#pragma unroll
                for (int e = 0; e < 4; ++e) { const float a = __uint_as_float(u[e] << 16), bq = __uint_as_float(u[e] & 0xffff0000u); const int d = 8 * c + 2 * e;
                    r0 = fmaf(fq[d], a, r0); r0 = fmaf(fq[d + 1], bq, r0); r1 = fmaf(fq[64 + d], a, r1); r1 = fmaf(fq[64 + d + 1], bq, r1);
                    r2 = fmaf(fq[128 + d], a, r2); r2 = fmaf(fq[128 + d + 1], bq, r2); r3 = fmaf(fq[192 + d], a, r3); r3 = fmaf(fq[192 + d + 1], bq, r3); } }
            fsc[k] = fmaf(w3, fmaxf(r3, 0.f), fmaf(w2, fmaxf(r2, 0.f), fmaf(w1, fmaxf(r1, 0.f), fmaf(w0, fmaxf(r0, 0.f), 0.f)))); }
        __syncthreads();
        for (int pass = 3; pass >= 0; --pass) { const int shift = pass * 8; if (tid < 256) fh[tid] = 0u; __syncthreads();
            const unsigned pfx = fmisc[0], nd = fmisc[1], himask = (pass == 3) ? 0u : (0xffffffffu << (shift + 8));
            for (int k = tid; k < n; k += 512) { const unsigned key = mono(fsc[k]); if ((key & himask) == pfx) __hip_atomic_fetch_add(fh + ((key >> shift) & 255u), 1u, __ATOMIC_RELAXED, __HIP_MEMORY_SCOPE_WORKGROUP); }
            __syncthreads();
            unsigned c = 0u, incl = 0u;
            if (tid < 256) { c = fh[tid]; incl = c;
#pragma unroll
                for (int off = 1; off < 64; off <<= 1) { const unsigned t = __shfl_down(incl, off, 64); if (lane + off < 64) incl += t; }
                if (lane == 0) ftot[wid] = incl; }
            __syncthreads();
            if (tid < 256) { unsigned above = incl - c; for (int w2_ = wid + 1; w2_ < 4; ++w2_) above += ftot[w2_];
                if (above < nd && above + c >= nd) { fmisc[0] = pfx | ((unsigned)tid << shift); fmisc[1] = nd - above; } }
            __syncthreads(); }
        const unsigned T = fmisc[0], nd = fmisc[1];
        unsigned myties = 0u;
        for (int i = 0; i < 8; ++i) { const int k = tid * 8 + i; if (k < n && mono(fsc[k]) == T) ++myties; }
        unsigned inc2 = myties;
#pragma unroll
        for (int off = 1; off < 64; off <<= 1) { const unsigned t = __shfl_up(inc2, off, 64); if (lane >= off) inc2 += t; }
        if (lane == 63) ftot[8 + wid] = inc2;
        __syncthreads();
        unsigned before = inc2 - myties; for (int w2_ = 0; w2_ < wid; ++w2_) before += ftot[8 + w2_];
        for (int i = 0; i < 8; ++i) { const int k = tid * 8 + i; if (k >= n) break; const unsigned key = mono(fsc[k]); bool sel;
            if (key > T) sel = true; else if (key == T) { sel = before < nd; ++before; } else sel = false;
            const unsigned kk = (unsigned)k & 31u, r = (kk & 3u) | ((kk >> 3) << 2), hh = (kk >> 2) & 1u; TLDS unsigned* wp = img + ((unsigned)k >> 6) * 64u + (unsigned)ql + 32u * hh; const unsigned bm = 1u << (16u * (((unsigned)k >> 5) & 1u) + r);
            if (sel) __hip_atomic_fetch_or(wp, bm, __ATOMIC_RELAXED, __HIP_MEMORY_SCOPE_WORKGROUP); else __hip_atomic_fetch_and(wp, ~bm, __ATOMIC_RELAXED, __HIP_MEMORY_SCOPE_WORKGROUP); }
        __syncthreads();
    }
    { const int nchunk = ((qb32 >> 1) + 1) * 16; u32x4* dst = (u32x4*)((unsigned*)(ws + WS_MASK) + (((size_t)b * 128 + qb32) * 64) * 64); const TLDS u32x4* src = (const TLDS u32x4*)img;
      for (int i = tid; i < nchunk; i += 512) dst[i] = src[i]; }
    __syncthreads();
}
}

__device__ __forceinline__ void phase_topk(unsigned char* ws, tk::lds_ptr shm) {
    const int G = gridDim.x;
    for (int id = vcu_of_block(); id < 2048; id += G) {
        const int i = id >> 8, v = id & 255, b = v >> 4, s = v & 15; const int qb = (i & 1) ? 127 - (16 * (i >> 1) + s) : 16 * (i >> 1) + s;
        tk::topk_unit(b, qb, ws, shm);
    }
}
constexpr int MEGA_LDS = 147456;
#define LAS __attribute__((address_space(3)))
#define XB_TMO      128
#define XB_XCNT(j)  (256  + 64 * (j))
#define XB_XSUB(j)  (1280 + 64 * (j))
#define XB_XGEN(j)  (2304 + 64 * (j))
#define XB_TOP      3328
#define XB_TOPGEN   3392
#define XCD_BAR_WORDS 3456
#define XB_SPIN_CAP (1u << 18)

__device__ __forceinline__ unsigned xb_ld(unsigned* p)              { return __hip_atomic_load(p, __ATOMIC_RELAXED, __HIP_MEMORY_SCOPE_AGENT); }
__device__ __forceinline__ unsigned xb_add(unsigned* p, unsigned v) { return __hip_atomic_fetch_add(p, v, __ATOMIC_RELAXED, __HIP_MEMORY_SCOPE_AGENT); }
__device__ __forceinline__ unsigned xb_xcc_id() { return (unsigned)__builtin_amdgcn_s_getreg((3 << 11) | 20) & 0xFu; }
#define XB_SPIN(cond, bar) do { unsigned _sp = 0; while (cond) { __builtin_amdgcn_s_sleep(1); \
    if ((++_sp & 255u) == 0u) { if (xb_ld(&(bar)[XB_TMO])) break; if (_sp > XB_SPIN_CAP) { atomicAdd(&(bar)[XB_TMO], 1u); break; } } } } while (0)

struct XcdBarrier {
    unsigned* bar; unsigned x;
    volatile LAS unsigned* st;
};

__device__ __forceinline__ XcdBarrier xcd_barrier_post(unsigned* bar, volatile LAS unsigned* st) {
    XcdBarrier b; b.bar = bar; b.x = xb_xcc_id(); b.st = st;
    if (threadIdx.x == 0) (void)xb_add(&bar[XB_XCNT(b.x)], 1u);
    return b;
}
__device__ __forceinline__ void xcd_barrier_complete(unsigned* bar, unsigned x, unsigned& nloc, unsigned& nx) {
    const unsigned G = gridDim.x * gridDim.y * gridDim.z;
    unsigned sum, cnt, mine, sp = 0u;
    for (;;) {
        sum = 0u; cnt = 0u; mine = 0u;
#pragma unroll
        for (unsigned j = 0; j < 16; ++j) { const unsigned c = xb_ld(&bar[XB_XCNT(j)]); sum += c; cnt += (c > 0u) ? 1u : 0u; mine = (j == x) ? c : mine; }
        if (sum == G) break;
        __builtin_amdgcn_s_sleep(1);
        if ((++sp & 255u) == 0u) { if (xb_ld(&bar[XB_TMO])) break; if (sp > XB_SPIN_CAP) { atomicAdd(&bar[XB_TMO], 1u); break; } }
    }
    nloc = mine > 0u ? mine : 1u; nx = cnt > 0u ? cnt : 1u;
}

__device__ __forceinline__ void xcd_barrier(const XcdBarrier& b) {
    asm volatile("s_waitcnt vmcnt(0)" ::: "memory");
    __syncthreads();
    if (threadIdx.x == 0) {
        unsigned* bar = b.bar;
        __builtin_amdgcn_s_waitcnt(0);
        unsigned nloc = b.st[0], nx = b.st[1];
        if (nloc == 0u) { xcd_barrier_complete(bar, b.x, nloc, nx); b.st[0] = nloc; b.st[1] = nx; }
        const unsigned old = xb_add(&bar[XB_XSUB(b.x)], 1u);
        const unsigned gen = old / nloc;
        if (old + 1u == (gen + 1u) * nloc) {
            __builtin_amdgcn_fence(__ATOMIC_RELEASE, "agent");
            asm volatile("s_waitcnt vmcnt(0)" ::: "memory");
            const unsigned og = xb_add(&bar[XB_TOP], 1u);
            const unsigned tg = og / nx;
            if (og + 1u == (tg + 1u) * nx) xb_add(&bar[XB_TOPGEN], 1u);
            else XB_SPIN(xb_ld(&bar[XB_TOPGEN]) == tg, bar);
            __builtin_amdgcn_fence(__ATOMIC_ACQUIRE, "agent");
            xb_add(&bar[XB_XGEN(b.x)], 1u);
            asm volatile("s_waitcnt vmcnt(0)" ::: "memory");
        } else {
            XB_SPIN(xb_ld(&bar[XB_XGEN(b.x)]) == gen, bar);
            __builtin_amdgcn_fence(__ATOMIC_ACQUIRE, "agent");
            asm volatile("s_waitcnt vmcnt(0)" ::: "memory");
        }
    }
    __syncthreads();
}
struct MegaArgs { const float* x; const float* gain; const float* w_in; const float* w_out; const float* rel_bias; const float* gqa; const float* gka; const float* gqb; const float* gkb; float* out; unsigned char* ws; };
#define XCD_SYNC() xcd_barrier(xbar)
__global__ __launch_bounds__(512, 2) void mega_fwd(MegaArgs a) {
    extern __shared__ __attribute__((aligned(16))) unsigned char smem[];
    unsigned char* ws = a.ws;
    volatile LAS unsigned* MISC = (volatile LAS unsigned*)((LAS unsigned char*)smem + MEGA_LDS - 64);
    if (threadIdx.x < 16) MISC[threadIdx.x] = 0u;
    __syncthreads();
    XcdBarrier xbar = xcd_barrier_post((unsigned*)(ws + WS_CTL + 16384), MISC);
    { const size_t gid = (size_t)blockIdx.x * 512 + threadIdx.x, gsz = (size_t)gridDim.x * 512; const int wv = __builtin_amdgcn_readfirstlane(threadIdx.x >> 6);
      prep_w_body(gid, gsz, a.w_in, a.gain, a.w_out, a.rel_bias, (bf16_t*)(ws + WS_WTI), (bf16_t*)(ws + WS_WTO), (float*)(ws + WS_TAB), (int*)(ws + WS_TAB + 4096), a.gqa, a.gka, a.gqb, a.gkb, (float*)(ws + WS_GTAB), (float*)(ws + WS_ATAB));
      prep_weights((int)(gid >> 6), (int)(gsz >> 6), threadIdx.x & 63, a.w_in, a.gain, a.w_out, (bf16_t*)(ws + WS_WTI), (bf16_t*)(ws + WS_WTO), (__attribute__((address_space(3))) float*)(smem + wv * 16384));
      prep_x_body((int)(gid >> 6), (int)(gsz >> 6), threadIdx.x & 63, a.x, (bf16_t*)(ws + WS_XB), (float*)(ws + WS_RSTD)); }
    XCD_SYNC();
    { pg8::Gemm g{(const bf16_t*)(ws + WS_XB), (const bf16_t*)(ws + WS_WTI), M_TOK, NPHYS, 1024}; pg8::StaticOrder S; S.init(M_TOK, NPHYS, gridDim.x, blockIdx.x);
      PG8_LAS float* gl = (PG8_LAS float*)((PG8_LAS unsigned char*)smem + 131072);
      if (threadIdx.x < 256) gl[threadIdx.x] = threadIdx.x < 64 ? a.gqa[threadIdx.x] : threadIdx.x < 128 ? a.gka[threadIdx.x - 64] : threadIdx.x < 192 ? a.gqb[threadIdx.x - 128] : a.gkb[threadIdx.x - 192];
      __syncthreads();
      pg8::EpiIn E{ws, gl};
      pg8::gemm_phase<pg8::EpiIn, pg8::StaticOrder, true, true>((PG8_LAS unsigned char*)smem, g, S, E); }
    XCD_SYNC();
    phase_topk(ws, (tk::lds_ptr)smem);
    phase_attn_b12(ws, (att::lds_ptr)smem);
    XCD_SYNC();
    phase_attn_a(ws, (att::lds_ptr)smem);
    phase_attn_b3(ws, (att::lds_ptr)smem);
    XCD_SYNC();
    { pg8::Gemm g{(const bf16_t*)(ws + WS_MIX), (const bf16_t*)(ws + WS_WTO), M_TOK, 1024, 1024}; pg8::StaticOrder S; S.init(M_TOK, 1024, gridDim.x, blockIdx.x);
      pg8::EpiOut E{a.x, a.out};
      pg8::gemm_phase<pg8::EpiOut, pg8::StaticOrder, true, true>((PG8_LAS unsigned char*)smem, g, S, E); }
}

extern "C" void kernel_launch(void* const* d_in, const int* in_sizes, int n_in, void* d_out, int out_size, void* d_ws, size_t ws_size, hipStream_t stream) {
    static int grid_blocks = 0;
    if (grid_blocks == 0) {
        if (n_in != 9 || ws_size < WS_END) { fprintf(stderr, "kernel_launch: unexpected inputs (n_in %d, ws %zu)\n", n_in, ws_size); grid_blocks = -1; return; }
        int dev = 0, cus = 0, per_cu = 0;
        (void)hipGetDevice(&dev); (void)hipDeviceGetAttribute(&cus, hipDeviceAttributeMultiprocessorCount, dev);
        (void)hipFuncSetAttribute((const void*)mega_fwd, hipFuncAttributeMaxDynamicSharedMemorySize, MEGA_LDS);
        (void)hipOccupancyMaxActiveBlocksPerMultiprocessor(&per_cu, (const void*)mega_fwd, 512, MEGA_LDS);
        if (per_cu < 1) { fprintf(stderr, "kernel_launch: occupancy query says %d blocks per CU\n", per_cu); per_cu = 1; }
        grid_blocks = cus;
    }
    if (grid_blocks < 0) return;
    (void)hipMemsetAsync((unsigned char*)d_ws + WS_CTL, 0, 65536, stream);
    MegaArgs a{};
    a.x = (const float*)d_in[0]; a.gain = (const float*)d_in[1]; a.w_in = (const float*)d_in[2]; a.w_out = (const float*)d_in[3]; a.rel_bias = (const float*)d_in[4];
    a.gqa = (const float*)d_in[5]; a.gka = (const float*)d_in[6]; a.gqb = (const float*)d_in[7]; a.gkb = (const float*)d_in[8]; a.out = (float*)d_out; a.ws = (unsigned char*)d_ws;
    hipLaunchKernelGGL(mega_fwd, dim3(grid_blocks), dim3(512), MEGA_LDS, stream, a);
    const hipError_t e = hipPeekAtLastError();
    if (e != hipSuccess) fprintf(stderr, "launch failed: %s (grid %d)\n", hipGetErrorString(e), grid_blocks);
}
```

```cpp
#include <hip/hip_runtime.h>
#include <stdint.h>
#include <cstdio>

typedef unsigned short bf16_t;

constexpr int D_MODEL = 1024, BATCH = 16, SEQ = 4096, M_TOK = BATCH * SEQ;
constexpr int NPHYS = 4608;
constexpr float EPS = 1e-6f;
constexpr float LOG2E = 1.4426950408889634f;
constexpr float QSCALE = 0.125f * LOG2E;
constexpr float IDX_SCALE = 0.0625f;

constexpr size_t MiB = 1u << 20;
constexpr size_t WS_CTL = 0;
constexpr size_t WS_WTI = 2 * MiB;
constexpr size_t WS_WTO = 11 * MiB;
constexpr size_t WS_TAB = 13 * MiB;
constexpr size_t WS_GTAB = WS_TAB + 32768;
constexpr size_t WS_ATAB = WS_TAB + 65536;
constexpr size_t WS_RSTD = 14 * MiB;
constexpr size_t WS_WI = 15 * MiB;
constexpr size_t WS_XB = 16 * MiB;
constexpr size_t WS_MIX = 696 * MiB;
constexpr size_t HM_PITCH = (size_t)SEQ * 64 + 2048;
constexpr size_t WS_QA = 144 * MiB, WS_KA = 209 * MiB, WS_VA = 274 * MiB, WS_ZA = 339 * MiB;
constexpr size_t WS_QB = 404 * MiB, WS_KB = 469 * MiB, WS_VB = 534 * MiB, WS_ZB = 599 * MiB;
constexpr size_t WS_MASK = 664 * MiB;
constexpr size_t WS_QI = 696 * MiB;
constexpr size_t WS_KI = 728 * MiB;
constexpr size_t WS_BSC = 736 * MiB;
constexpr size_t WS_PB1 = 824 * MiB, WS_PB2 = 889 * MiB;
constexpr size_t WS_LB1 = 954 * MiB, WS_LB2 = 956 * MiB;
constexpr size_t WS_GM = 958 * MiB;
constexpr size_t WS_END = 992 * MiB;

__device__ __forceinline__ float bf2f(bf16_t v) { return __uint_as_float(((unsigned)v) << 16); }
__device__ __forceinline__ bf16_t f2bf(float f) { unsigned u = __float_as_uint(f); return (bf16_t)((u + 0x7fffu + ((u >> 16) & 1u)) >> 16); }

__host__ __device__ __forceinline__ int logical_of_phys(int p) { const int tile = p >> 8, pc = p & 255, bj = pc >> 7, wc = (pc >> 5) & 3, w = pc & 31; return tile * 256 + 64 * wc + 32 * bj + w; }
__host__ __device__ __forceinline__ int src_col_of_logical(int L) {
    if (L < 2048) return L;
    if (L < 4096) return 2372 + (L - 2048);
    if (L < 4352) return 2048 + (L - 4096);
    if (L < 4416) return 2304 + (L - 4352);
    if (L < 4420) return 2368 + (L - 4416);
    return -1;
}
__device__ __forceinline__ int crow(int r, int hi) { return (r & 3) + 8 * (r >> 2) + 4 * hi; }
__device__ __forceinline__ size_t mask_word_index(int b, int q, int k, int& bit) {
    const int qb = q >> 5, kb = k >> 5, kk = k & 31; const int r = (kk & 3) | ((kk >> 3) << 2), hi = (kk >> 2) & 1;
    bit = (q & 31) + 32 * hi;
    return (((size_t)b * 128 + qb) * 128 + kb) * 16 + r;
}

__device__ __forceinline__ void prep_w_body(size_t gid, size_t gsz, const float* __restrict__ w_in, const float* __restrict__ gain, const float* __restrict__ w_out, const float* __restrict__ rel_bias,
                         bf16_t* WTI, bf16_t* WTO, float* bias2, int* bucket, const float* gqa, const float* gka, const float* gqb, const float* gkb, float* gtab, float* atab) {
    for (size_t i = gid; i < 512; i += gsz) bias2[i] = rel_bias[i] * LOG2E;
    for (size_t i = gid; i < 256; i += gsz) { const int w = (int)(i >> 6), d = (int)(i & 63); gtab[i] = w == 0 ? gqa[d] : w == 1 ? gka[d] : w == 2 ? gqb[d] : gkb[d]; }
    for (size_t i = gid; i < 4096; i += gsz) { const int d = (int)i; int bk;
        if (d < 16) bk = d; else { const float df = (float)d; int lg = 16 + (int)(logf(df / 16.f) / logf(8.f) * 16.f); bk = lg < 31 ? lg : 31; }
        bucket[i] = bk; }
    for (size_t e = gid; e < (size_t)32 * 132; e += gsz) { const int kh = (int)(e / 132), j = (int)(e % 132), kind = kh >> 3, h = kh & 7, dil = kind <= 1 ? 1 : (kind == 2 ? 4 : 16), hoff = kind == 0 ? 0 : 8;
        const float far = rel_bias[31 * 16 + hoff + h] * LOG2E; float v = 0.f;
        if (j <= 128) { const int d = j * dil; int bk; if (d < 16) bk = d; else if (d >= 128) bk = 31; else { int lg = 16 + (int)(logf((float)d / 16.f) / logf(8.f) * 16.f); bk = lg < 31 ? lg : 31; }
            v = rel_bias[bk * 16 + hoff + h] * LOG2E - far; }
        else if (j == 129) { float mx = 0.f; for (int bk = 0; bk < 32; ++bk) mx = fmaxf(mx, rel_bias[bk * 16 + hoff + h] * LOG2E - far);
            const float* gq = kind == 0 ? gqa : gqb; const float* gk = kind == 0 ? gka : gkb; float qm = 0.f, km = 0.f;
            for (int d = 0; d < 64; ++d) { qm = fmaxf(qm, fabsf(gq[d])); km = fmaxf(km, fabsf(gk[d])); }
            v = -(64.f * QSCALE * qm * km * 1.02f + mx); }
        atab[e] = v; }
}

__device__ __forceinline__ void prep_x_body(int wave, int nw, int lane, const float* __restrict__ x, bf16_t* XB, float* RSTD) {
    for (int m4 = wave * 4; m4 < M_TOK; m4 += nw * 4) {
        float4 v[4][4]; float s[4];
#pragma unroll
        for (int rr = 0; rr < 4; ++rr) { const float4* xr = (const float4*)(x + (size_t)(m4 + rr) * 1024) + lane;
#pragma unroll
            for (int j = 0; j < 4; ++j) { typedef float f4e_t __attribute__((ext_vector_type(4))); const f4e_t t_ = __builtin_nontemporal_load((const f4e_t*)(xr + 64 * j)); v[rr][j] = make_float4(t_[0], t_[1], t_[2], t_[3]); } }
#pragma unroll
        for (int rr = 0; rr < 4; ++rr) { float a = 0.f;
#pragma unroll
            for (int j = 0; j < 4; ++j) a += v[rr][j].x * v[rr][j].x + v[rr][j].y * v[rr][j].y + v[rr][j].z * v[rr][j].z + v[rr][j].w * v[rr][j].w;
            s[rr] = a; }
#pragma unroll
        for (int o = 1; o < 64; o <<= 1) {
#pragma unroll
            for (int rr = 0; rr < 4; ++rr) s[rr] += __shfl_xor(s[rr], o); }
#pragma unroll
        for (int rr = 0; rr < 4; ++rr) { uint2* o2 = (uint2*)(XB + (size_t)(m4 + rr) * 1024) + lane; const float ms_ = s[rr] * (1.f / 1024.f) + EPS; const float rs = rsqrtf(ms_); if (lane == 0) RSTD[m4 + rr] = sqrtf(ms_);
#pragma unroll
            for (int j = 0; j < 4; ++j) { uint2 w; w.x = f2bf(v[rr][j].x * rs) | ((unsigned)f2bf(v[rr][j].y * rs) << 16); w.y = f2bf(v[rr][j].z * rs) | ((unsigned)f2bf(v[rr][j].w * rs) << 16); o2[64 * j] = w; } }
    }
}

__device__ __forceinline__ void transpose_item(const float* __restrict__ W, int ldw, int src_col0, int nvalid, const float* __restrict__ gain, bf16_t* WTrow0, int k0, __attribute__((address_space(3))) float* scr, int lane) {
    { const int n = lane & 31; const bool ok = src_col0 >= 0 && n < nvalid; const float* wp = W + (size_t)(k0 + (lane >> 5)) * ldw + (ok ? src_col0 + n : 0); float v[32];
#pragma unroll
      for (int i = 0; i < 32; ++i) v[i] = ok ? wp[(size_t)(2 * i) * ldw] : 0.f;
      float gg[32];
#pragma unroll
      for (int i = 0; i < 32; ++i) gg[i] = gain ? gain[k0 + 2 * i + (lane >> 5)] : 1.f;
#pragma unroll
      for (int i = 0; i < 32; ++i) scr[(2 * i + (lane >> 5)) * 33 + n] = v[i] * gg[i]; }
    asm volatile("s_waitcnt lgkmcnt(0)" ::: "memory");
    const int c = lane & 7;
#pragma unroll
    for (int j = 0; j < 4; ++j) { const int n = (lane >> 3) + 8 * j; const __attribute__((address_space(3))) float* s = scr + (8 * c) * 33 + n;
        uint4 o; o.x = f2bf(s[0 * 33]) | ((unsigned)f2bf(s[1 * 33]) << 16); o.y = f2bf(s[2 * 33]) | ((unsigned)f2bf(s[3 * 33]) << 16); o.z = f2bf(s[4 * 33]) | ((unsigned)f2bf(s[5 * 33]) << 16); o.w = f2bf(s[6 * 33]) | ((unsigned)f2bf(s[7 * 33]) << 16);
        *(uint4*)(WTrow0 + (size_t)n * 1024 + k0 + 8 * c) = o; }
    asm volatile("s_waitcnt lgkmcnt(0)" ::: "memory");
}
__device__ __forceinline__ void prep_weights(int gw, int ngw, int lane, const float* __restrict__ w_in, const float* __restrict__ gain, const float* __restrict__ w_out, bf16_t* WTI, bf16_t* WTO, __attribute__((address_space(3))) float* scr) {
    for (int it = gw; it < 2816; it += ngw) {
        if (it < 2304) { const int ng = it >> 4, kg = it & 15; const int L0 = logical_of_phys(ng * 32); const int src0 = src_col_of_logical(L0); const int nvalid = (L0 == 4416) ? 4 : 32;
            transpose_item(w_in, 4420, src0, nvalid, gain, WTI + (size_t)(ng * 32) * 1024, kg * 64, scr, lane); }
        else { const int r = it - 2304, ng = r >> 4, kg = r & 15; transpose_item(w_out, 1024, ng * 32, 32, nullptr, WTO + (size_t)(ng * 32) * 1024, kg * 64, scr, lane); }
    }
}
namespace pg8 {
#define PG8_LAS __attribute__((address_space(3)))
typedef unsigned short bf16_t;
typedef short bf16x8 __attribute__((ext_vector_type(8)));
typedef float f32x4 __attribute__((ext_vector_type(4)));
typedef unsigned u32x4 __attribute__((ext_vector_type(4)));
constexpr int BM = 256, BK = 64, HALF = 128, HTB = HALF * BK * 2  , STAGE_BYTES = 8 * HTB, NXCD = 8, WGM = 8;

__host__ __device__ __forceinline__ int lds_byte(int r, int c) { const int st = (r >> 4) * 2 + (c >> 5), rr = r & 15, cc = c & 31, ob = rr * 64 + cc * 2; return st * 1024 + (ob ^ (((ob >> 9) & 1) << 5)); }
__host__ __device__ __forceinline__ void stage_rc(int b, int& R, int& C) { const int st = b / 1024, sb = b % 1024, swz = sb ^ (((sb >> 9) & 1) << 5); R = (st >> 1) * 16 + swz / 64; C = (st & 1) * 32 + (swz % 64) / 2; }
__host__ __device__ __forceinline__ int perm32(int rho) { const int n = rho >> 4, i = rho & 15; return 8 * (i >> 2) + 4 * n + (i & 3); }

struct Unit { int pm, pn; };
struct Gemm { const bf16_t* A; const bf16_t* Bt; int M, N, K; };

struct StaticOrder {
    int nM, nN, nwg, G, c;
    __host__ __device__ void init(int M, int N, int G_, int c_) { nM = M / BM; nN = N / BM; nwg = nM * nN; G = G_; c = c_; }
    __host__ __device__ bool next(int i, Unit& u) const {
        const long L = (long)i * G + c; if (L >= nwg) return false;
        int wgid = (int)L; { const int q = nwg / NXCD, r = nwg % NXCD, xcd = wgid % NXCD, off = wgid / NXCD; wgid = (xcd < r ? xcd * (q + 1) : r * (q + 1) + (xcd - r) * q) + off; }
        const int nig = WGM * nN, gid = wgid / nig, fm = gid * WGM, gsz = (nM - fm) < WGM ? (nM - fm) : WGM;
        u.pm = fm + ((wgid % nig) % gsz); u.pn = (wgid % nig) / gsz; return true;
    }
    __device__ __forceinline__ void a_ready(const Unit&) const {}
    __device__ __forceinline__ void done(const Unit&) const {}
};
__device__ __forceinline__ unsigned cvt_pk_bf16(float lo, float hi) { unsigned r; asm volatile("v_cvt_pk_bf16_f32 %0, %1, %2" : "=v"(r) : "v"(lo), "v"(hi)); return r; }
typedef float f32x2 __attribute__((ext_vector_type(2)));
template <class Epi, class Sched, bool ALIGN_EPI = false, bool SP2 = false>
__device__ __forceinline__ void gemm_phase(PG8_LAS unsigned char* lds, const Gemm g, const Sched& S, const Epi& E) {
    int tid_ = threadIdx.x; asm volatile("" : "+v"(tid_));
    const int tid = tid_, wid = __builtin_amdgcn_readfirstlane(tid >> 6), lane = tid & 63, wr = wid >> 2, wc = wid & 3, fr = lane & 15, fq = lane >> 4;
    const int K = g.K, nt = K / BK;
    unsigned voffA[2], voffB[2];
#pragma unroll
    for (int i = 0; i < 2; ++i) { int R, C; stage_rc(tid * 16 + i * 8192, R, C); const int Rb = Epi::PERM ? ((R & ~31) + perm32(R & 31)) : R;
        voffA[i] = (unsigned)(R * K + C) * 2u; voffB[i] = (unsigned)(Rb * K + C) * 2u; }
    const size_t kstep = (size_t)(BK * 2);
    const size_t hstep = (size_t)HALF * K * 2;
    const size_t tstep = 2 * hstep;
    const unsigned ldsw = (unsigned)wid * 1024u;
    const int aoff = lds_byte(wr * 64 + fr, fq * 8), boff = lds_byte(wc * 32 + fr, fq * 8);
#define PG8_SA(b, h) (((b) * 2 + (h)) * HTB)
#define PG8_SB(b, h) ((4 + (b) * 2 + (h)) * HTB)
#define PG8_STAGE(bufoff, gbase, voff) do { _Pragma("unroll") for (int _i = 0; _i < 2; ++_i) \
        __builtin_amdgcn_global_load_lds((const unsigned*)((const char*)(gbase) + (voff)[_i]), (PG8_LAS unsigned*)(lds + (bufoff) + ldsw + _i * 8192), 16, 0, 0); } while (0)
#define PG8_LDA(dst, b, h) do { _Pragma("unroll") for (int m = 0; m < 4; ++m) _Pragma("unroll") for (int k = 0; k < 2; ++k) dst[m][k] = *(const PG8_LAS bf16x8*)(lds + PG8_SA(b, h) + aoff + m * 2048 + k * 1024); } while (0)
#define PG8_LDB(dst, b, h) do { _Pragma("unroll") for (int n = 0; n < 2; ++n) _Pragma("unroll") for (int k = 0; k < 2; ++k) dst[n][k] = *(const PG8_LAS bf16x8*)(lds + PG8_SB(b, h) + boff + n * 2048 + k * 1024); } while (0)
#define PG8_MMA(ai, bj, At, Bt) do { __builtin_amdgcn_s_setprio(1); _Pragma("unroll") for (int m = 0; m < 4; ++m) _Pragma("unroll") for (int n = 0; n < 2; ++n) _Pragma("unroll") for (int k = 0; k < 2; ++k) \
        acc[ai][bj][m][n] = __builtin_amdgcn_mfma_f32_16x16x32_bf16(Bt[n][k], At[m][k], acc[ai][bj][m][n], 0, 0, 0); __builtin_amdgcn_s_setprio(0); } while (0)
#define PG8_WAIT_V(n) asm volatile("s_waitcnt vmcnt(" #n ")" ::: "memory")
#define PG8_WAIT_L(n) asm volatile("s_waitcnt lgkmcnt(" #n ")" ::: "memory")
#define PG8_BAR __builtin_amdgcn_s_barrier()
#define PG8_SCHED __builtin_amdgcn_sched_barrier(0)
    Unit cur, nxt; int ui = 0;
    if (!S.next(0, cur)) return;
    f32x4 acc[2][2][4][2];
#pragma unroll
    for (int a = 0; a < 2; ++a)
#pragma unroll
        for (int b = 0; b < 2; ++b)
#pragma unroll
            for (int m = 0; m < 4; ++m)
#pragma unroll
                for (int n = 0; n < 2; ++n) acc[a][b][m][n] = (f32x4){0.f, 0.f, 0.f, 0.f};
    bf16x8 At[4][2], B0[2][2], B1[2][2];
    const char* cA = (const char*)g.A + (size_t)cur.pm * tstep; const char* cB = (const char*)g.Bt + (size_t)cur.pn * tstep;
    S.a_ready(cur);
    if constexpr (SP2) {
        PG8_STAGE(PG8_SB(0, 0), cB, voffB); PG8_STAGE(PG8_SB(0, 1), cB + hstep, voffB); PG8_STAGE(PG8_SA(0, 0), cA, voffA); PG8_STAGE(PG8_SA(0, 1), cA + hstep, voffA);
        if (wr == 1) PG8_BAR;
        PG8_WAIT_V(2); PG8_BAR;
        PG8_STAGE(PG8_SB(1, 0), cB + kstep, voffB); PG8_STAGE(PG8_SA(1, 0), cA + kstep, voffA); PG8_STAGE(PG8_SB(1, 1), cB + hstep + kstep, voffB);
        PG8_WAIT_V(6); PG8_BAR;
    } else {
        PG8_STAGE(PG8_SB(0, 0), cB, voffB); PG8_STAGE(PG8_SA(0, 0), cA, voffA); PG8_STAGE(PG8_SB(0, 1), cB + hstep, voffB); PG8_STAGE(PG8_SA(0, 1), cA + hstep, voffA);
        if (wr == 1) PG8_BAR;
        PG8_WAIT_V(4); PG8_BAR;
        PG8_STAGE(PG8_SB(1, 0), cB + kstep, voffB); PG8_STAGE(PG8_SA(1, 0), cA + kstep, voffA); PG8_STAGE(PG8_SB(1, 1), cB + hstep + kstep, voffB);
        PG8_WAIT_V(6); PG8_BAR;
    }
    for (;;) {
        const bool has_next = S.next(ui + 1, nxt);
        const char* nA = has_next ? (const char*)g.A + (size_t)nxt.pm * tstep : cA; const char* nB = has_next ? (const char*)g.Bt + (size_t)nxt.pn * tstep : cB;
        for (int t = 0; t < nt; t += 2) {
            const bool last = (t == nt - 2);
            const char* a1 = cA + (size_t)(t + 1) * kstep;
            const char* a2 = last ? nA : cA + (size_t)(t + 2) * kstep; const char* b2 = last ? nB : cB + (size_t)(t + 2) * kstep;
            const char* a3 = a2 + kstep; const char* b3 = b2 + kstep;
            if (last && has_next) S.a_ready(nxt);
            if constexpr (SP2) {
            PG8_LDB(B0, 0, 0); PG8_LDB(B1, 0, 1); PG8_SCHED; PG8_LDA(At, 0, 0); PG8_STAGE(PG8_SA(1, 1), a1 + hstep, voffA);
            PG8_WAIT_V(8); PG8_WAIT_L(0); PG8_BAR; PG8_MMA(0, 0, At, B0); PG8_MMA(0, 1, At, B1); PG8_BAR; PG8_SCHED;
            PG8_LDA(At, 0, 1); PG8_STAGE(PG8_SB(0, 0), b2, voffB); PG8_STAGE(PG8_SB(0, 1), b2 + hstep, voffB); PG8_STAGE(PG8_SA(0, 0), a2, voffA);
            PG8_WAIT_V(8); PG8_WAIT_L(0); PG8_BAR; PG8_MMA(1, 0, At, B0); PG8_MMA(1, 1, At, B1); PG8_BAR; PG8_SCHED;
            PG8_LDB(B0, 1, 0); PG8_LDB(B1, 1, 1); PG8_SCHED; PG8_LDA(At, 1, 0); PG8_STAGE(PG8_SA(0, 1), a2 + hstep, voffA);
            PG8_WAIT_V(8); PG8_WAIT_L(0); PG8_BAR; PG8_MMA(0, 0, At, B0); PG8_MMA(0, 1, At, B1); PG8_BAR; PG8_SCHED;
            PG8_LDA(At, 1, 1); PG8_STAGE(PG8_SB(1, 0), b3, voffB); PG8_STAGE(PG8_SB(1, 1), b3 + hstep, voffB); PG8_STAGE(PG8_SA(1, 0), a3, voffA);
            PG8_WAIT_V(8); PG8_WAIT_L(0); PG8_BAR; PG8_MMA(1, 0, At, B0); PG8_MMA(1, 1, At, B1); PG8_BAR; PG8_SCHED;
            } else {
            PG8_LDB(B0, 0, 0); PG8_SCHED; PG8_LDA(At, 0, 0); PG8_STAGE(PG8_SA(1, 1), a1 + hstep, voffA);
            PG8_WAIT_L(8); PG8_BAR; PG8_WAIT_L(0); PG8_MMA(0, 0, At, B0); PG8_BAR; PG8_SCHED;
            PG8_LDB(B1, 0, 1); PG8_STAGE(PG8_SB(0, 0), b2, voffB);
            PG8_BAR; PG8_WAIT_L(0); PG8_MMA(0, 1, At, B1); PG8_BAR;
            PG8_LDA(At, 0, 1); PG8_STAGE(PG8_SA(0, 0), a2, voffA);
            PG8_BAR; PG8_WAIT_L(0); PG8_MMA(1, 0, At, B0); PG8_BAR; PG8_SCHED;
            PG8_STAGE(PG8_SB(0, 1), b2 + hstep, voffB);
            PG8_WAIT_V(6); PG8_BAR; PG8_MMA(1, 1, At, B1); PG8_BAR;
            PG8_LDB(B0, 1, 0); PG8_SCHED; PG8_LDA(At, 1, 0); PG8_STAGE(PG8_SA(0, 1), a2 + hstep, voffA);
            PG8_WAIT_L(8); PG8_BAR; PG8_WAIT_L(0); PG8_MMA(0, 0, At, B0); PG8_BAR; PG8_SCHED;
            PG8_LDB(B1, 1, 1); PG8_STAGE(PG8_SB(1, 0), b3, voffB);
            PG8_BAR; PG8_WAIT_L(0); PG8_MMA(0, 1, At, B1); PG8_BAR;
            PG8_LDA(At, 1, 1); PG8_STAGE(PG8_SA(1, 0), a3, voffA);
            PG8_BAR; PG8_WAIT_L(0); PG8_MMA(1, 0, At, B0); PG8_BAR; PG8_SCHED;
            PG8_STAGE(PG8_SB(1, 1), b3 + hstep, voffB);
            PG8_WAIT_V(6); PG8_BAR; PG8_MMA(1, 1, At, B1); PG8_BAR;
            }
        }
        if constexpr (ALIGN_EPI) { if (wr == 0) PG8_BAR; }
        if constexpr (!Epi::AFTER_DRAIN) { E(acc, cur, wr, wc, fr, fq); S.done(cur); }
        if (!has_next) break;
#pragma unroll
        for (int a = 0; a < 2; ++a)
#pragma unroll
            for (int b = 0; b < 2; ++b)
#pragma unroll
                for (int m = 0; m < 4; ++m)
#pragma unroll
                    for (int n = 0; n < 2; ++n) acc[a][b][m][n] = (f32x4){0.f, 0.f, 0.f, 0.f};
        cur = nxt; cA = nA; cB = nB; ++ui;
        if constexpr (ALIGN_EPI) { if (wr == 1) PG8_BAR; }
    }
    PG8_WAIT_V(0);
    if constexpr (!ALIGN_EPI) { if (wr == 0) PG8_BAR; }
    PG8_BAR;
    if constexpr (Epi::AFTER_DRAIN) { E.fused(acc, cur, wr, wc, fr, fq, lds, wid, lane); S.done(cur); }
#undef PG8_SA
#undef PG8_SB
#undef PG8_STAGE
#undef PG8_LDA
#undef PG8_LDB
#undef PG8_MMA
#undef PG8_WAIT_V
#undef PG8_WAIT_L
#undef PG8_BAR
#undef PG8_SCHED
}
}
namespace pg8 {
struct EpiIn {
    static constexpr bool PERM = true, AFTER_DRAIN = false;
    unsigned char* ws; const PG8_LAS float* gtab;
    __device__ __forceinline__ void operator()(const f32x4 (&acc)[2][2][4][2], const Unit& u, int wr, int wc, int fr, int fq) const {
        const int pn = u.pn; const int row0 = u.pm * BM + wr * 64 + fr;
#define RS(ai, m) 1.f
        if (pn < 16) {
            const int grp = pn >> 1;
            bf16_t* base = (bf16_t*)(ws + WS_QA + (size_t)grp * 65 * MiB) + (size_t)((pn & 1) * 4 + wc) * HM_PITCH + 8 * fq;
#define HMROW(r) ((size_t)((r) >> 12) * 8 * HM_PITCH + (size_t)((r) & 4095) * 64)
            if ((grp & 3) < 2) {
                const PG8_LAS float* g = gtab + ((grp >> 2) * 2 + (grp & 1)) * 64; const float sc = (grp & 3) == 0 ? QSCALE : 1.f;
                f32x4 gv[2][2];
#pragma unroll
                for (int bj = 0; bj < 2; ++bj)
#pragma unroll
                    for (int n = 0; n < 2; ++n) gv[bj][n] = *(const PG8_LAS f32x4*)(g + 32 * bj + 8 * fq + 4 * n);
#pragma unroll
                for (int ai = 0; ai < 2; ++ai)
#pragma unroll
                    for (int m = 0; m < 4; ++m) {
                        const float r_ = RS(ai, m); f32x4 y[2][2]; float ss = 0.f;
#pragma unroll
                        for (int bj = 0; bj < 2; ++bj)
#pragma unroll
                            for (int n = 0; n < 2; ++n) { y[bj][n] = acc[ai][bj][m][n] * r_; ss += (y[bj][n][0] * y[bj][n][0] + y[bj][n][1] * y[bj][n][1]) + (y[bj][n][2] * y[bj][n][2] + y[bj][n][3] * y[bj][n][3]); }
                        ss += __shfl_xor(ss, 16); ss += __shfl_xor(ss, 32);
                        const float rn = rsqrtf(ss * (1.f / 64.f) + EPS) * sc;
                        bf16_t* rowp = base + HMROW(row0 + ai * HALF + m * 16);
#pragma unroll
                        for (int bj = 0; bj < 2; ++bj) { const f32x4 v0 = y[bj][0] * rn * gv[bj][0], v1 = y[bj][1] * rn * gv[bj][1];
                            u32x4 w; w.x = cvt_pk_bf16(v0[0], v0[1]); w.y = cvt_pk_bf16(v0[2], v0[3]); w.z = cvt_pk_bf16(v1[0], v1[1]); w.w = cvt_pk_bf16(v1[2], v1[3]);
                            *(u32x4*)(rowp + 32 * bj) = w; }
                        asm volatile("" ::: "memory");
                    }
            } else {
#pragma unroll
                for (int ai = 0; ai < 2; ++ai)
#pragma unroll
                    for (int m = 0; m < 4; ++m) { const float r_ = RS(ai, m); bf16_t* rowp = base + HMROW(row0 + ai * HALF + m * 16);
#pragma unroll
                        for (int bj = 0; bj < 2; ++bj) { const f32x4 v0 = acc[ai][bj][m][0] * r_, v1 = acc[ai][bj][m][1] * r_;
                            u32x4 w; w.x = cvt_pk_bf16(v0[0], v0[1]); w.y = cvt_pk_bf16(v0[2], v0[3]); w.z = cvt_pk_bf16(v1[0], v1[1]); w.w = cvt_pk_bf16(v1[2], v1[3]);
                            *(u32x4*)(rowp + 32 * bj) = w; } }
            }
#undef HMROW
        } else if (pn == 16) {
            bf16_t* base = (bf16_t*)(ws + WS_QI) + wc * 64 + 8 * fq;
#pragma unroll
            for (int ai = 0; ai < 2; ++ai)
#pragma unroll
                for (int m = 0; m < 4; ++m) { const float r_ = RS(ai, m); bf16_t* rowp = base + (size_t)(row0 + ai * HALF + m * 16) * 256;
#pragma unroll
                    for (int bj = 0; bj < 2; ++bj) { const f32x4 v0 = acc[ai][bj][m][0] * r_, v1 = acc[ai][bj][m][1] * r_;
                        u32x4 w; w.x = cvt_pk_bf16(v0[0], v0[1]); w.y = cvt_pk_bf16(v0[2], v0[3]); w.z = cvt_pk_bf16(v1[0], v1[1]); w.w = cvt_pk_bf16(v1[2], v1[3]);
                        *(u32x4*)(rowp + 32 * bj) = w; } }
        } else {
            if (wc == 0) {
                bf16_t* base = (bf16_t*)(ws + WS_KI) + 8 * fq;
#pragma unroll
                for (int ai = 0; ai < 2; ++ai)
#pragma unroll
                    for (int m = 0; m < 4; ++m) { const float r_ = RS(ai, m); bf16_t* rowp = base + (size_t)(row0 + ai * HALF + m * 16) * 64;
#pragma unroll
                        for (int bj = 0; bj < 2; ++bj) { const f32x4 v0 = acc[ai][bj][m][0] * r_, v1 = acc[ai][bj][m][1] * r_;
                            u32x4 w; w.x = cvt_pk_bf16(v0[0], v0[1]); w.y = cvt_pk_bf16(v0[2], v0[3]); w.z = cvt_pk_bf16(v1[0], v1[1]); w.w = cvt_pk_bf16(v1[2], v1[3]);
                            *(u32x4*)(rowp + 32 * bj) = w; } }
            } else if (wc == 1) {
                if (fq == 0) {
                    float* wi = (float*)(ws + WS_WI);
#pragma unroll
                    for (int ai = 0; ai < 2; ++ai)
#pragma unroll
                        for (int m = 0; m < 4; ++m) *(f32x4*)(wi + (size_t)(row0 + ai * HALF + m * 16) * 4) = acc[ai][0][m][0] * (RS(ai, m) * IDX_SCALE);
                }
            }
        }
    }
};
#undef RS
struct EpiOut {
    static constexpr bool PERM = false, AFTER_DRAIN = false;
    const bf16_t* xb; const float* rsc; float* out;
    __device__ __forceinline__ void operator()(const f32x4 (&acc)[2][2][4][2], const Unit& u, int wr, int wc, int fr, int fq) const {
        const int row0 = u.pm * BM + wr * 64 + fr, col0 = u.pn * BM + wc * 32 + 4 * fq;
        uint2 xa[2][2][2], xc[2][2][2]; float sa[2], sc[2];
#define EO_LOAD(X, S, b) do { const int ai_ = (b) >> 1, mp_ = (b) & 1; _Pragma("unroll") for (int mm = 0; mm < 2; ++mm) { const size_t r_ = (size_t)(row0 + ai_ * HALF + (2 * mp_ + mm) * 16); const size_t off = r_ * 1024 + col0; S[mm] = rsc[r_]; \
            _Pragma("unroll") for (int bj = 0; bj < 2; ++bj) _Pragma("unroll") for (int n = 0; n < 2; ++n) X[mm][bj][n] = *(const uint2*)(xb + off + bj * HALF + n * 16); } } while (0)
#define EO_STORE(X, S, b) do { const int ai_ = (b) >> 1, mp_ = (b) & 1; _Pragma("unroll") for (int mm = 0; mm < 2; ++mm) { const size_t off = (size_t)(row0 + ai_ * HALF + (2 * mp_ + mm) * 16) * 1024 + col0; const float s_ = S[mm]; \
            _Pragma("unroll") for (int bj = 0; bj < 2; ++bj) _Pragma("unroll") for (int n = 0; n < 2; ++n) { const uint2 p_ = X[mm][bj][n]; const f32x4 a_ = acc[ai_][bj][2 * mp_ + mm][n]; f32x4 o_; \
                o_[0] = fmaf(__uint_as_float(p_.x << 16), s_, a_[0]); o_[1] = fmaf(__uint_as_float(p_.x & 0xffff0000u), s_, a_[1]); o_[2] = fmaf(__uint_as_float(p_.y << 16), s_, a_[2]); o_[3] = fmaf(__uint_as_float(p_.y & 0xffff0000u), s_, a_[3]); \
                *(f32x4*)(out + off + bj * HALF + n * 16) = o_; } } } while (0)
        EO_LOAD(xa, sa, 0); __builtin_amdgcn_sched_barrier(0);
        EO_LOAD(xc, sc, 1); __builtin_amdgcn_sched_barrier(0);
        EO_STORE(xa, sa, 0); __builtin_amdgcn_sched_barrier(0);
        EO_LOAD(xa, sa, 2); __builtin_amdgcn_sched_barrier(0);
        EO_STORE(xc, sc, 1); __builtin_amdgcn_sched_barrier(0);
        EO_LOAD(xc, sc, 3); __builtin_amdgcn_sched_barrier(0);
        EO_STORE(xa, sa, 2); __builtin_amdgcn_sched_barrier(0);
        EO_STORE(xc, sc, 3); __builtin_amdgcn_sched_barrier(0);
#undef EO_LOAD
#undef EO_STORE
    }
};
}

constexpr int GEMM_LDS = 131072;
namespace att {
using bf16x8 = __attribute__((ext_vector_type(8))) short;
using s16x4 = __attribute__((ext_vector_type(4))) short;
using f32x16 = __attribute__((ext_vector_type(16))) float;
using u32x4 = __attribute__((ext_vector_type(4))) unsigned;
using f32x4 = __attribute__((ext_vector_type(4))) float;
#define ALDS __attribute__((address_space(3)))
typedef ALDS const char* lds_cptr;
typedef ALDS unsigned char* lds_ptr;

constexpr int SLOTB = 8192;
constexpr int LDS_K = 0, LDS_V = 3 * SLOTB, LDS_TAB = 6 * SLOTB, LDS_WS = LDS_TAB + 1024, LDS_OST = LDS_WS + 2048, LDS_BYTES = LDS_OST + 8 * 8192;
constexpr int TABN = 132;

struct Unit { int b, h, kind, dil, rho, u0; };

__device__ __forceinline__ void glds16(const void* gsrc, unsigned lds_dst) { unsigned keep;
    asm volatile("s_mov_b32 %0, m0\n\ts_mov_b32 m0, %2\n\ts_nop 0\n\tglobal_load_lds_dwordx4 %1, off\n\ts_mov_b32 m0, %0" : "=&s"(keep) : "v"(gsrc), "s"(lds_dst) : "memory"); }
__device__ __forceinline__ void glds16s(const void* sbase, unsigned voff, unsigned lds_dst) { unsigned keep;
    asm volatile("s_mov_b32 %0, m0\n\ts_mov_b32 m0, %3\n\ts_nop 0\n\tglobal_load_lds_dwordx4 %1, %2\n\ts_mov_b32 m0, %0" : "=&s"(keep) : "v"(voff), "s"(sbase), "s"(lds_dst) : "memory"); }
__device__ __forceinline__ float cndm(float p, unsigned long long m) { float o; asm("v_cndmask_b32_e64 %0, 0, %1, %2" : "=v"(o) : "v"(p), "s"(m)); return o; }
typedef float f32x2_t __attribute__((ext_vector_type(2))); typedef __bf16 bf16x2_t __attribute__((ext_vector_type(2)));
__device__ __forceinline__ unsigned cvtpk(float lo, float hi) { f32x2_t v = {lo, hi}; bf16x2_t b = __builtin_convertvector(v, bf16x2_t); return __builtin_bit_cast(unsigned, b); }
typedef short v4i16_t __attribute__((ext_vector_type(4)));
__device__ __forceinline__ s16x4 vtr(lds_cptr p) { return __builtin_bit_cast(s16x4, __builtin_amdgcn_ds_read_tr16_b64_v4i16((ALDS v4i16_t*)p)); }
__device__ __forceinline__ float silu(float z) { return z / (1.f + __expf(-z)); }

constexpr int LDS_OSB = LDS_WS + 2048;
constexpr int LDS_CT = LDS_OSB + 8 * 4096;
constexpr int LDS_B_BYTES = LDS_CT + 6 * 8192;
__device__ __forceinline__ void build_ctab(int kind, int h, unsigned char* ws, ALDS unsigned char* shm, int tid, int ct_off = LDS_CT) {
    const float* T = (const float*)(ws + WS_ATAB) + (kind * 8 + h) * TABN; const float negb = T[129];
    ALDS float* ct = (ALDS float*)(shm + ct_off);
    for (int e = tid; e < 6 * 2048; e += 512) {
        const int c = e & 3, lane = (e >> 2) & 63, g = (e >> 8) & 7, i = e >> 11; const int reg = 4 * g + c, r = reg & 15, r32 = lane & 31, hi = lane >> 5;
        const int j = 32 * i + r32 - 4 * hi - ((r & 3) + 8 * (r >> 2)) - (reg >= 16 ? 32 : 0);
        ct[e] = (j >= 0 && j <= 128) ? T[j] + negb : -1e30f; }
}
__device__ __forceinline__ void unit_start(const Unit U, const bool rebuild, unsigned char* ws, ALDS unsigned char* shm, bf16x8 (&qr)[4], int tid, int lane, int r32, int hi, int wid) {
    const size_t rowbase = (size_t)U.b * SEQ; const int dil = U.dil, rho = U.rho, h = U.h; const unsigned lds0 = (unsigned)(uintptr_t)shm;
    const size_t hmb = (size_t)(U.b * 8 + h) * HM_PITCH; const bf16_t* Qg = (const bf16_t*)(ws + WS_QB) + hmb; const bf16_t* Kg = (const bf16_t*)(ws + WS_KB) + hmb; const bf16_t* Vg = (const bf16_t*)(ws + WS_VB) + hmb;
    const int xw = U.u0 + 32 * wid, kt0 = U.u0 >= 128 ? U.u0 - 128 : 0;
    const bf16_t* ksrc = Kg + ((size_t)(kt0 + 8 * wid + (lane >> 3)) * dil + rho) * 64 + (((lane & 7) ^ ((lane >> 3) & 7)) * 8);
    const bf16_t* vsrc = Vg + ((size_t)(kt0 + 16 * (wid & 3) + (lane >> 2)) * dil + rho) * 64 + (wid >> 2) * 32 + (lane & 3) * 8;
    const size_t tstep = (size_t)64 * dil * 64; const unsigned kdst = lds0 + LDS_K + wid * 1024, vdst = lds0 + LDS_V + wid * 1024;
    glds16(ksrc, (unsigned)__builtin_amdgcn_readfirstlane(kdst)); glds16(vsrc, (unsigned)__builtin_amdgcn_readfirstlane(vdst));
    glds16(ksrc + tstep, (unsigned)__builtin_amdgcn_readfirstlane(kdst + SLOTB)); glds16(vsrc + tstep, (unsigned)__builtin_amdgcn_readfirstlane(vdst + SLOTB));
    const bf16_t* qp = Qg + ((size_t)(xw + r32) * dil + rho) * 64 + hi * 8;
#pragma unroll
    for (int d0 = 0; d0 < 4; ++d0) qr[d0] = *(const bf16x8*)(qp + d0 * 16);
    if (rebuild) build_ctab(U.kind, h, ws, shm, tid);
}
template <int MODE> __device__ __forceinline__ void attn_unit(const Unit U, const bool first, const Unit N, const bool has_next, unsigned char* ws, ALDS unsigned char* shm, bf16x8 (&qr)[4]) {
    int tid_ = threadIdx.x; asm volatile("" : "+v"(tid_));
    const int tid = tid_, lane = tid & 63, r32 = lane & 31, hi = lane >> 5; const int wid = __builtin_amdgcn_readfirstlane(tid >> 6);
    const int dil = U.dil, rho = U.rho, h = U.h; const size_t rowbase = (size_t)U.b * SEQ;
    const size_t hmb = (size_t)(U.b * 8 + h) * HM_PITCH;
    const bf16_t* Kg = (const bf16_t*)(ws + WS_KB) + hmb;
    const bf16_t* Vg = (const bf16_t*)(ws + WS_VB) + hmb;
    const unsigned lds0 = (unsigned)(uintptr_t)shm;
    const int xw = U.u0 + 32 * wid;
    const int kt0 = U.u0 >= 128 ? U.u0 - 128 : 0;
    const int NT = (U.u0 + 256 - kt0) >> 6;
    if (first) unit_start(U, true, ws, shm, qr, tid, lane, r32, hi, wid);
    const bf16_t* ksrc = Kg + ((size_t)(kt0 + 8 * wid + (lane >> 3)) * dil + rho) * 64 + (((lane & 7) ^ ((lane >> 3) & 7)) * 8);
    const bf16_t* vsrc = Vg + ((size_t)(kt0 + 16 * (wid & 3) + (lane >> 2)) * dil + rho) * 64 + (wid >> 2) * 32 + (lane & 3) * 8;
    const size_t tstep = (size_t)64 * dil * 64;
    const unsigned kdst = lds0 + LDS_K + wid * 1024, vdst = lds0 + LDS_V + wid * 1024;
#define ATT_DMA(t, slot) do { glds16(ksrc + (size_t)(t) * tstep, (unsigned)__builtin_amdgcn_readfirstlane(kdst + (slot) * SLOTB)); glds16(vsrc + (size_t)(t) * tstep, (unsigned)__builtin_amdgcn_readfirstlane(vdst + (slot) * SLOTB)); } while (0)
    const lds_cptr kp0 = (lds_cptr)shm + LDS_K + r32 * 128; int kofs[4];
#pragma unroll
    for (int d0 = 0; d0 < 4; ++d0) kofs[d0] = ((2 * d0 + hi) ^ (r32 & 7)) * 16;
    const lds_cptr vp0 = (lds_cptr)shm + LDS_V + ((lane >> 4) & 1) * 32 + (lane & 3) * 8 + (4 * hi + ((lane & 15) >> 2)) * 64;
    const lds_cptr ctp = (lds_cptr)shm + LDS_CT + lane * 16;
    const bf16x8 ones8 = (bf16x8){0x3F80, 0x3F80, 0x3F80, 0x3F80, 0x3F80, 0x3F80, 0x3F80, 0x3F80};
    f32x16 o[3]; o[0] = f32x16{}; o[1] = f32x16{}; o[2] = f32x16{};
    u32x4 eq1[2][2], eq2[2][2], ezz[2][2]; float el[2][2];
    if (MODE == 2) {
#pragma unroll
        for (int d0 = 0; d0 < 2; ++d0)
#pragma unroll
            for (int i = 0; i < 2; ++i) { const int row = i * 16 + (lane >> 2), ch = lane & 3; const size_t tok = rowbase + (size_t)(xw + row) * dil + rho; const int col = h * 64 + d0 * 32 + ch * 8;
                const size_t hm = hmb + ((size_t)(xw + row) * dil + rho) * 64 + d0 * 32 + ch * 8; eq1[d0][i] = *(const u32x4*)((const bf16_t*)(ws + WS_PB1) + hm); eq2[d0][i] = *(const u32x4*)((const bf16_t*)(ws + WS_PB2) + hm);
                ezz[d0][i] = *(const u32x4*)((const bf16_t*)(ws + WS_ZB) + hm);
                el[d0][i] = ((const float*)(ws + WS_LB1))[tok * 8 + h] + ((const float*)(ws + WS_LB2))[tok * 8 + h]; }
    }
    int slot = 0;
    for (int t = 0; t < NT; ++t) {
        if (t + 1 < NT) asm volatile("s_waitcnt vmcnt(2) lgkmcnt(0)\n\ts_barrier" ::: "memory");
        else asm volatile("s_waitcnt vmcnt(0) lgkmcnt(0)\n\ts_barrier" ::: "memory");
        if (t + 2 < NT) { const int s2 = slot >= 1 ? slot - 1 : 2; ATT_DMA(t + 2, s2); }
        const int kt = kt0 + 64 * t; const int tau = xw - kt;
        if (tau >= 0 && tau <= 160) {
            f32x16 p0, p1; const lds_cptr cb = ctp + (tau >> 5) * 8192; const lds_cptr kb = kp0 + slot * SLOTB; bf16x8 kfr[8];
#pragma unroll
            for (int d0 = 0; d0 < 4; ++d0) { kfr[2 * d0] = *(const ALDS bf16x8*)(kb + kofs[d0]); kfr[2 * d0 + 1] = *(const ALDS bf16x8*)(kb + kofs[d0] + 4096); }
#pragma unroll
            for (int g = 0; g < 4; ++g) { const f32x4 v0 = *(const ALDS f32x4*)(cb + g * 1024), v1 = *(const ALDS f32x4*)(cb + (4 + g) * 1024);
                p0[4 * g] = v0[0]; p0[4 * g + 1] = v0[1]; p0[4 * g + 2] = v0[2]; p0[4 * g + 3] = v0[3]; p1[4 * g] = v1[0]; p1[4 * g + 1] = v1[1]; p1[4 * g + 2] = v1[2]; p1[4 * g + 3] = v1[3]; }
            __builtin_amdgcn_sched_barrier(0);
#pragma unroll
            for (int d0 = 0; d0 < 4; ++d0) { p0 = __builtin_amdgcn_mfma_f32_32x32x16_bf16(kfr[2 * d0], qr[d0], p0, 0, 0, 0); p1 = __builtin_amdgcn_mfma_f32_32x32x16_bf16(kfr[2 * d0 + 1], qr[d0], p1, 0, 0, 0); }
            __builtin_amdgcn_sched_barrier(0);
            const lds_cptr vp = vp0 + slot * SLOTB; s16x4 vlo[8], vhi[8];
#pragma unroll
            for (int i = 0; i < 8; ++i) { vlo[i] = vtr(vp + ((i >> 2) * 4096 + (i & 3) * 1024)); vhi[i] = vtr(vp + ((i >> 2) * 4096 + (i & 3) * 1024 + 512)); }
            __builtin_amdgcn_sched_barrier(0);
#pragma unroll
            for (int r = 0; r < 16; ++r) { p0[r] = __builtin_amdgcn_exp2f(p0[r]); p1[r] = __builtin_amdgcn_exp2f(p1[r]); }
            u32x4 pw0, pw1, pw2, pw3;
            pw0 = (u32x4){cvtpk(p0[0], p0[1]), cvtpk(p0[2], p0[3]), cvtpk(p0[4], p0[5]), cvtpk(p0[6], p0[7])};
            pw1 = (u32x4){cvtpk(p0[8], p0[9]), cvtpk(p0[10], p0[11]), cvtpk(p0[12], p0[13]), cvtpk(p0[14], p0[15])};
            pw2 = (u32x4){cvtpk(p1[0], p1[1]), cvtpk(p1[2], p1[3]), cvtpk(p1[4], p1[5]), cvtpk(p1[6], p1[7])};
            pw3 = (u32x4){cvtpk(p1[8], p1[9]), cvtpk(p1[10], p1[11]), cvtpk(p1[12], p1[13]), cvtpk(p1[14], p1[15])};
            __builtin_amdgcn_sched_barrier(0);
#define ATT_VF(i) (bf16x8){vlo[i][0], vlo[i][1], vlo[i][2], vlo[i][3], vhi[i][0], vhi[i][1], vhi[i][2], vhi[i][3]}
            o[0] = __builtin_amdgcn_mfma_f32_32x32x16_bf16(__builtin_bit_cast(bf16x8, pw0), ATT_VF(0), o[0], 0, 0, 0); o[1] = __builtin_amdgcn_mfma_f32_32x32x16_bf16(__builtin_bit_cast(bf16x8, pw0), ATT_VF(4), o[1], 0, 0, 0);
            o[2] = __builtin_amdgcn_mfma_f32_32x32x16_bf16(__builtin_bit_cast(bf16x8, pw0), ones8, o[2], 0, 0, 0);
            o[0] = __builtin_amdgcn_mfma_f32_32x32x16_bf16(__builtin_bit_cast(bf16x8, pw1), ATT_VF(1), o[0], 0, 0, 0); o[1] = __builtin_amdgcn_mfma_f32_32x32x16_bf16(__builtin_bit_cast(bf16x8, pw1), ATT_VF(5), o[1], 0, 0, 0);
            o[2] = __builtin_amdgcn_mfma_f32_32x32x16_bf16(__builtin_bit_cast(bf16x8, pw1), ones8, o[2], 0, 0, 0);
            o[0] = __builtin_amdgcn_mfma_f32_32x32x16_bf16(__builtin_bit_cast(bf16x8, pw2), ATT_VF(2), o[0], 0, 0, 0); o[1] = __builtin_amdgcn_mfma_f32_32x32x16_bf16(__builtin_bit_cast(bf16x8, pw2), ATT_VF(6), o[1], 0, 0, 0);
            o[2] = __builtin_amdgcn_mfma_f32_32x32x16_bf16(__builtin_bit_cast(bf16x8, pw2), ones8, o[2], 0, 0, 0);
            o[0] = __builtin_amdgcn_mfma_f32_32x32x16_bf16(__builtin_bit_cast(bf16x8, pw3), ATT_VF(3), o[0], 0, 0, 0); o[1] = __builtin_amdgcn_mfma_f32_32x32x16_bf16(__builtin_bit_cast(bf16x8, pw3), ATT_VF(7), o[1], 0, 0, 0);
            o[2] = __builtin_amdgcn_mfma_f32_32x32x16_bf16(__builtin_bit_cast(bf16x8, pw3), ones8, o[2], 0, 0, 0);
#undef ATT_VF
            __builtin_amdgcn_sched_barrier(0);
        }
        slot = slot == 2 ? 0 : slot + 1;
    }
    asm volatile("s_waitcnt lgkmcnt(0)\n\ts_barrier" ::: "memory");
    bf16x8 qrn[4];
#pragma unroll
    for (int d0 = 0; d0 < 4; ++d0) qrn[d0] = qr[d0];
    if (has_next) unit_start(N, (N.kind != U.kind) || (N.h != U.h), ws, shm, qrn, tid, lane, r32, hi, wid);
    ALDS float* stg = (ALDS float*)(shm + LDS_OSB) + wid * 1024;
    ALDS float* wsf = (ALDS float*)(shm + LDS_WS) + wid * 64;
    if (r32 == 0) {
#pragma unroll
        for (int r = 0; r < 16; ++r) wsf[(r & 3) + 8 * (r >> 2) + 4 * hi] = o[2][r]; }
#pragma unroll
    for (int d0 = 0; d0 < 2; ++d0) {
#pragma unroll
        for (int r = 0; r < 16; ++r) { const int orow = (r & 3) + 8 * (r >> 2) + 4 * hi; stg[orow * 32 + r32] = o[d0][r]; }
        asm volatile("s_waitcnt lgkmcnt(0)" ::: "memory");
#pragma unroll
        for (int i = 0; i < 2; ++i) {
            const int row = i * 16 + (lane >> 2), ch = lane & 3; const size_t tok = rowbase + (size_t)(xw + row) * dil + rho; const int col = h * 64 + d0 * 32 + ch * 8;
            const f32x4 a0 = *(const ALDS f32x4*)(stg + row * 32 + ch * 8), a1 = *(const ALDS f32x4*)(stg + row * 32 + ch * 8 + 4);
            float v[8] = {a0[0], a0[1], a0[2], a0[3], a1[0], a1[1], a1[2], a1[3]};
            float l = wsf[row];
            if (MODE == 1) {
                bf16_t* pb = (bf16_t*)(ws + (U.kind == 1 ? WS_PB1 : WS_PB2)); float* lp = (float*)(ws + (U.kind == 1 ? WS_LB1 : WS_LB2));
                u32x4 w; w.x = cvtpk(v[0], v[1]); w.y = cvtpk(v[2], v[3]); w.z = cvtpk(v[4], v[5]); w.w = cvtpk(v[6], v[7]);
                *(u32x4*)(pb + hmb + ((size_t)(xw + row) * dil + rho) * 64 + d0 * 32 + ch * 8) = w; if (d0 == 0 && ch == 0) lp[tok * 8 + h] = l;
            } else {
                const u32x4 q1 = eq1[d0][i], q2 = eq2[d0][i]; l += el[d0][i];
#pragma unroll
                for (int e = 0; e < 4; ++e) { v[2 * e] += __uint_as_float(q1[e] << 16) + __uint_as_float(q2[e] << 16); v[2 * e + 1] += __uint_as_float(q1[e] & 0xffff0000u) + __uint_as_float(q2[e] & 0xffff0000u); }
                const u32x4 zz = ezz[d0][i]; const float rl = 1.f / l;
#pragma unroll
                for (int e = 0; e < 4; ++e) { v[2 * e] *= rl * silu(__uint_as_float(zz[e] << 16)); v[2 * e + 1] *= rl * silu(__uint_as_float(zz[e] & 0xffff0000u)); }
                u32x4 w; w.x = cvtpk(v[0], v[1]); w.y = cvtpk(v[2], v[3]); w.z = cvtpk(v[4], v[5]); w.w = cvtpk(v[6], v[7]);
                *(u32x4*)((bf16_t*)(ws + WS_MIX) + tok * 1024 + 512 + col) = w;
            }
        }
        asm volatile("s_waitcnt lgkmcnt(0)" ::: "memory");
    }
#undef ATT_DMA
#pragma unroll
    for (int d0 = 0; d0 < 4; ++d0) qr[d0] = qrn[d0];
}
constexpr int BS_NS = 5, BS_K = 0, BS_V = BS_NS * SLOTB, BS_WS = 2 * BS_NS * SLOTB, BS_OS = BS_WS + 2048, BS_CT = BS_OS + 2 * 4096, BS_BYTES = BS_CT + 6 * 8192;
template <int MODE> __device__ __forceinline__ void b_stream(int b, int h, int kind, int dil, int rho0, int nseq, int lt, unsigned char* ws, ALDS unsigned char* shm) {
    int tid_ = threadIdx.x; asm volatile("" : "+v"(tid_));
    const int tid = tid_, lane = tid & 63, r32 = lane & 31, hi = lane >> 5; const int wid = __builtin_amdgcn_readfirstlane(tid >> 6), hw = wid >> 1;
    const int T = 1 << lt, NS = nseq << lt;
    const size_t rowbase = (size_t)b * SEQ; const size_t hmb = (size_t)(b * 8 + h) * HM_PITCH;
    const bf16_t* Qg = (const bf16_t*)(ws + WS_QB) + hmb; const bf16_t* Kg = (const bf16_t*)(ws + WS_KB) + hmb; const bf16_t* Vg = (const bf16_t*)(ws + WS_VB) + hmb;
    const unsigned lds0 = (unsigned)(uintptr_t)shm;
    __syncthreads();
    build_ctab(kind, h, ws, shm, tid, BS_CT);
    const int krow = 8 * wid + (lane >> 3), kcol = ((lane & 7) ^ ((lane >> 3) & 7)) * 8, vrow = 16 * (wid & 3) + (lane >> 2), vcol = (wid >> 2) * 32 + (lane & 3) * 8;
    const unsigned kdst = lds0 + BS_K + wid * 1024, vdst = lds0 + BS_V + wid * 1024;
#define BS_DMA(sg) do { const int sq_ = (sg) >> lt, t_ = (sg) & (T - 1), rho_ = rho0 + sq_; const unsigned so_ = (unsigned)(((sg) % BS_NS) * SLOTB); \
        glds16(Kg + ((size_t)(64 * t_ + krow) * dil + rho_) * 64 + kcol, (unsigned)__builtin_amdgcn_readfirstlane(kdst + so_)); \
        glds16(Vg + ((size_t)(64 * t_ + vrow) * dil + rho_) * 64 + vcol, (unsigned)__builtin_amdgcn_readfirstlane(vdst + so_)); } while (0)
    const lds_cptr kp0 = (lds_cptr)shm + BS_K + r32 * 128; int kofs[4];
#pragma unroll
    for (int d0 = 0; d0 < 4; ++d0) kofs[d0] = ((2 * d0 + hi) ^ (r32 & 7)) * 16;
    const lds_cptr vp0 = (lds_cptr)shm + BS_V + ((lane >> 4) & 1) * 32 + (lane & 3) * 8 + (4 * hi + ((lane & 15) >> 2)) * 64;
    const lds_cptr ctp = (lds_cptr)shm + BS_CT + lane * 16;
    bf16x8 qr[4], qn[4];
#pragma unroll
    for (int d0 = 0; d0 < 4; ++d0) qr[d0] = bf16x8{};
#define BS_LOADS(JJ) do { const int sq_ = (JJ) >> (lt + 1), j_ = (JJ) & (2 * T - 1), rho_ = rho0 + sq_, xw_ = 32 * j_; \
        const bf16_t* qp_ = Qg + ((size_t)(xw_ + r32) * dil + rho_) * 64 + hi * 8; \
        _Pragma("unroll") for (int d0 = 0; d0 < 4; ++d0) asm volatile("global_load_dwordx4 %0, %1, off" : "=v"(qn[d0]) : "v"(qp_ + d0 * 16) : "memory"); } while (0)
#define BS_PIN() do { _Pragma("unroll") for (int d0 = 0; d0 < 4; ++d0) { asm volatile("" : "+v"(qn[d0])); qr[d0] = qn[d0]; } } while (0)
    f32x16 o[2]; o[0] = f32x16{}; o[1] = f32x16{}; float l_reg = 0.f;
    BS_LOADS(wid);
    BS_DMA(0); BS_DMA(1); BS_DMA(2); BS_DMA(3);
#define BS_CLOSE(s_, KIND) do { const int n3 = ((s_) + 3 < NS) ? 2 : 0, n2 = ((s_) + 2 < NS) ? 2 : 0, n1 = ((s_) + 1 < NS) ? 2 : 0; \
          const int nw = (KIND) == 1 ? n3 : ((KIND) == 2 ? n1 + n2 + n3 + 4 : n1 + n2 + n3); \
          if (nw == 10) asm volatile("s_waitcnt vmcnt(10) lgkmcnt(0)\n\ts_barrier" ::: "memory"); \
          else if (nw == 8) asm volatile("s_waitcnt vmcnt(8) lgkmcnt(0)\n\ts_barrier" ::: "memory"); \
          else if (nw == 6) asm volatile("s_waitcnt vmcnt(6) lgkmcnt(0)\n\ts_barrier" ::: "memory"); \
          else if (nw == 4) asm volatile("s_waitcnt vmcnt(4) lgkmcnt(0)\n\ts_barrier" ::: "memory"); \
          else if (nw == 2) asm volatile("s_waitcnt vmcnt(2) lgkmcnt(0)\n\ts_barrier" ::: "memory"); \
          else asm volatile("s_waitcnt vmcnt(0) lgkmcnt(0)\n\ts_barrier" ::: "memory"); } while (0)
    BS_CLOSE(0, 1); BS_PIN();
    for (int s = 0; s <= NS; ++s) {
        const int u = s + 6 - hw, n = (u >> 2) - 1, ph = u & 3;
        const int J = wid + 8 * n;
        if (ph != 3) {
            const int sq = J >> (lt + 1), j = J & (2 * T - 1), tq = (j >> 1) - 2 + ph;
            const bool ldr = ph == 2 && n >= 0 && sq < nseq;
            const bool ldq = ldr && s < NS && ((J + 8) >> (lt + 1)) < nseq;
            if (ldq) BS_LOADS(J + 8);
            if (s + 4 < NS) BS_DMA(s + 4);
            if (n >= 0 && sq < nseq && tq >= 0) {
                const int tau = 32 * j - 64 * tq; const int slot = s % BS_NS;
                f32x16 p0, p1; const lds_cptr cb = ctp + (tau >> 5) * 8192; const lds_cptr kb = kp0 + slot * SLOTB; bf16x8 kfr[8];
#pragma unroll
                for (int d0 = 0; d0 < 4; ++d0) { kfr[2 * d0] = *(const ALDS bf16x8*)(kb + kofs[d0]); kfr[2 * d0 + 1] = *(const ALDS bf16x8*)(kb + kofs[d0] + 4096); }
#pragma unroll
                for (int g = 0; g < 4; ++g) { const f32x4 v0 = *(const ALDS f32x4*)(cb + g * 1024), v1 = *(const ALDS f32x4*)(cb + (4 + g) * 1024);
                    p0[4 * g] = v0[0]; p0[4 * g + 1] = v0[1]; p0[4 * g + 2] = v0[2]; p0[4 * g + 3] = v0[3]; p1[4 * g] = v1[0]; p1[4 * g + 1] = v1[1]; p1[4 * g + 2] = v1[2]; p1[4 * g + 3] = v1[3]; }
                __builtin_amdgcn_sched_barrier(0);
#pragma unroll
                for (int d0 = 0; d0 < 4; ++d0) { p0 = __builtin_amdgcn_mfma_f32_32x32x16_bf16(kfr[2 * d0], qr[d0], p0, 0, 0, 0); p1 = __builtin_amdgcn_mfma_f32_32x32x16_bf16(kfr[2 * d0 + 1], qr[d0], p1, 0, 0, 0); }
                __builtin_amdgcn_sched_barrier(0);
                const lds_cptr vp = vp0 + slot * SLOTB;
#pragma unroll
                for (int r = 0; r < 16; ++r) { p0[r] = __builtin_amdgcn_exp2f(p0[r]); p1[r] = __builtin_amdgcn_exp2f(p1[r]); }
#pragma unroll
                for (int r = 0; r < 16; ++r) { l_reg += p0[r]; l_reg += p1[r]; }
                u32x4 pw[4];
                pw[0] = (u32x4){cvtpk(p0[0], p0[1]), cvtpk(p0[2], p0[3]), cvtpk(p0[4], p0[5]), cvtpk(p0[6], p0[7])};
                pw[1] = (u32x4){cvtpk(p0[8], p0[9]), cvtpk(p0[10], p0[11]), cvtpk(p0[12], p0[13]), cvtpk(p0[14], p0[15])};
                pw[2] = (u32x4){cvtpk(p1[0], p1[1]), cvtpk(p1[2], p1[3]), cvtpk(p1[4], p1[5]), cvtpk(p1[6], p1[7])};
                pw[3] = (u32x4){cvtpk(p1[8], p1[9]), cvtpk(p1[10], p1[11]), cvtpk(p1[12], p1[13]), cvtpk(p1[14], p1[15])};
                __builtin_amdgcn_sched_barrier(0);
#pragma unroll
                for (int kk = 0; kk < 2; ++kk) {
                    s16x4 vl[4], vh[4];
#pragma unroll
                    for (int q = 0; q < 4; ++q) { const int i = (q >> 1) * 4 + 2 * kk + (q & 1); vl[q] = vtr(vp + ((i >> 2) * 4096 + (i & 3) * 1024)); vh[q] = vtr(vp + ((i >> 2) * 4096 + (i & 3) * 1024 + 512)); }
                    __builtin_amdgcn_sched_barrier(0);
#define BS_VF(q) (bf16x8){vl[q][0], vl[q][1], vl[q][2], vl[q][3], vh[q][0], vh[q][1], vh[q][2], vh[q][3]}
                    o[0] = __builtin_amdgcn_mfma_f32_32x32x16_bf16(__builtin_bit_cast(bf16x8, pw[2 * kk]), BS_VF(0), o[0], 0, 0, 0); o[1] = __builtin_amdgcn_mfma_f32_32x32x16_bf16(__builtin_bit_cast(bf16x8, pw[2 * kk]), BS_VF(2), o[1], 0, 0, 0);
                    o[0] = __builtin_amdgcn_mfma_f32_32x32x16_bf16(__builtin_bit_cast(bf16x8, pw[2 * kk + 1]), BS_VF(1), o[0], 0, 0, 0); o[1] = __builtin_amdgcn_mfma_f32_32x32x16_bf16(__builtin_bit_cast(bf16x8, pw[2 * kk + 1]), BS_VF(3), o[1], 0, 0, 0);
#undef BS_VF
                    __builtin_amdgcn_sched_barrier(0);
                }
                __builtin_amdgcn_sched_barrier(0);
            }
            if (s < NS) { if (ldq) { BS_CLOSE(s + 1, 1); BS_PIN(); } else BS_CLOSE(s + 1, 0); }
        } else {
            const int sq = J >> (lt + 1), j = J & (2 * T - 1);
            if (MODE == 1 && s + 4 < NS) BS_DMA(s + 4);
            if (n >= 0 && sq < nseq) {
                const int rho = rho0 + sq, xw = 32 * j;
                ALDS float* stg = (ALDS float*)(shm + BS_OS) + (wid & 1) * 1024; ALDS float* wsf = (ALDS float*)(shm + BS_WS) + wid * 64;
                u32x4 eq1[2][2], eq2[2][2], ezz[2][2]; float el1[2], el2[2];
                if (MODE == 2) {
#pragma unroll
                    for (int i = 0; i < 2; ++i) { const int row = i * 16 + (lane >> 2), ch = lane & 3; const size_t sub = (size_t)(xw + row) * dil + rho; const size_t tok = rowbase + sub;
                        el1[i] = ((const float*)(ws + WS_LB1))[tok * 8 + h]; el2[i] = ((const float*)(ws + WS_LB2))[tok * 8 + h];
#pragma unroll
                        for (int d0 = 0; d0 < 2; ++d0) { const size_t hm = hmb + sub * 64 + d0 * 32 + ch * 8;
                            eq1[d0][i] = *(const u32x4*)((const bf16_t*)(ws + WS_PB1) + hm); eq2[d0][i] = *(const u32x4*)((const bf16_t*)(ws + WS_PB2) + hm); ezz[d0][i] = *(const u32x4*)((const bf16_t*)(ws + WS_ZB) + hm); } }
                }
                { float lt_ = l_reg; auto rr = __builtin_amdgcn_permlane32_swap(__float_as_uint(lt_), __float_as_uint(lt_), false, false); lt_ = __uint_as_float(rr[0]) + __uint_as_float(rr[1]); if (hi == 0) wsf[r32] = lt_; }
#pragma unroll
                for (int d0 = 0; d0 < 2; ++d0) {
#pragma unroll
                    for (int r = 0; r < 16; ++r) { const int orow = (r & 3) + 8 * (r >> 2) + 4 * hi; stg[orow * 32 + r32] = o[d0][r]; }
                    asm volatile("s_waitcnt lgkmcnt(0)" ::: "memory");
#pragma unroll
                    for (int i = 0; i < 2; ++i) {
                        const int row = i * 16 + (lane >> 2), ch = lane & 3; const size_t sub = (size_t)(xw + row) * dil + rho; const size_t tok = rowbase + sub; const int col = h * 64 + d0 * 32 + ch * 8;
                        const f32x4 a0 = *(const ALDS f32x4*)(stg + row * 32 + ch * 8), a1 = *(const ALDS f32x4*)(stg + row * 32 + ch * 8 + 4);
                        float v[8] = {a0[0], a0[1], a0[2], a0[3], a1[0], a1[1], a1[2], a1[3]};
                        float l = wsf[row];
                        if (MODE == 1) {
                            bf16_t* pb = (bf16_t*)(ws + (kind == 1 ? WS_PB1 : WS_PB2)); float* lp = (float*)(ws + (kind == 1 ? WS_LB1 : WS_LB2));
                            u32x4 w; w.x = cvtpk(v[0], v[1]); w.y = cvtpk(v[2], v[3]); w.z = cvtpk(v[4], v[5]); w.w = cvtpk(v[6], v[7]);
                            *(u32x4*)(pb + hmb + sub * 64 + d0 * 32 + ch * 8) = w; if (d0 == 0 && ch == 0) lp[tok * 8 + h] = l;
                        } else {
                            const u32x4 q1 = eq1[d0][i], q2 = eq2[d0][i]; l += el1[i] + el2[i];
#pragma unroll
                            for (int e = 0; e < 4; ++e) { v[2 * e] += __uint_as_float(q1[e] << 16) + __uint_as_float(q2[e] << 16); v[2 * e + 1] += __uint_as_float(q1[e] & 0xffff0000u) + __uint_as_float(q2[e] & 0xffff0000u); }
                            const u32x4 zz = ezz[d0][i]; const float rl = 1.f / l;
#pragma unroll
                            for (int e = 0; e < 4; ++e) { v[2 * e] *= rl * silu(__uint_as_float(zz[e] << 16)); v[2 * e + 1] *= rl * silu(__uint_as_float(zz[e] & 0xffff0000u)); }
                            u32x4 w; w.x = cvtpk(v[0], v[1]); w.y = cvtpk(v[2], v[3]); w.z = cvtpk(v[4], v[5]); w.w = cvtpk(v[6], v[7]);
                            *(u32x4*)((bf16_t*)(ws + WS_MIX) + tok * 1024 + 512 + col) = w;
                        }
                    }
                    asm volatile("s_waitcnt lgkmcnt(0)" ::: "memory");
                }
                o[0] = f32x16{}; o[1] = f32x16{}; l_reg = 0.f;
            }
            if (MODE == 2 && s + 4 < NS) BS_DMA(s + 4);
            if (s < NS) { if (MODE == 2) BS_CLOSE(s + 1, 1); else if (n >= 0 && sq < nseq) BS_CLOSE(s + 1, 2); else BS_CLOSE(s + 1, 0); }
        }
    }
    asm volatile("s_waitcnt vmcnt(0) lgkmcnt(0)\n\ts_barrier" ::: "memory");
#undef BS_DMA
#undef BS_LOADS
#undef BS_PIN
#undef BS_CLOSE
}
#define SBAR() __builtin_amdgcn_sched_barrier(0)
#define PIN(x) asm volatile("" : "+v"(x))
#define MFMA32(a, b, c) __builtin_amdgcn_mfma_f32_32x32x16_bf16(a, b, c, 0, 0, 0)
__device__ __forceinline__ void kload2(bf16x8* kf, lds_cptr kp, int d0) { kf[2 * d0] = *(const ALDS bf16x8*)(kp + d0 * 2048); kf[2 * d0 + 1] = *(const ALDS bf16x8*)(kp + d0 * 2048 + 512); }
#define MEXP(X, MW, BIT) do { float e_ = __builtin_amdgcn_exp2f(X); int m_; asm("v_bfe_i32 %1, %2, %3, 1\n\tv_and_b32 %0, %0, %1" : "+v"(e_), "=&v"(m_) : "v"(MW), "n"(BIT)); X = e_; } while (0)
__device__ __forceinline__ void bias_near(f32x16& c0, f32x16& c1, const ALDS float* tab, int jb) {
#pragma unroll
    for (int r = 0; r < 16; ++r) { const int c = (r & 3) + 8 * (r >> 2); unsigned j0 = (unsigned)(jb - c), j1 = (unsigned)(jb - c - 32); j0 = j0 < 128u ? j0 : 128u; j1 = j1 < 128u ? j1 : 128u; c0[r] += tab[j0]; c1[r] += tab[j1]; }
}
#define MEXP4(X, i, MW, B0) do { float e0_ = __builtin_amdgcn_exp2f(X[i]), e1_ = __builtin_amdgcn_exp2f(X[(i) + 1]), e2_ = __builtin_amdgcn_exp2f(X[(i) + 2]), e3_ = __builtin_amdgcn_exp2f(X[(i) + 3]); int m0_, m1_, m2_, m3_; \
    asm("v_bfe_i32 %4, %8, %9, 1\n\tv_bfe_i32 %5, %8, %10, 1\n\tv_bfe_i32 %6, %8, %11, 1\n\tv_bfe_i32 %7, %8, %12, 1\n\tv_and_b32 %0, %0, %4\n\tv_and_b32 %1, %1, %5\n\tv_and_b32 %2, %2, %6\n\tv_and_b32 %3, %3, %7" \
        : "+v"(e0_), "+v"(e1_), "+v"(e2_), "+v"(e3_), "=&v"(m0_), "=&v"(m1_), "=&v"(m2_), "=&v"(m3_) : "v"(MW), "n"(B0), "n"((B0) + 1), "n"((B0) + 2), "n"((B0) + 3)); \
    X[i] = e0_; X[(i) + 1] = e1_; X[(i) + 2] = e2_; X[(i) + 3] = e3_; } while (0)
#define A2_MLOAD(dst, ptr, tt) asm volatile("global_load_dword %0, %1, %2" : "=v"(dst) : "v"(mvo), "s"((ptr) + (size_t)(tt) * 64) : "memory")
#define A2_PKW(P, i) cvtpk(P[i], P[(i) + 1])
#define A2_BC(x) __builtin_bit_cast(bf16x8, x)
__device__ __forceinline__ void bias_near4(f32x16& c0, f32x16& c1, const ALDS float* tab, int jb) {
#pragma unroll
    for (int g = 0; g < 4; ++g) {
#pragma unroll
        for (int rr = 0; rr < 4; ++rr) { const int r = 4 * g + rr; const int c = (r & 3) + 8 * (r >> 2); unsigned j0 = (unsigned)(jb - c), j1 = (unsigned)(jb - c - 32); j0 = j0 < 128u ? j0 : 128u; j1 = j1 < 128u ? j1 : 128u; c0[r] += tab[j0]; c1[r] += tab[j1]; }
        __builtin_amdgcn_sched_barrier(0); }
}
__device__ __forceinline__ void attn_unit_a2(int b, int h, int qb, const bool load_tab, unsigned char* ws, lds_ptr shm) {
    int tid_ = threadIdx.x; asm volatile("" : "+v"(tid_));
    const int tid = tid_, lane = tid & 63, r32 = lane & 31, hi = lane >> 5; const int wid = __builtin_amdgcn_readfirstlane(tid >> 6);
    const int grp = wid >> 2;
    const size_t rowbase = (size_t)b * SEQ; const int u0 = qb * 512, NT = 8 * qb + 8;
    const int xa = u0 + 32 * wid, xb = u0 + 32 * (15 - wid);
    const int TS = xa >= 191 ? (xa - 191) / 64 + 1 : 0;
    const size_t hmb = (size_t)(b * 8 + h) * HM_PITCH;
    const bf16_t* Qg = (const bf16_t*)(ws + WS_QA) + hmb;
    const bf16_t* Kg = (const bf16_t*)(ws + WS_KA) + hmb;
    const bf16_t* Vg = (const bf16_t*)(ws + WS_VA) + hmb;
    const unsigned lds0 = (unsigned)(uintptr_t)shm;
    ALDS float* tab = (ALDS float*)(shm + LDS_TAB);
    if (load_tab) { const float tv = ((const float*)(ws + WS_ATAB))[h * TABN + (tid < TABN ? tid : TABN - 1)]; if (tid < TABN) tab[tid] = tv; }
    const unsigned kvo = (unsigned)(lane * 128 + wid * 16), vvo = (unsigned)((16 * (wid & 3) + (lane >> 2)) * 128 + (wid >> 2) * 64 + (lane & 3) * 16), mvo = (unsigned)(lane * 4);
    const unsigned kdst = lds0 + LDS_K + wid * 1024, vdst = lds0 + LDS_V + wid * 1024;
#define A2_DMA_K(t, slot) glds16s(Kg + (size_t)(t) * 64 * 64, kvo, (unsigned)__builtin_amdgcn_readfirstlane(kdst + (slot)))
#define A2_DMA_V(t, slot) glds16s(Vg + (size_t)(t) * 64 * 64, vvo, (unsigned)__builtin_amdgcn_readfirstlane(vdst + (slot)))
    const lds_cptr vp0 = (lds_cptr)shm + LDS_V + ((lane >> 4) & 1) * 32 + (lane & 3) * 8 + (4 * hi + ((lane & 15) >> 2)) * 64;
    const lds_cptr kp0 = (lds_cptr)shm + LDS_K + hi * 1024 + r32 * 16;
    const unsigned* mpa = (const unsigned*)(ws + WS_MASK) + (((size_t)b * 128 + (xa >> 5)) * 64) * 64;
    const unsigned* mpb = (const unsigned*)(ws + WS_MASK) + (((size_t)b * 128 + (xb >> 5)) * 64) * 64;
    bf16x8 qa[4], qbv[4];
    { const bf16_t* qp = Qg + (size_t)(xa + r32) * 64 + hi * 8; const bf16_t* qp2 = Qg + (size_t)(xb + r32) * 64 + hi * 8;
#pragma unroll
      for (int d0 = 0; d0 < 4; ++d0) { qa[d0] = *(const bf16x8*)(qp + d0 * 16); qbv[d0] = *(const bf16x8*)(qp2 + d0 * 16); } }
    unsigned man, mbn, mac = 0u, mbc = 0u, map_ = 0u, mbp = 0u;
    A2_DMA_K(0, 0); A2_MLOAD(man, mpa, 0); A2_MLOAD(mbn, mpb, 0); A2_DMA_K(1, SLOTB); A2_DMA_V(0, 0);
    const f32x16 zero16 = f32x16{};
    f32x16 oa0 = f32x16{}, oa1 = f32x16{}, ob0 = f32x16{}, ob1 = f32x16{}; float la = 0.f, lb = 0.f;
    f32x16 sa0 = f32x16{}, sa1 = f32x16{}, sb0 = f32x16{}, sb1 = f32x16{}; u32x4 pwa[4], pwb[4];
#pragma unroll
    for (int i = 0; i < 4; ++i) { pwa[i] = (u32x4){0u, 0u, 0u, 0u}; pwb[i] = (u32x4){0u, 0u, 0u, 0u}; }
    const int jba = xa + r32 - 4 * hi;
#define jbb (jba + (xb - xa))
    asm volatile("s_waitcnt vmcnt(2) lgkmcnt(0)\n\ts_barrier" ::: "memory");
    asm volatile("" : "+v"(man), "+v"(mbn));
#pragma unroll
    for (int d0 = 0; d0 < 4; ++d0) asm volatile("" : "+v"(qa[d0]), "+v"(qbv[d0]));
    mac = man; mbc = mbn;
    int s_prev = 2 * SLOTB, s_cur = 0, s_next = SLOTB;
#define A2_SOFT(S0, S1, PW, L, MW, NEAR, JB, x) do { \
        if (NEAR) bias_near4(S0, S1, tab, (JB) - 64 * (x)); \
        MEXP4(S0, 0, MW, 0); MEXP4(S0, 4, MW, 4); MEXP4(S0, 8, MW, 8); MEXP4(S0, 12, MW, 12); MEXP4(S1, 0, MW, 16); MEXP4(S1, 4, MW, 20); MEXP4(S1, 8, MW, 24); MEXP4(S1, 12, MW, 28); \
        _Pragma("unroll") for (int r = 0; r < 16; ++r) asm("v_add_f32 %0, %0, %1" : "+v"(L) : "v"(S0[r])); \
        _Pragma("unroll") for (int r = 0; r < 16; ++r) asm("v_add_f32 %0, %0, %1" : "+v"(L) : "v"(S1[r])); \
        PW[0] = (u32x4){A2_PKW(S0, 0), A2_PKW(S0, 2), A2_PKW(S0, 4), A2_PKW(S0, 6)}; PW[1] = (u32x4){A2_PKW(S0, 8), A2_PKW(S0, 10), A2_PKW(S0, 12), A2_PKW(S0, 14)}; \
        PW[2] = (u32x4){A2_PKW(S1, 0), A2_PKW(S1, 2), A2_PKW(S1, 4), A2_PKW(S1, 6)}; PW[3] = (u32x4){A2_PKW(S1, 8), A2_PKW(S1, 10), A2_PKW(S1, 12), A2_PKW(S1, 14)}; } while (0)
#define A2_SPART(x, MA, MB) do { if ((x) >= 0 && (x) < NT) { \
        if (64 * (x) <= xb + 31) { A2_SOFT(sb0, sb1, pwb, lb, MB, 64 * (x) + 63 > xb - 128, jbb, x); } \
        if (64 * (x) <= xa + 31) { A2_SOFT(sa0, sa1, pwa, la, MA, 64 * (x) + 63 > xa - 128, jba, x); } } \
        __builtin_amdgcn_sched_barrier(0); } while (0)
#define A2_SSTEADY(MA, MB) do { A2_SOFT(sb0, sb1, pwb, lb, MB, false, jbb, 0); A2_SOFT(sa0, sa1, pwa, la, MA, false, jba, 0); __builtin_amdgcn_sched_barrier(0); } while (0)
#define A2_VRD2(k, VL0, VH0, VL1, VH1) do { VL0 = vtr(vp_ + (k) * 1024); VH0 = vtr(vp_ + (k) * 1024 + 512); VL1 = vtr(vp_ + 4096 + (k) * 1024); VH1 = vtr(vp_ + 4096 + (k) * 1024 + 512); } while (0)
#define A2_V8(L, H) (bf16x8){L[0], L[1], L[2], L[3], H[0], H[1], H[2], H[3]}
#define A2_PV(BOTH) do { const lds_cptr vp_ = vp0 + s_prev; s16x4 l0, h0, l1, h1, l0n, h0n, l1n, h1n; \
            A2_VRD2(0, l0, h0, l1, h1); \
            _Pragma("unroll") for (int k = 0; k < 4; ++k) { \
                if (k < 3) A2_VRD2(k + 1, l0n, h0n, l1n, h1n); \
                __builtin_amdgcn_sched_barrier(0); \
                ob0 = MFMA32(A2_BC(pwb[k]), A2_V8(l0, h0), ob0); ob1 = MFMA32(A2_BC(pwb[k]), A2_V8(l1, h1), ob1); \
                if (BOTH) { oa0 = MFMA32(A2_BC(pwa[k]), A2_V8(l0, h0), oa0); oa1 = MFMA32(A2_BC(pwa[k]), A2_V8(l1, h1), oa1); } \
                __builtin_amdgcn_sched_barrier(0); \
                l0 = l0n; h0 = h0n; l1 = l1n; h1 = h1n; } } while (0)
#define A2_QK(BOTH) do { const lds_cptr kb_ = kp0 + s_cur; bf16x8 k0 = *(const ALDS bf16x8*)(kb_), k1 = *(const ALDS bf16x8*)(kb_ + 512), k0n, k1n; \
            _Pragma("unroll") for (int d0 = 0; d0 < 4; ++d0) { \
                if (d0 < 3) { k0n = *(const ALDS bf16x8*)(kb_ + (d0 + 1) * 2048); k1n = *(const ALDS bf16x8*)(kb_ + (d0 + 1) * 2048 + 512); } \
                __builtin_amdgcn_sched_barrier(0); \
                sb0 = MFMA32(k0, qbv[d0], d0 == 0 ? zero16 : sb0); sb1 = MFMA32(k1, qbv[d0], d0 == 0 ? zero16 : sb1); \
                if (BOTH) { sa0 = MFMA32(k0, qa[d0], d0 == 0 ? zero16 : sa0); sa1 = MFMA32(k1, qa[d0], d0 == 0 ? zero16 : sa1); } \
                __builtin_amdgcn_sched_barrier(0); \
                k0 = k0n; k1 = k1n; } } while (0)
#define A2_MPART(t) do { \
        if ((t) >= 1 && 64 * ((t) - 1) <= xb + 31) { { const bool bo_ = 64 * ((t) - 1) <= xa + 31; A2_PV(bo_); } } \
        if ((t) < NT && 64 * (t) <= xb + 31) { { const bool bo_ = 64 * (t) <= xa + 31; A2_QK(bo_); } } } while (0)
#define A2_PVK(k, L0, H0, L1, H1) do { ob0 = MFMA32(A2_BC(pwb[k]), A2_V8(L0, H0), ob0); ob1 = MFMA32(A2_BC(pwb[k]), A2_V8(L1, H1), ob1); oa0 = MFMA32(A2_BC(pwa[k]), A2_V8(L0, H0), oa0); oa1 = MFMA32(A2_BC(pwa[k]), A2_V8(L1, H1), oa1); } while (0)
#define A2_QKK(d0, K0, K1) do { sb0 = MFMA32(K0, qbv[d0], d0 == 0 ? zero16 : sb0); sb1 = MFMA32(K1, qbv[d0], d0 == 0 ? zero16 : sb1); sa0 = MFMA32(K0, qa[d0], d0 == 0 ? zero16 : sa0); sa1 = MFMA32(K1, qa[d0], d0 == 0 ? zero16 : sa1); } while (0)
#define A2_KRD(d0, K0, K1) do { K0 = *(const ALDS bf16x8*)(kb_ + (d0) * 2048); K1 = *(const ALDS bf16x8*)(kb_ + (d0) * 2048 + 512); } while (0)
#define A2_SB() __builtin_amdgcn_sched_barrier(0)
#define A2_MS_HEAD() const lds_cptr vp_ = vp0 + s_prev; const lds_cptr kb_ = kp0 + s_cur; s16x4 l0, h0, l1, h1, l0n, h0n, l1n, h1n; bf16x8 k0, k1, k0n, k1n; A2_VRD2(0, l0, h0, l1, h1); A2_VRD2(1, l0n, h0n, l1n, h1n); A2_SB()
#define A2_MS_BODY() do { \
        A2_PVK(0, l0, h0, l1, h1); A2_SB(); A2_VRD2(2, l0, h0, l1, h1); A2_SB(); \
        A2_PVK(1, l0n, h0n, l1n, h1n); A2_SB(); A2_VRD2(3, l0n, h0n, l1n, h1n); A2_KRD(0, k0, k1); A2_SB(); \
        A2_PVK(2, l0, h0, l1, h1); A2_SB(); A2_KRD(1, k0n, k1n); A2_SB(); \
        A2_PVK(3, l0n, h0n, l1n, h1n); A2_SB(); \
        A2_QKK(0, k0, k1); A2_SB(); A2_KRD(2, k0, k1); A2_SB(); \
        A2_QKK(1, k0n, k1n); A2_SB(); A2_KRD(3, k0n, k1n); A2_SB(); \
        A2_QKK(2, k0, k1); A2_SB(); A2_QKK(3, k0n, k1n); A2_SB(); } while (0)
#define A2_ISSUE(t) do { if ((t) + 1 < NT) { A2_MLOAD(man, mpa, (t) + 1); A2_MLOAD(mbn, mpb, (t) + 1); } if ((t) + 2 < NT) A2_DMA_K((t) + 2, s_prev); if ((t) + 1 < NT) A2_DMA_V((t) + 1, s_next); } while (0)
#define A2_ISSUE_S(t) do { A2_MLOAD(man, mpa, (t) + 1); A2_MLOAD(mbn, mpb, (t) + 1); A2_DMA_K((t) + 2, s_prev); A2_DMA_V((t) + 1, s_next); } while (0)
#define A2_ROT() do { asm volatile("" : "+v"(man), "+v"(mbn)); map_ = mac; mbp = mbc; mac = man; mbc = mbn; { const int tmp = s_prev; s_prev = s_cur; s_cur = s_next; s_next = tmp; } } while (0)
#define A2_CLOSE(t) do { \
        if ((t) + 2 < NT) asm volatile("s_waitcnt vmcnt(2) lgkmcnt(0)\n\ts_barrier" ::: "memory"); \
        else if ((t) + 1 < NT) asm volatile("s_waitcnt vmcnt(1) lgkmcnt(0)\n\ts_barrier" ::: "memory"); \
        else asm volatile("s_waitcnt vmcnt(0) lgkmcnt(0)\n\ts_barrier" ::: "memory"); \
        A2_ROT(); } while (0)
#define A2_CLOSE_S() do { asm volatile("s_waitcnt vmcnt(2) lgkmcnt(0)\n\ts_barrier" ::: "memory"); A2_ROT(); } while (0)
    if (grp == 0) {
        A2_ISSUE(0); A2_MPART(0); A2_SPART(0, mac, mbc); A2_CLOSE(0);
        int t = 1;
        for (; t < TS; ++t) { __builtin_amdgcn_s_setprio(1); A2_MS_HEAD(); A2_ISSUE_S(t); A2_MS_BODY(); __builtin_amdgcn_s_setprio(0); A2_SSTEADY(mac, mbc); A2_CLOSE_S(); }
        for (; t < NT; ++t) { A2_ISSUE(t); __builtin_amdgcn_s_setprio(1); A2_MPART(t); __builtin_amdgcn_s_setprio(0); A2_SPART(t, mac, mbc); A2_CLOSE(t); }
        A2_MPART(NT);
    } else {
        A2_ISSUE(0); A2_MPART(0); A2_CLOSE(0);
        int t = 1;
        for (; t < TS; ++t) { A2_ISSUE_S(t); A2_SSTEADY(map_, mbp); __builtin_amdgcn_s_setprio(1); A2_MS_HEAD(); A2_MS_BODY(); __builtin_amdgcn_s_setprio(0); A2_CLOSE_S(); }
        for (; t < NT; ++t) { A2_ISSUE(t); A2_SPART(t - 1, map_, mbp); __builtin_amdgcn_s_setprio(1); A2_MPART(t); __builtin_amdgcn_s_setprio(0); A2_CLOSE(t); }
        A2_SPART(NT - 1, map_, mbp); A2_MPART(NT);
    }
    asm volatile("s_waitcnt lgkmcnt(0)\n\ts_barrier" ::: "memory");
    ALDS float* wsf = (ALDS float*)(shm + LDS_WS) + wid * 64;
    ALDS float* stg = (ALDS float*)(shm + LDS_OST) + wid * 2048;
#define A2_EPI(O0, O1, L, X) do { u32x4 zzv[4]; \
        _Pragma("unroll") for (int i = 0; i < 4; ++i) { const int row = i * 8 + (lane >> 3), ch = lane & 7; zzv[i] = *(const u32x4*)((const bf16_t*)(ws + WS_ZA) + hmb + (size_t)((X) + row) * 64 + ch * 8); } \
        float l_ = L; { auto rr = __builtin_amdgcn_permlane32_swap(__float_as_uint(l_), __float_as_uint(l_), false, false); l_ = __uint_as_float(rr[0]) + __uint_as_float(rr[1]); } \
        if (hi == 0) wsf[r32] = l_; \
        _Pragma("unroll") for (int r = 0; r < 16; ++r) { const int orow = (r & 3) + 8 * (r >> 2) + 4 * hi; stg[orow * 64 + r32] = O0[r]; stg[orow * 64 + 32 + r32] = O1[r]; } \
        asm volatile("s_waitcnt lgkmcnt(0)" ::: "memory"); \
        _Pragma("unroll") for (int i = 0; i < 4; ++i) { \
            const int row = i * 8 + (lane >> 3), ch = lane & 7; const size_t tok = rowbase + (size_t)((X) + row); const int col = h * 64 + ch * 8; \
            const f32x4 a0 = *(const ALDS f32x4*)(stg + row * 64 + ch * 8), a1 = *(const ALDS f32x4*)(stg + row * 64 + ch * 8 + 4); const float rl = 1.f / wsf[row]; \
            float v[8] = {a0[0], a0[1], a0[2], a0[3], a1[0], a1[1], a1[2], a1[3]}; const u32x4 zz = zzv[i]; \
            _Pragma("unroll") for (int e = 0; e < 4; ++e) { v[2 * e] *= rl * silu(__uint_as_float(zz[e] << 16)); v[2 * e + 1] *= rl * silu(__uint_as_float(zz[e] & 0xffff0000u)); } \
            u32x4 w; w.x = cvtpk(v[0], v[1]); w.y = cvtpk(v[2], v[3]); w.z = cvtpk(v[4], v[5]); w.w = cvtpk(v[6], v[7]); \
            *(u32x4*)((bf16_t*)(ws + WS_MIX) + tok * 1024 + col) = w; } \
        asm volatile("s_waitcnt lgkmcnt(0)" ::: "memory"); } while (0)
    A2_EPI(oa0, oa1, la, xa);
    A2_EPI(ob0, ob1, lb, xb);
    asm volatile("s_waitcnt lgkmcnt(0)\n\ts_barrier" ::: "memory");
#undef A2_DMA_K
#undef A2_DMA_V
#undef A2_SOFT
#undef A2_SPART
#undef A2_SSTEADY
#undef A2_VRD2
#undef A2_V8
#undef A2_PV
#undef A2_QK
#undef A2_MPART
#undef A2_PVK
#undef A2_QKK
#undef A2_KRD
#undef A2_SB
#undef A2_MS_HEAD
#undef A2_MS_BODY
#undef A2_ISSUE
#undef A2_ISSUE_S
#undef A2_ROT
#undef A2_CLOSE
#undef A2_CLOSE_S
#undef A2_EPI
#undef jbb
}
}

__device__ __forceinline__ int vcu_of_block() { const int G = gridDim.x, bx = blockIdx.x; return (G % 8 == 0) ? (bx % 8) * (G / 8) + bx / 8 : bx; }

__device__ __forceinline__ void phase_attn_a(unsigned char* ws, att::lds_ptr shm) {
    const int G = gridDim.x;
    int prev_h = -1;
    for (int id = vcu_of_block(); id < 1024; id += G) {
        const int i = id >> 8, v = id & 255, bh = v >> 1, half = v & 1, s = i >> 1; const int qb = (i & 1) ? 7 - (2 * s + half) : 2 * s + half;
        att::attn_unit_a2(bh >> 3, bh & 7, qb, (bh & 7) != prev_h, ws, shm); prev_h = bh & 7;
    }
}
__device__ __forceinline__ att::Unit unit_b12(int id) { const int blk = id >> 8, v = id & 255, bh = v >> 1, half = v & 1; return att::Unit{bh >> 3, bh & 7, 1 + half, half ? 4 : 1, half ? (blk & 3) : 0, half ? (blk >> 2) * 256 : blk * 256}; }
__device__ __forceinline__ void phase_attn_b12(unsigned char* ws, att::lds_ptr shm) {
    const int G = gridDim.x;
    if (G == 256) {
        const int vcu = vcu_of_block(); if (vcu & 1) return;
        const int bh = vcu >> 1;
#pragma nounroll
        for (int kind = 1; kind <= 2; ++kind) att::b_stream<1>(bh >> 3, bh & 7, kind, kind == 1 ? 1 : 4, 0, kind == 1 ? 1 : 4, kind == 1 ? 6 : 4, ws, shm);
        return;
    }
    for (int id = vcu_of_block(); id < 256; id += G) { const int bh = id >> 1;
        if ((id & 1) == 0) att::b_stream<1>(bh >> 3, bh & 7, 1, 1, 0, 1, 6, ws, shm); else att::b_stream<1>(bh >> 3, bh & 7, 2, 4, 0, 4, 4, ws, shm); }
}
__device__ __forceinline__ att::Unit unit_b3(int id) { const int i = id >> 8, v = id & 255, bh = v >> 1, half = v & 1; return att::Unit{bh >> 3, bh & 7, 3, 16, half * 8 + i, 0}; }
__device__ __forceinline__ void phase_attn_b3(unsigned char* ws, att::lds_ptr shm) {
    const int G = gridDim.x; att::bf16x8 qr[4]; bool first = true;
    for (int id = vcu_of_block(); id < 2048; id += G) { const bool hn = id + G < 2048;
        att::attn_unit<2>(unit_b3(id), first, unit_b3(hn ? id + G : id), hn, ws, shm, qr); first = false; }
}
namespace tk {
using bf16x8 = __attribute__((ext_vector_type(8))) short;
using f32x16 = __attribute__((ext_vector_type(16))) float;
using u32x4 = __attribute__((ext_vector_type(4))) unsigned;
#define TLDS __attribute__((address_space(3)))
typedef TLDS unsigned char* lds_ptr;
typedef TLDS unsigned TLDS_U;
constexpr int CAP = 384;
constexpr int HSTR = 1028;
constexpr int L_HIST = 0;
constexpr int L_LIST = 0;
constexpr int L_ZB = 98304;
constexpr int L_IMG = 114688;
constexpr int L_H2 = 131584;
constexpr int L_SC = 139776;
constexpr int L_FB = 0;
constexpr int LDS_BYTES = 140800;

__device__ __forceinline__ unsigned mono(float s) { const unsigned u = __float_as_uint(s); return (u & 0x80000000u) ? ~u : (u | 0x80000000u); }

__device__ __forceinline__ float relu_i(float x) { const int xi = __float_as_int(x); return __int_as_float(xi > 0 ? xi : 0); }
__device__ __forceinline__ void load_kf(bf16x8 (&kf)[4], const bf16_t* __restrict__ KIb, int j, int r32, int hi) {
    const bf16_t* kp = KIb + (size_t)(32 * j + r32) * 64 + hi * 8;
#pragma unroll
    for (int s = 0; s < 4; ++s) kf[s] = *(const bf16x8*)(kp + s * 16);
}
__device__ __forceinline__ f32x16 bscore(const bf16x8 (&kf)[4], const bf16x8 (&qf)[4][4], const float (&w)[4]) {
    f32x16 B;
#pragma unroll
    for (int r = 0; r < 16; ++r) B[r] = 32768.f;
#pragma unroll
    for (int h = 0; h < 4; ++h) {
        f32x16 a;
#pragma unroll
        for (int r = 0; r < 16; ++r) a[r] = 0.f;
#pragma unroll
        for (int s = 0; s < 4; ++s) a = __builtin_amdgcn_mfma_f32_32x32x16_bf16(kf[s], qf[h][s], a, 0, 0, 0);
#pragma unroll
        for (int r = 0; r < 16; ++r) B[r] = fmaf(w[h], relu_i(a[r]), B[r]);
    }
    return B;
}
template <bool DIAG> __device__ __forceinline__ void p1_block(const unsigned (&code)[16], TLDS unsigned* hrow, int r32, int hi) {
#pragma unroll
    for (int r = 0; r < 16; ++r) { const int c = (r & 3) + 8 * (r >> 2) + 4 * hi; const int bin = (int)(code[r] >> 6);
        if (!DIAG || c <= r32) __hip_atomic_fetch_add(hrow + bin, 1u, __ATOMIC_RELAXED, __HIP_MEMORY_SCOPE_WORKGROUP); }
}
__device__ __forceinline__ void img_set(TLDS unsigned* img, unsigned ql, unsigned idx) {
    const unsigned kk = idx & 31u, r = (kk & 3u) | ((kk >> 3) << 2), hh = (kk >> 2) & 1u;
    __hip_atomic_fetch_or(img + (idx >> 6) * 64u + ql + 32u * hh, 1u << (16u * ((idx >> 5) & 1u) + r), __ATOMIC_RELAXED, __HIP_MEMORY_SCOPE_WORKGROUP);
}
template <bool DIAG> __device__ __forceinline__ void p2_block(const unsigned (&code)[16], int j, unsigned ilo, unsigned ihi, bool ztie, int lane, int r32, int hi, TLDS unsigned* img, TLDS unsigned* lists, TLDS unsigned* ccnt, TLDS unsigned* zb) {
    unsigned bits = 0u; bool anyc = false;
#pragma unroll
    for (int r = 0; r < 16; ++r) { const int c = (r & 3) + 8 * (r >> 2) + 4 * hi; const bool ok = !DIAG || c <= r32; const bool def = ok && (code[r] >= ihi); anyc |= ok && !def && (code[r] >= ilo);
        bits |= def ? (1u << r) : 0u; }
    ((TLDS unsigned short*)img)[((j >> 1) * 64 + lane) * 2 + (j & 1)] = (unsigned short)bits;
    if (__any(anyc)) {
#pragma unroll
        for (int r = 0; r < 16; ++r) { const int c = (r & 3) + 8 * (r >> 2) + 4 * hi; const bool ok = !DIAG || c <= r32;
            if (ok && (code[r] >= ilo) && !(code[r] >= ihi)) { unsigned jb_ = (unsigned)(32 * j + 4 * hi); asm volatile("" : "+v"(jb_));
                const unsigned idx = jb_ + (unsigned)((r & 3) + 8 * (r >> 2));
                if (ztie && code[r] == 32768u) __hip_atomic_fetch_or(zb + r32 * 128 + (idx >> 5), 1u << (idx & 31u), __ATOMIC_RELAXED, __HIP_MEMORY_SCOPE_WORKGROUP);
                else { const unsigned slot = __hip_atomic_fetch_add(ccnt + r32, 1u, __ATOMIC_RELAXED, __HIP_MEMORY_SCOPE_WORKGROUP);
                    if (slot < (unsigned)CAP) lists[r32 * CAP + slot] = ((code[r] - ilo) << 12) | (4095u - idx); } } }
    }
}

__device__ __forceinline__ void topk_unit(int b, int qb32, unsigned char* ws, lds_ptr shm) {
    int tid_ = threadIdx.x; asm volatile("" : "+v"(tid_));
    const int tid = tid_, lane = tid & 63, r32 = lane & 31, hi = lane >> 5; const int wid = __builtin_amdgcn_readfirstlane(tid >> 6);
    const int q0 = 32 * qb32, nkb = qb32 + 1; const size_t rowbase = (size_t)b * SEQ;
    const bf16_t* KIb = (const bf16_t*)(ws + WS_KI) + rowbase * 64;
    unsigned char* bsc = ws + WS_BSC + (size_t)blockIdx.x * (260 * 1024);
    TLDS unsigned* hist = (TLDS unsigned*)(shm + L_HIST); TLDS unsigned* lists = (TLDS unsigned*)(shm + L_LIST); TLDS unsigned* img = (TLDS unsigned*)(shm + L_IMG);
    TLDS unsigned* h2 = (TLDS unsigned*)(shm + L_H2); TLDS float* tlo = (TLDS float*)(shm + L_SC); TLDS float* thi = tlo + 32; TLDS int* needv = (TLDS int*)(thi + 32); TLDS unsigned* ccnt = (TLDS unsigned*)(needv + 32); TLDS unsigned* zb = (TLDS unsigned*)(shm + L_ZB);
    { TLDS u32x4* hz = (TLDS u32x4*)hist;
#pragma unroll
      for (int i = 0; i < 16; ++i) hz[tid + 512 * i] = (u32x4){0u, 0u, 0u, 0u};
      if (tid < 32) hz[8192 + tid] = (u32x4){0u, 0u, 0u, 0u}; }
    if (tid < 32) ccnt[tid] = 0u;
    bf16x8 qf[4][4]; float w[4];
    { const bf16_t* qp = (const bf16_t*)(ws + WS_QI) + (rowbase + q0 + r32) * 256 + hi * 8;
#pragma unroll
      for (int h = 0; h < 4; ++h)
#pragma unroll
          for (int s = 0; s < 4; ++s) qf[h][s] = *(const bf16x8*)(qp + h * 64 + s * 16);
      const float4 wv = *(const float4*)((const float*)(ws + WS_WI) + (rowbase + q0 + r32) * 4);
      float n2[4];
#pragma unroll
      for (int h = 0; h < 4; ++h) { float a = 0.f;
#pragma unroll
          for (int s2 = 0; s2 < 4; ++s2)
#pragma unroll
              for (int e = 0; e < 8; ++e) { const float v = bf2f((bf16_t)qf[h][s2][e]); a = fmaf(v, v, a); }
          n2[h] = a + __shfl_xor(a, 32); }
      const float S2 = wv.x * wv.x * n2[0] + wv.y * wv.y * n2[1] + wv.z * wv.z * n2[2] + wv.w * wv.w * n2[3];
      const float g = S2 > 1e-30f ? 8192.f * rsqrtf(S2) : 0.f;     w[0] = wv.x * g; w[1] = wv.y * g; w[2] = wv.z * g; w[3] = wv.w * g; }
    __syncthreads();
    { bf16x8 kf[4], kn[4]; int j = wid; if (j < nkb) load_kf(kf, KIb, j, r32, hi); TLDS unsigned* hrow = hist + r32 * HSTR;
      for (; j < nkb; j += 8) {
        const bool more = j + 8 < nkb; if (more) load_kf(kn, KIb, j + 8, r32, hi);
        const f32x16 B = bscore(kf, qf, w);
        unsigned code[16];
#pragma unroll
        for (int r = 0; r < 16; ++r) code[r] = (unsigned)__builtin_amdgcn_fmed3f(B[r], 0.f, 65535.f);
        { uint4* sp = (uint4*)(bsc + (size_t)j * 2048) + lane;
          sp[0] = make_uint4(code[0] | (code[1] << 16), code[2] | (code[3] << 16), code[4] | (code[5] << 16), code[6] | (code[7] << 16));
          sp[64] = make_uint4(code[8] | (code[9] << 16), code[10] | (code[11] << 16), code[12] | (code[13] << 16), code[14] | (code[15] << 16)); }
        if (j == qb32) p1_block<true>(code, hrow, r32, hi); else p1_block<false>(code, hrow, r32, hi);
        if (more) {
#pragma unroll
            for (int s2 = 0; s2 < 4; ++s2) kf[s2] = kn[s2]; }
      } }
    __syncthreads();
    { const int q = tid >> 4, sub = tid & 15; const TLDS unsigned* hq = hist + q * HSTR; unsigned csum = 0u;
#pragma unroll
      for (int i = 0; i < 16; ++i) { const u32x4 v = *(const TLDS u32x4*)(hq + 64 * sub + 4 * i); csum += (v.x + v.y) + (v.z + v.w); }
      unsigned incl = csum;
#pragma unroll
      for (int off = 1; off < 16; off <<= 1) { const unsigned t = __shfl_down(incl, off, 16); if (sub + off < 16) incl += t; }
      const unsigned total = __shfl(incl, 0, 16); unsigned above = incl - csum;
      const bool f1 = (above < 256u) && (above + csum >= 256u);
      const unsigned long long bal1 = __ballot(f1); const unsigned g1 = (unsigned)(bal1 >> (16 * ((lane >> 4) & 3))) & 0xffffu;
      if (total < 256u || g1 == 0u) { if (sub == 0) { tlo[q] = -INFINITY; thi[q] = -INFINITY; needv[q] = 0; } }
      else {
          const int cst = __builtin_ctz(g1); const unsigned ab1 = __shfl(above, cst, 16);
          const u32x4 v = *(const TLDS u32x4*)(hq + 64 * cst + 4 * sub); const unsigned c4 = (v.x + v.y) + (v.z + v.w); unsigned in2 = c4;
#pragma unroll
          for (int off = 1; off < 16; off <<= 1) { const unsigned t = __shfl_down(in2, off, 16); if (sub + off < 16) in2 += t; }
          unsigned ab2 = ab1 + (in2 - c4);
          if ((ab2 < 256u) && (ab2 + c4 >= 256u)) { int bs;
              if (ab2 + v.w >= 256u) bs = 3; else { ab2 += v.w; if (ab2 + v.z >= 256u) bs = 2; else { ab2 += v.z; if (ab2 + v.y >= 256u) bs = 1; else { ab2 += v.y; bs = 0; } } }
              const int bstar = 64 * cst + 4 * sub + bs;
              tlo[q] = bstar <= 0 ? -INFINITY : (float)bstar; thi[q] = bstar >= 1023 ? INFINITY : (float)(bstar + 1); needv[q] = 256 - (int)ab2; }
      }
    }
    __syncthreads();
    if (tid < 64) img[(qb32 >> 1) * 64 + tid] = 0u;
    { TLDS u32x4* zz = (TLDS u32x4*)zb; zz[tid] = (u32x4){0u, 0u, 0u, 0u}; zz[tid + 512] = (u32x4){0u, 0u, 0u, 0u}; }
    __syncthreads();
    { const float tl = tlo[r32], th = thi[r32]; const bool ztie = (tl == 512.f);
      const unsigned ilo = tl == -INFINITY ? 0u : (unsigned)tl * 64u, ihi = th == -INFINITY ? 0u : (th == INFINITY ? 65536u : (unsigned)th * 64u);
      int j = wid; uint4 c0, c1, n0, n1;
      if (j < nkb) { const uint4* sp = (const uint4*)(bsc + (size_t)j * 2048) + lane; c0 = sp[0]; c1 = sp[64]; }
      for (; j < nkb; j += 8) {
        const bool more = j + 8 < nkb; if (more) { const uint4* sp = (const uint4*)(bsc + (size_t)(j + 8) * 2048) + lane; n0 = sp[0]; n1 = sp[64]; }
        const unsigned wv_[8] = {c0.x, c0.y, c0.z, c0.w, c1.x, c1.y, c1.z, c1.w}; unsigned code[16];
#pragma unroll
        for (int i = 0; i < 8; ++i) { code[2 * i] = wv_[i] & 0xffffu; code[2 * i + 1] = wv_[i] >> 16; }
        if (j == qb32) p2_block<true>(code, j, ilo, ihi, ztie, lane, r32, hi, img, lists, ccnt, zb); else p2_block<false>(code, j, ilo, ihi, ztie, lane, r32, hi, img, lists, ccnt, zb);
        if (more) { c0 = n0; c1 = n1; }
      } }
    __syncthreads();
    { const int q = 4 * wid + (lane >> 4), sub = lane & 15; const unsigned craw = ccnt[q]; const int C = craw > (unsigned)CAP ? CAP : (int)craw; int need = (craw > (unsigned)CAP) ? 0 : needv[q];
      int needz = 0; if (need > C) { needz = need - C; need = C; }
      int cm = C; cm = max(cm, __shfl_xor(cm, 16)); cm = max(cm, __shfl_xor(cm, 32));
      const TLDS unsigned* list = lists + q * CAP; TLDS unsigned* hq = h2 + q * 64; unsigned prefix = 0u;
      unsigned cr[8]; unsigned kmax = 0u;
#pragma unroll
      for (int e = 0; e < 8; ++e) { const int i = sub + 16 * e; cr[e] = (i < C) ? list[i] : ~0u; if (i < C) kmax = kmax > cr[e] ? kmax : cr[e]; }
      for (int i = sub + 128; i < cm; i += 16) if (i < C) { const unsigned ck = list[i]; kmax = kmax > ck ? kmax : ck; }
#pragma unroll
      for (int o = 1; o < 64; o <<= 1) { const unsigned t = __shfl_xor(kmax, o); kmax = kmax > t ? kmax : t; }
      const int nb = 32 - __builtin_clz(kmax | 1u); const int L = (nb + 5) / 6;
      for (int level = 0; level < L; ++level) {
          const int shift = 6 * (L - 1 - level);
          *(TLDS u32x4*)(hq + 4 * sub) = (u32x4){0u, 0u, 0u, 0u};
          asm volatile("s_waitcnt lgkmcnt(0)" ::: "memory");
#pragma unroll
          for (int e = 0; e < 8; ++e) { const unsigned ck = cr[e]; if (ck != ~0u && (ck >> (shift + 6)) == prefix) __hip_atomic_fetch_add(hq + (unsigned)((ck >> shift) & 63u), 1u, __ATOMIC_RELAXED, __HIP_MEMORY_SCOPE_WORKGROUP); }
          for (int i = sub + 128; i < cm; i += 32) { const bool v0 = i < C, v1 = i + 16 < C; const unsigned k0 = v0 ? list[i] : 0u, k1 = v1 ? list[i + 16] : 0u;
              if (v0 && (k0 >> (shift + 6)) == prefix) __hip_atomic_fetch_add(hq + (unsigned)((k0 >> shift) & 63u), 1u, __ATOMIC_RELAXED, __HIP_MEMORY_SCOPE_WORKGROUP);
              if (v1 && (k1 >> (shift + 6)) == prefix) __hip_atomic_fetch_add(hq + (unsigned)((k1 >> shift) & 63u), 1u, __ATOMIC_RELAXED, __HIP_MEMORY_SCOPE_WORKGROUP); }
          asm volatile("s_waitcnt lgkmcnt(0)" ::: "memory");
          const u32x4 v = *(const TLDS u32x4*)(hq + 4 * sub); const unsigned c4 = (v.x + v.y) + (v.z + v.w); unsigned incl = c4;
#pragma unroll
          for (int off = 1; off < 16; off <<= 1) { const unsigned t = __shfl_down(incl, off, 16); if (sub + off < 16) incl += t; }
          unsigned ab = incl - c4; const bool f = need > 0 && ab < (unsigned)need && ab + c4 >= (unsigned)need;
          int d = 0;
          if (f) { if (ab + v.w >= (unsigned)need) d = 3; else { ab += v.w; if (ab + v.z >= (unsigned)need) d = 2; else { ab += v.z; if (ab + v.y >= (unsigned)need) d = 1; else { ab += v.y; d = 0; } } } d += 4 * sub; }
          const unsigned long long bal = __ballot(f); const unsigned g = (unsigned)(bal >> (16 * ((lane >> 4) & 3))) & 0xffffu;
          if (g != 0u) { const int src = __builtin_ctz(g); d = __shfl(d, src, 16); const unsigned abn = __shfl(ab, src, 16); need -= (int)abn; prefix = (prefix << 6) | (unsigned)d; }
          else { need = 0; prefix = (prefix << 6); }
      }
      if (need > 0) {
#pragma unroll
          for (int e = 0; e < 8; ++e) { const unsigned ck = cr[e];
              if (ck != ~0u && ck >= prefix) { img_set(img, (unsigned)(q & 31), 4095u - (ck & 4095u)); } }
          for (int i = sub + 128; i < C; i += 16) { const unsigned ck = list[i];
              if (ck >= prefix) { img_set(img, (unsigned)(q & 31), 4095u - (ck & 4095u)); } }
      }
      if (__any(needz > 0)) {
          unsigned wv[8]; unsigned pc = 0u; const TLDS unsigned* zq = zb + q * 128 + 8 * sub;
#pragma unroll
          for (int e = 0; e < 8; ++e) { wv[e] = needz > 0 ? zq[e] : 0u; pc += __popc(wv[e]); }
          unsigned incl = pc;
#pragma unroll
          for (int off = 1; off < 16; off <<= 1) { const unsigned t = __shfl_up(incl, off, 16); if (sub >= off) incl += t; }
          unsigned below = incl - pc;
#pragma unroll
          for (int e = 0; e < 8; ++e) { unsigned w_ = wv[e];
              while (w_ != 0u && below < (unsigned)needz) { const unsigned bpos = (unsigned)__builtin_ctz(w_); w_ &= w_ - 1u; ++below;
                  img_set(img, (unsigned)(q & 31), 256u * sub + 32u * e + bpos); }
              below += __popc(w_); }
      }
    }
    __syncthreads();
    const unsigned ovf = (unsigned)__ballot(lane < 32 && ccnt[lane & 31] > (unsigned)CAP);
    for (int ql = 0; ql < 32; ++ql) {
        if (!((ovf >> ql) & 1u)) continue;
        __syncthreads();
        TLDS float* fsc = (TLDS float*)(shm + L_FB); TLDS unsigned* fh = (TLDS unsigned*)(shm + L_FB + 16384); TLDS unsigned* ftot = fh + 256; TLDS unsigned* fmisc = ftot + 16; TLDS float* fq = (TLDS float*)(fmisc + 16);
        const int q = q0 + ql, n = q + 1; const bf16_t* qrow = (const bf16_t*)(ws + WS_QI) + (rowbase + q) * 256; const float* wq = (const float*)(ws + WS_WI) + (rowbase + q) * 4;
        if (tid < 256) fq[tid] = bf2f(qrow[tid]);
        const float w0 = wq[0], w1 = wq[1], w2 = wq[2], w3 = wq[3];
        if (tid == 0) { fmisc[0] = 0u; fmisc[1] = 256u; }
        __syncthreads();
        for (int k = tid; k < n; k += 512) { const uint4* kr = (const uint4*)(KIb + (size_t)k * 64); float r0 = 0.f, r1 = 0.f, r2 = 0.f, r3 = 0.f;
#pragma unroll 2
            for (int c = 0; c < 8; ++c) { const uint4 v = kr[c]; const unsigned u[4] = {v.x, v.y, v.z, v.w};
#pragma unroll
                for (int e = 0; e < 4; ++e) { const float a = __uint_as_float(u[e] << 16), bq = __uint_as_float(u[e] & 0xffff0000u); const int d = 8 * c + 2 * e;
                    r0 = fmaf(fq[d], a, r0); r0 = fmaf(fq[d + 1], bq, r0); r1 = fmaf(fq[64 + d], a, r1); r1 = fmaf(fq[64 + d + 1], bq, r1);
                    r2 = fmaf(fq[128 + d], a, r2); r2 = fmaf(fq[128 + d + 1], bq, r2); r3 = fmaf(fq[192 + d], a, r3); r3 = fmaf(fq[192 + d + 1], bq, r3); } }
            fsc[k] = fmaf(w3, fmaxf(r3, 0.f), fmaf(w2, fmaxf(r2, 0.f), fmaf(w1, fmaxf(r1, 0.f), fmaf(w0, fmaxf(r0, 0.f), 0.f)))); }
        __syncthreads();
        for (int pass = 3; pass >= 0; --pass) { const int shift = pass * 8; if (tid < 256) fh[tid] = 0u; __syncthreads();
            const unsigned pfx = fmisc[0], nd = fmisc[1], himask = (pass == 3) ? 0u : (0xffffffffu << (shift + 8));
            for (int k = tid; k < n; k += 512) { const unsigned key = mono(fsc[k]); if ((key & himask) == pfx) __hip_atomic_fetch_add(fh + ((key >> shift) & 255u), 1u, __ATOMIC_RELAXED, __HIP_MEMORY_SCOPE_WORKGROUP); }
            __syncthreads();
            unsigned c = 0u, incl = 0u;
            if (tid < 256) { c = fh[tid]; incl = c;
#pragma unroll
                for (int off = 1; off < 64; off <<= 1) { const unsigned t = __shfl_down(incl, off, 64); if (lane + off < 64) incl += t; }
                if (lane == 0) ftot[wid] = incl; }
            __syncthreads();
            if (tid < 256) { unsigned above = incl - c; for (int w2_ = wid + 1; w2_ < 4; ++w2_) above += ftot[w2_];
                if (above < nd && above + c >= nd) { fmisc[0] = pfx | ((unsigned)tid << shift); fmisc[1] = nd - above; } }
            __syncthreads(); }
        const unsigned T = fmisc[0], nd = fmisc[1];
        unsigned myties = 0u;
        for (int i = 0; i < 8; ++i) { const int k = tid * 8 + i; if (k < n && mono(fsc[k]) == T) ++myties; }
        unsigned inc2 = myties;
#pragma unroll
        for (int off = 1; off < 64; off <<= 1) { const unsigned t = __shfl_up(inc2, off, 64); if (lane >= off) inc2 += t; }
        if (lane == 63) ftot[8 + wid] = inc2;
        __syncthreads();
        unsigned before = inc2 - myties; for (int w2_ = 0; w2_ < wid; ++w2_) before += ftot[8 + w2_];
        for (int i = 0; i < 8; ++i) { const int k = tid * 8 + i; if (k >= n) break; const unsigned key = mono(fsc[k]); bool sel;
            if (key > T) sel = true; else if (key == T) { sel = before < nd; ++before; } else sel = false;
            const unsigned kk = (unsigned)k & 31u, r = (kk & 3u) | ((kk >> 3) << 2), hh = (kk >> 2) & 1u; TLDS unsigned* wp = img + ((unsigned)k >> 6) * 64u + (unsigned)ql + 32u * hh; const unsigned bm = 1u << (16u * (((unsigned)k >> 5) & 1u) + r);
            if (sel) __hip_atomic_fetch_or(wp, bm, __ATOMIC_RELAXED, __HIP_MEMORY_SCOPE_WORKGROUP); else __hip_atomic_fetch_and(wp, ~bm, __ATOMIC_RELAXED, __HIP_MEMORY_SCOPE_WORKGROUP); }
        __syncthreads();
    }
    { const int nchunk = ((qb32 >> 1) + 1) * 16; u32x4* dst = (u32x4*)((unsigned*)(ws + WS_MASK) + (((size_t)b * 128 + qb32) * 64) * 64); const TLDS u32x4* src = (const TLDS u32x4*)img;
      for (int i = tid; i < nchunk; i += 512) dst[i] = src[i]; }
    __syncthreads();
}
}

__device__ __forceinline__ void phase_topk(unsigned char* ws, tk::lds_ptr shm) {
    const int G = gridDim.x; unsigned* ctr = (unsigned*)(ws + WS_CTL + 40960); volatile tk::TLDS_U* slot = (volatile tk::TLDS_U*)(shm + 147200);
    const bool half = (G == 256); const unsigned base = half ? 128u : (unsigned)G;
    int id = vcu_of_block();
    if (half) { if (id & 1) id >>= 1; else { if (threadIdx.x == 0) *slot = base + atomicAdd(ctr, 1u); __syncthreads(); id = (int)*slot; __syncthreads(); } }
    while (id < 2048) {
        unsigned nxt = 0u; if (threadIdx.x == 0) nxt = base + atomicAdd(ctr, 1u);
        tk::topk_unit(id & 15, 127 - (id >> 4), ws, shm);
        if (threadIdx.x == 0) *slot = nxt;
        __syncthreads();
        id = (int)*slot;
        __syncthreads();
    }
}
constexpr int MEGA_LDS = 147456;
#define LAS __attribute__((address_space(3)))
#define XB_TMO      128
#define XB_XCNT(j)  (256  + 64 * (j))
#define XB_XSUB(j)  (1280 + 64 * (j))
#define XB_XGEN(j)  (2304 + 64 * (j))
#define XB_TOP      3328
#define XB_TOPGEN   3392
#define XCD_BAR_WORDS 3456
#define XB_SPIN_CAP (1u << 18)

__device__ __forceinline__ unsigned xb_ld(unsigned* p)              { return __hip_atomic_load(p, __ATOMIC_RELAXED, __HIP_MEMORY_SCOPE_AGENT); }
__device__ __forceinline__ unsigned xb_add(unsigned* p, unsigned v) { return __hip_atomic_fetch_add(p, v, __ATOMIC_RELAXED, __HIP_MEMORY_SCOPE_AGENT); }
__device__ __forceinline__ unsigned xb_xcc_id() { return (unsigned)__builtin_amdgcn_s_getreg((3 << 11) | 20) & 0xFu; }
#define XB_SPIN(cond, bar) do { unsigned _sp = 0; while (cond) { __builtin_amdgcn_s_sleep(1); \
    if ((++_sp & 255u) == 0u) { if (xb_ld(&(bar)[XB_TMO])) break; if (_sp > XB_SPIN_CAP) { atomicAdd(&(bar)[XB_TMO], 1u); break; } } } } while (0)

struct XcdBarrier {
    unsigned* bar; unsigned x;
    volatile LAS unsigned* st;
};

__device__ __forceinline__ XcdBarrier xcd_barrier_post(unsigned* bar, volatile LAS unsigned* st) {
    XcdBarrier b; b.bar = bar; b.x = xb_xcc_id(); b.st = st;
    if (threadIdx.x == 0) (void)xb_add(&bar[XB_XCNT(b.x)], 1u);
    return b;
}
__device__ __forceinline__ void xcd_barrier_complete(unsigned* bar, unsigned x, unsigned& nloc, unsigned& nx) {
    const unsigned G = gridDim.x * gridDim.y * gridDim.z;
    unsigned sum, cnt, mine, sp = 0u;
    for (;;) {
        sum = 0u; cnt = 0u; mine = 0u;
#pragma unroll
        for (unsigned j = 0; j < 16; ++j) { const unsigned c = xb_ld(&bar[XB_XCNT(j)]); sum += c; cnt += (c > 0u) ? 1u : 0u; mine = (j == x) ? c : mine; }
        if (sum == G) break;
        __builtin_amdgcn_s_sleep(1);
        if ((++sp & 255u) == 0u) { if (xb_ld(&bar[XB_TMO])) break; if (sp > XB_SPIN_CAP) { atomicAdd(&bar[XB_TMO], 1u); break; } }
    }
    nloc = mine > 0u ? mine : 1u; nx = cnt > 0u ? cnt : 1u;
}

__device__ __forceinline__ void xcd_barrier(const XcdBarrier& b) {
    asm volatile("s_waitcnt vmcnt(0)" ::: "memory");
    __syncthreads();
    if (threadIdx.x == 0) {
        unsigned* bar = b.bar;
        __builtin_amdgcn_s_waitcnt(0);
        unsigned nloc = b.st[0], nx = b.st[1];
        if (nloc == 0u) { xcd_barrier_complete(bar, b.x, nloc, nx); b.st[0] = nloc; b.st[1] = nx; }
        const unsigned old = xb_add(&bar[XB_XSUB(b.x)], 1u);
        const unsigned gen = old / nloc;
        if (old + 1u == (gen + 1u) * nloc) {
            __builtin_amdgcn_fence(__ATOMIC_RELEASE, "agent");
            asm volatile("s_waitcnt vmcnt(0)" ::: "memory");
            const unsigned og = xb_add(&bar[XB_TOP], 1u);
            const unsigned tg = og / nx;
            if (og + 1u == (tg + 1u) * nx) xb_add(&bar[XB_TOPGEN], 1u);
            else XB_SPIN(xb_ld(&bar[XB_TOPGEN]) == tg, bar);
            __builtin_amdgcn_fence(__ATOMIC_ACQUIRE, "agent");
            xb_add(&bar[XB_XGEN(b.x)], 1u);
            asm volatile("s_waitcnt vmcnt(0)" ::: "memory");
        } else {
            XB_SPIN(xb_ld(&bar[XB_XGEN(b.x)]) == gen, bar);
            __builtin_amdgcn_fence(__ATOMIC_ACQUIRE, "agent");
            asm volatile("s_waitcnt vmcnt(0)" ::: "memory");
        }
    }
    __syncthreads();
}
struct MegaArgs { const float* x; const float* gain; const float* w_in; const float* w_out; const float* rel_bias; const float* gqa; const float* gka; const float* gqb; const float* gkb; float* out; unsigned char* ws; };
#define XCD_SYNC() xcd_barrier(xbar)
__global__ __launch_bounds__(512, 2) void mega_fwd(MegaArgs a) {
    extern __shared__ __attribute__((aligned(16))) unsigned char smem[];
    unsigned char* ws = a.ws;
    volatile LAS unsigned* MISC = (volatile LAS unsigned*)((LAS unsigned char*)smem + MEGA_LDS - 64);
    if (threadIdx.x < 16) MISC[threadIdx.x] = 0u;
    __syncthreads();
    XcdBarrier xbar = xcd_barrier_post((unsigned*)(ws + WS_CTL + 16384), MISC);
    { const size_t gid = (size_t)blockIdx.x * 512 + threadIdx.x, gsz = (size_t)gridDim.x * 512; const int wv = __builtin_amdgcn_readfirstlane(threadIdx.x >> 6);
      prep_w_body(gid, gsz, a.w_in, a.gain, a.w_out, a.rel_bias, (bf16_t*)(ws + WS_WTI), (bf16_t*)(ws + WS_WTO), (float*)(ws + WS_TAB), (int*)(ws + WS_TAB + 4096), a.gqa, a.gka, a.gqb, a.gkb, (float*)(ws + WS_GTAB), (float*)(ws + WS_ATAB));
      prep_weights((int)(gid >> 6), (int)(gsz >> 6), threadIdx.x & 63, a.w_in, a.gain, a.w_out, (bf16_t*)(ws + WS_WTI), (bf16_t*)(ws + WS_WTO), (__attribute__((address_space(3))) float*)(smem + wv * 16384));
      prep_x_body((int)(gid >> 6), (int)(gsz >> 6), threadIdx.x & 63, a.x, (bf16_t*)(ws + WS_XB), (float*)(ws + WS_RSTD)); }
    XCD_SYNC();
    { pg8::Gemm g{(const bf16_t*)(ws + WS_XB), (const bf16_t*)(ws + WS_WTI), M_TOK, NPHYS, 1024}; pg8::StaticOrder S; S.init(M_TOK, NPHYS, gridDim.x, blockIdx.x);
      PG8_LAS float* gl = (PG8_LAS float*)((PG8_LAS unsigned char*)smem + 131072);
      if (threadIdx.x < 256) gl[threadIdx.x] = threadIdx.x < 64 ? a.gqa[threadIdx.x] : threadIdx.x < 128 ? a.gka[threadIdx.x - 64] : threadIdx.x < 192 ? a.gqb[threadIdx.x - 128] : a.gkb[threadIdx.x - 192];
      __syncthreads();
      pg8::EpiIn E{ws, gl};
      pg8::gemm_phase<pg8::EpiIn, pg8::StaticOrder, true, true>((PG8_LAS unsigned char*)smem, g, S, E); }
    XCD_SYNC();
    phase_attn_b12(ws, (att::lds_ptr)smem);
    phase_topk(ws, (tk::lds_ptr)smem);
    XCD_SYNC();
    phase_attn_a(ws, (att::lds_ptr)smem);
    phase_attn_b3(ws, (att::lds_ptr)smem);
    XCD_SYNC();
    { pg8::Gemm g{(const bf16_t*)(ws + WS_MIX), (const bf16_t*)(ws + WS_WTO), M_TOK, 1024, 1024}; pg8::StaticOrder S; S.init(M_TOK, 1024, gridDim.x, blockIdx.x);
      pg8::EpiOut E{(const bf16_t*)(ws + WS_XB), (const float*)(ws + WS_RSTD), a.out};
      pg8::gemm_phase<pg8::EpiOut, pg8::StaticOrder, true, true>((PG8_LAS unsigned char*)smem, g, S, E); }
}

extern "C" void kernel_launch(void* const* d_in, const int* in_sizes, int n_in, void* d_out, int out_size, void* d_ws, size_t ws_size, hipStream_t stream) {
    static int grid_blocks = 0;
    if (grid_blocks == 0) {
        if (n_in != 9 || ws_size < WS_END) { fprintf(stderr, "kernel_launch: unexpected inputs (n_in %d, ws %zu)\n", n_in, ws_size); grid_blocks = -1; return; }
        int dev = 0, cus = 0, per_cu = 0;
        (void)hipGetDevice(&dev); (void)hipDeviceGetAttribute(&cus, hipDeviceAttributeMultiprocessorCount, dev);
        (void)hipFuncSetAttribute((const void*)mega_fwd, hipFuncAttributeMaxDynamicSharedMemorySize, MEGA_LDS);
        (void)hipOccupancyMaxActiveBlocksPerMultiprocessor(&per_cu, (const void*)mega_fwd, 512, MEGA_LDS);
        if (per_cu < 1) { fprintf(stderr, "kernel_launch: occupancy query says %d blocks per CU\n", per_cu); per_cu = 1; }
        grid_blocks = cus < 256 ? cus : 256;
        if (false) grid_blocks = cus;
    }
    if (grid_blocks < 0) return;
    (void)hipMemsetAsync((unsigned char*)d_ws + WS_CTL, 0, 65536, stream);
    MegaArgs a{};
    a.x = (const float*)d_in[0]; a.gain = (const float*)d_in[1]; a.w_in = (const float*)d_in[2]; a.w_out = (const float*)d_in[3]; a.rel_bias = (const float*)d_in[4];
    a.gqa = (const float*)d_in[5]; a.gka = (const float*)d_in[6]; a.gqb = (const float*)d_in[7]; a.gkb = (const float*)d_in[8]; a.out = (float*)d_out; a.ws = (unsigned char*)d_ws;
    hipLaunchKernelGGL(mega_fwd, dim3(grid_blocks), dim3(512), MEGA_LDS, stream, a);
    const hipError_t e = hipPeekAtLastError();
    if (e != hipSuccess) fprintf(stderr, "launch failed: %s (grid %d)\n", hipGetErrorString(e), grid_blocks);
}
```
